# Optimizing an MI355X kernel written in HIP

```python
import jax
import jax.numpy as jnp
from jax import lax
import numpy as np

D_MODEL = 1024
BATCH = 4
SEQ = 4096
DEPTH = 4

CTX_LEN = 256
GRID_W = 64
D_MIX = 1024

RG_WIDTH = 384
RG_BLOCKS = 6
RG_BLOCK = RG_WIDTH // RG_BLOCKS
RG_C = 8.0
CONV_K = 4

NA_HEADS = 6
NA_HEAD_DIM = 64
NA_WIDTH = NA_HEADS * NA_HEAD_DIM
NA_ROWS = 8
NA_COLS = 16

GDN_HEADS = 4
GDN_DK = 64
GDN_DV = 64
GDN_QK = GDN_HEADS * GDN_DK
GDN_WIDTH = GDN_HEADS * GDN_DV
GDN_CHUNK = 64
ROPE_BASE = 10000.0

CONV_CH = RG_WIDTH + 2 * GDN_QK + GDN_WIDTH
CONV_SPLIT = (RG_WIDTH, RG_WIDTH + GDN_QK, RG_WIDTH + 2 * GDN_QK)
REST_SIZES = (RG_WIDTH, NA_WIDTH, NA_WIDTH, NA_WIDTH, NA_WIDTH, GDN_WIDTH, 2 * GDN_HEADS, 2 * GDN_HEADS)
REST_SPLIT = tuple(int(v) for v in np.cumsum(REST_SIZES)[:-1])
D_IN = CONV_CH + sum(REST_SIZES)

DEEPNORM_ALPHA = (2.0 * DEPTH) ** 0.25
DEEPNORM_BETA = (8.0 * DEPTH) ** -0.25
LN_EPS = 1e-5
NORM_EPS = 1e-6
F32 = jnp.float32

kernel_name = 'hybrid_rglru_natten_gdn_prefix_dit'


def layer_norm(x, g, b):
    xf = x.astype(F32)
    mu = jnp.mean(xf, -1, keepdims=True)
    var = jnp.mean(jnp.square(xf - mu), -1, keepdims=True)
    return ((xf - mu) * lax.rsqrt(var + LN_EPS)).astype(x.dtype) * g + b


def split_heads(t, n_heads):
    return t.reshape(t.shape[:-1] + (n_heads, t.shape[-1] // n_heads))


def flip_seq(t, d):
    return t[:, ::-1] if d else t


def depthwise_conv_centred(u, w):
    k = w.shape[0]
    return lax.conv_general_dilated(u, w[:, None, :].astype(u.dtype), window_strides=(1,),
                                    padding=[(k // 2, k - 1 - k // 2)],
                                    dimension_numbers=('NWC', 'WIO', 'NWC'),
                                    feature_group_count=u.shape[-1])


def combined_projection(u, w_in, conv_w):
    p = u @ w_in
    conv = depthwise_conv_centred(p[..., :CONV_CH], conv_w)
    xa, qg, kg, vg = jnp.split(conv, CONV_SPLIT, axis=-1)
    za, qn, kn, vn, zn, zg, b_raw, a_raw = jnp.split(p[..., CONV_CH:], REST_SPLIT, axis=-1)
    return (xa, qg, kg, vg, za, qn, kn, vn, zn, zg, b_raw, a_raw)


def _linear_combine(left, right):
    a1, b1 = left
    a2, b2 = right
    return a1 * a2, a2 * b1 + b2


def block_diag_linear(u, w, b):
    ub = u.reshape(u.shape[:-1] + (RG_BLOCKS, RG_BLOCK))
    return jnp.einsum('blnd,nde->blne', ub, w).reshape(u.shape) + b


def rglru_scan(u, w_a, b_a, w_x, b_x, lam, h0):
    r = jax.nn.sigmoid(block_diag_linear(u, w_a, b_a))
    i = jax.nn.sigmoid(block_diag_linear(u, w_x, b_x))
    log_a = RG_C * r * jax.nn.log_sigmoid(lam)
    a = jnp.exp(log_a)
    b = jnp.sqrt(-jnp.expm1(2.0 * log_a)) * (i * u)
    b = b.at[:, 0].add(a[:, 0] * h0)
    _, h = lax.associative_scan(_linear_combine, (a, b), axis=1)
    return h


def rglru_bidir(u_lat, u_ctx, w_a, b_a, w_x, b_x, lam, ctx_out):
    dt = u_lat.dtype
    ul, uc = u_lat.astype(F32), u_ctx.astype(F32)
    h0 = jnp.zeros(uc.shape[:1] + uc.shape[2:], F32)
    lat, ctx = [], []
    for d in range(2):
        prm = (w_a[d], b_a[d], w_x[d], b_x[d], lam[d].astype(F32))
        hc = rglru_scan(flip_seq(uc, d), *prm, h0)
        hl = rglru_scan(flip_seq(ul, d), *prm, hc[:, -1])
        lat.append(flip_seq(hl, d))
        ctx.append(flip_seq(hc, d))
    y_ctx = (ctx[0] + ctx[1]).astype(dt) if ctx_out else None
    return (lat[0] + lat[1]).astype(dt), y_ctx


def neighbourhood_attend(q, k, v, k_ctx, v_ctx, rpb):
    bsz, seq, nh, hd = q.shape
    rows = seq // GRID_W
    wr = min(NA_ROWS, rows)
    q = q * (hd ** -0.5)
    qg = q.reshape(bsz, rows, GRID_W, nh, hd)
    kg = k.reshape(bsz, rows, GRID_W, nh, hd)
    vg = v.reshape(bsz, rows, GRID_W, nh, hd)
    row_start = jnp.clip(jnp.arange(rows) - wr // 2, 0, rows - wr)
    col_start = jnp.clip(jnp.arange(GRID_W) - NA_COLS // 2, 0, GRID_W - NA_COLS)
    col_idx = col_start[:, None] + jnp.arange(NA_COLS)[None, :]
    col_off = col_idx - jnp.arange(GRID_W)[:, None] + (NA_COLS - 1)
    rpb_col = rpb[:, :, col_off]
    n_loc = wr * NA_COLS

    def row_block(args):
        r, q_row = args
        r0 = row_start[r]
        k_rows = lax.dynamic_slice_in_dim(kg, r0, wr, axis=1)
        v_rows = lax.dynamic_slice_in_dim(vg, r0, wr, axis=1)
        k_win = k_rows[:, :, col_idx]
        v_win = v_rows[:, :, col_idx]
        row_off = r0 + jnp.arange(wr) - r + (NA_ROWS - 1)
        bias = jnp.transpose(rpb_col[:, row_off], (2, 0, 1, 3))[None]
        s_loc = jnp.einsum('bjhd,bwjmhd->bjhwm', q_row, k_win) + bias
        s_ctx = jnp.einsum('bjhd,bchd->bjhc', q_row, k_ctx)
        s = jnp.concatenate([s_loc.reshape(bsz, GRID_W, nh, n_loc), s_ctx], -1).astype(F32)
        p = jax.nn.softmax(s, axis=-1).astype(v.dtype)
        p_loc = p[..., :n_loc].reshape(bsz, GRID_W, nh, wr, NA_COLS)
        return (jnp.einsum('bjhwm,bwjmhd->bjhd', p_loc, v_win)
                + jnp.einsum('bjhc,bchd->bjhd', p[..., n_loc:], v_ctx))

    o = lax.map(row_block, (jnp.arange(rows), jnp.moveaxis(qg, 1, 0)))
    return jnp.moveaxis(o, 0, 1).reshape(bsz, seq, nh, hd)


def context_attend(q, k, v):
    s = jnp.einsum('bqhd,bkhd->bhqk', q * (q.shape[-1] ** -0.5), k).astype(F32)
    p = jax.nn.softmax(s, axis=-1).astype(v.dtype)
    return jnp.einsum('bhqk,bkhd->bqhd', p, v)


def axial_rope(t, rows_pos, cols_pos):
    half = t.shape[-1] // 2
    nf = half // 2
    inv_freq = ROPE_BASE ** (-jnp.arange(nf, dtype=F32) / nf)

    def rot(tp, pos):
        ang = pos.astype(F32)[:, None] * inv_freq[None, :]
        cos = jnp.cos(ang)[None, :, None, :]
        sin = jnp.sin(ang)[None, :, None, :]
        t1, t2 = tp[..., :nf], tp[..., nf:]
        return jnp.concatenate([t1 * cos - t2 * sin, t2 * cos + t1 * sin], -1)

    return jnp.concatenate([rot(t[..., :half], rows_pos), rot(t[..., half:], cols_pos)], -1)


def l2_normalise(t):
    return t * lax.rsqrt(jnp.sum(jnp.square(t), -1, keepdims=True) + NORM_EPS)


def gdn_qkv(qg, kg, vg, rope):
    q = l2_normalise(split_heads(jax.nn.silu(qg), GDN_HEADS).astype(F32))
    k = l2_normalise(split_heads(jax.nn.silu(kg), GDN_HEADS).astype(F32))
    v = split_heads(jax.nn.silu(vg), GDN_HEADS).astype(F32)
    if rope is not None:
        q = axial_rope(q, *rope)
        k = axial_rope(k, *rope)
    return q * (GDN_DK ** -0.5), k, v


def gdn_gates(b_raw, a_raw, a_log, dt_bias, d):
    sl = slice(d * GDN_HEADS, (d + 1) * GDN_HEADS)
    beta = jax.nn.sigmoid(b_raw[..., sl].astype(F32))
    g = -jnp.exp(a_log[d].astype(F32)) * jax.nn.softplus(a_raw[..., sl].astype(F32) + dt_bias[d].astype(F32))
    return beta, g


def gated_delta_chunked(q, k, v, beta, g, s0):
    bsz, seq, nh, _ = q.shape
    dv = v.shape[-1]
    n = seq // GDN_CHUNK

    def chunks(t):
        t = t.reshape((bsz, n, GDN_CHUNK) + t.shape[2:])
        return jnp.moveaxis(t, (1, 2), (0, 3))

    qc, kc, vc, bc, gc = (chunks(t) for t in (q, k, v, beta, g))
    gcum = jnp.cumsum(gc, axis=-1)
    lower = jnp.tril(jnp.ones((GDN_CHUNK, GDN_CHUNK), bool))
    strict = jnp.tril(jnp.ones((GDN_CHUNK, GDN_CHUNK), bool), -1)
    decay = jnp.exp(jnp.where(lower, gcum[..., :, None] - gcum[..., None, :], -jnp.inf))
    kb = kc * bc[..., None]
    a_mat = (jnp.where(strict, jnp.einsum('nbhid,nbhjd->nbhij', kb, kc) * decay, 0.0)
             + jnp.eye(GDN_CHUNK, dtype=F32))
    u = lax.linalg.triangular_solve(a_mat, vc * bc[..., None], left_side=True, lower=True, unit_diagonal=True)
    w = lax.linalg.triangular_solve(a_mat, kb * jnp.exp(gcum)[..., None], left_side=True, lower=True,
                                    unit_diagonal=True)
    qk = jnp.einsum('nbhid,nbhjd->nbhij', qc, kc) * decay

    def step(s, inp):
        q_i, k_i, u_i, w_i, qk_i, g_i = inp
        v_new = u_i - jnp.einsum('bhck,bhkv->bhcv', w_i, s)
        o = (jnp.einsum('bhck,bhkv->bhcv', q_i * jnp.exp(g_i)[..., None], s)
             + jnp.einsum('bhij,bhjv->bhiv', qk_i, v_new))
        g_last = g_i[..., -1:]
        s = (s * jnp.exp(g_last)[..., None]
             + jnp.einsum('bhck,bhcv->bhkv', k_i * jnp.exp(g_last - g_i)[..., None], v_new))
        return s, o

    s_fin, o = lax.scan(step, s0, (qc, kc, u, w, qk, gcum))
    o = jnp.moveaxis(o, (0, 3), (1, 2)).reshape(bsz, seq, nh, dv)
    return s_fin, o


def gdn_bidir(lat, ctx, a_log, dt_bias, ctx_out):
    q_l, k_l, v_l, b_l, a_l = lat
    q_c, k_c, v_c, b_c, a_c = ctx
    s0 = jnp.zeros((q_c.shape[0], GDN_HEADS, GDN_DK, GDN_DV), F32)
    outs_l, outs_c = [], []
    for d in range(2):
        beta_c, g_c = gdn_gates(b_c, a_c, a_log, dt_bias, d)
        beta_l, g_l = gdn_gates(b_l, a_l, a_log, dt_bias, d)
        s_c, o_c = gated_delta_chunked(*[flip_seq(t, d) for t in (q_c, k_c, v_c, beta_c, g_c)], s0)
        _, o_l = gated_delta_chunked(*[flip_seq(t, d) for t in (q_l, k_l, v_l, beta_l, g_l)], s_c)
        outs_l.append(flip_seq(o_l, d))
        outs_c.append(flip_seq(o_c, d))
    o_ctx = outs_c[0] + outs_c[1] if ctx_out else None
    return outs_l[0] + outs_l[1], o_ctx


def gdn_output(o, norm_w, z):
    o = o * lax.rsqrt(jnp.mean(jnp.square(o), -1, keepdims=True) + NORM_EPS) * norm_w.astype(F32)
    o = o * jax.nn.silu(split_heads(z, GDN_HEADS).astype(F32))
    return o.reshape(o.shape[:2] + (GDN_WIDTH,)).astype(z.dtype)


def merge_heads(t):
    return t.reshape(t.shape[:2] + (-1,))


def trunk_layer(x, xc, mod, mod_c, rope, w_in, conv_w, rg_wa, rg_ba, rg_wx, rg_bx, rg_lam, na_rpb,
                gdn_alog, gdn_dtb, gdn_nw, w_out, ln_g, ln_b, ctx_out):
    shift, scale, gate = jnp.split(mod, 3, axis=-1)
    shift_c, scale_c, gate_c = jnp.split(mod_c, 3, axis=-1)
    (a_l, qg_l, kg_l, vg_l, za_l, qn_l, kn_l, vn_l, zn_l, zg_l, br_l, ar_l) = combined_projection(
        x * (1 + scale[:, None]) + shift[:, None], w_in, conv_w)
    (a_c, qg_c, kg_c, vg_c, za_c, qn_c, kn_c, vn_c, zn_c, zg_c, br_c, ar_c) = combined_projection(
        xc * (1 + scale_c) + shift_c, w_in, conv_w)

    h_l, h_c = rglru_bidir(a_l, a_c, rg_wa, rg_ba, rg_wx, rg_bx, rg_lam, ctx_out)
    kb_c, vb_c = split_heads(kn_c, NA_HEADS), split_heads(vn_c, NA_HEADS)
    nb_l = neighbourhood_attend(split_heads(qn_l, NA_HEADS), split_heads(kn_l, NA_HEADS),
                                split_heads(vn_l, NA_HEADS), kb_c, vb_c, na_rpb)
    q_l, k_l, v_l = gdn_qkv(qg_l, kg_l, vg_l, rope)
    q_c, k_c, v_c = gdn_qkv(qg_c, kg_c, vg_c, None)
    o_l, o_c = gdn_bidir((q_l, k_l, v_l, br_l, ar_l), (q_c, k_c, v_c, br_c, ar_c), gdn_alog, gdn_dtb, ctx_out)

    y_l = jnp.concatenate([h_l * jax.nn.silu(za_l),
                           merge_heads(nb_l) * jax.nn.silu(zn_l),
                           gdn_output(o_l, gdn_nw, zg_l)], -1) @ w_out
    x_new = layer_norm(DEEPNORM_ALPHA * x + gate[:, None] * y_l, ln_g, ln_b)
    if not ctx_out:
        return x_new, None
    nb_c = context_attend(split_heads(qn_c, NA_HEADS), kb_c, vb_c)
    y_c = jnp.concatenate([h_c * jax.nn.silu(za_c),
                           merge_heads(nb_c) * jax.nn.silu(zn_c),
                           gdn_output(o_c, gdn_nw, zg_c)], -1) @ w_out
    xc_new = layer_norm(DEEPNORM_ALPHA * xc + gate_c * y_c, ln_g, ln_b)
    return x_new, xc_new


def setup_inputs(seed: int = 0) -> dict:
    key = jax.random.key(seed)
    ks = jax.random.split(key, 20)

    def nrm(k, shape, s):
        return jax.random.normal(k, shape, F32) * s

    x = nrm(ks[0], (BATCH, SEQ, D_MODEL), 1.0)
    c = nrm(ks[1], (BATCH, D_MODEL), 1.0)
    ctx = nrm(ks[2], (BATCH, CTX_LEN, D_MODEL), 1.0)
    c_ctx = nrm(ks[3], (D_MODEL,), 1.0)
    w_mod = nrm(ks[4], (DEPTH, D_MODEL, 3 * D_MODEL), 0.5 * D_MODEL ** -0.5)
    b_mod = nrm(ks[5], (DEPTH, 3 * D_MODEL), 0.02)
    w_in = nrm(ks[6], (DEPTH, D_MODEL, D_IN), D_MODEL ** -0.5)
    conv_w = nrm(ks[7], (DEPTH, CONV_K, CONV_CH), CONV_K ** -0.5)
    rg_wa = nrm(ks[8], (DEPTH, 2, RG_BLOCKS, RG_BLOCK, RG_BLOCK), RG_BLOCK ** -0.5)
    rg_ba = nrm(ks[9], (DEPTH, 2, RG_WIDTH), 0.02)
    rg_wx = nrm(ks[10], (DEPTH, 2, RG_BLOCKS, RG_BLOCK, RG_BLOCK), RG_BLOCK ** -0.5)
    rg_bx = nrm(ks[11], (DEPTH, 2, RG_WIDTH), 0.02)
    a_pow = jax.random.uniform(ks[12], (DEPTH, 2, RG_WIDTH), F32, 0.9, 0.999)
    s_lam = a_pow ** (1.0 / RG_C)
    rg_lam = jnp.log(s_lam) - jnp.log1p(-s_lam)
    na_rpb = nrm(ks[13], (DEPTH, NA_HEADS, 2 * NA_ROWS - 1, 2 * NA_COLS - 1), 0.1)
    gdn_alog = jnp.log(jax.random.uniform(ks[14], (DEPTH, 2, GDN_HEADS), F32, 1.0, 16.0))
    dt0 = jnp.exp(jax.random.uniform(ks[15], (DEPTH, 2, GDN_HEADS), F32, np.log(1e-3), np.log(1e-1)))
    gdn_dtb = dt0 + jnp.log(-jnp.expm1(-dt0))
    gdn_nw = 1.0 + nrm(ks[16], (DEPTH, GDN_DV), 0.02)
    w_out = nrm(ks[17], (DEPTH, D_MIX, D_MODEL), D_MIX ** -0.5 * DEEPNORM_BETA)
    ln_g = 1.0 + nrm(ks[18], (DEPTH, D_MODEL), 0.02)
    ln_b = nrm(ks[19], (DEPTH, D_MODEL), 0.02)
    return {'x': x, 'c': c, 'ctx': ctx, 'c_ctx': c_ctx, 'w_mod': w_mod, 'b_mod': b_mod, 'w_in': w_in,
            'conv_w': conv_w, 'rg_wa': rg_wa, 'rg_ba': rg_ba, 'rg_wx': rg_wx, 'rg_bx': rg_bx,
            'rg_lam': rg_lam, 'na_rpb': na_rpb, 'gdn_alog': gdn_alog, 'gdn_dtb': gdn_dtb,
            'gdn_nw': gdn_nw, 'w_out': w_out, 'ln_g': ln_g, 'ln_b': ln_b}


def reference(x, c, ctx, c_ctx, w_mod, b_mod, w_in, conv_w, rg_wa, rg_ba, rg_wx, rg_bx, rg_lam, na_rpb,
              gdn_alog, gdn_dtb, gdn_nw, w_out, ln_g, ln_b):
    pos = jnp.arange(x.shape[1])
    rope = (pos // GRID_W, pos % GRID_W)
    sc = jax.nn.silu(c)
    scc = jax.nn.silu(c_ctx)
    xc = ctx
    for l in range(DEPTH):
        mod = sc @ w_mod[l] + b_mod[l]
        mod_c = scc @ w_mod[l] + b_mod[l]
        x, xc = trunk_layer(x, xc, mod, mod_c, rope, w_in[l], conv_w[l], rg_wa[l], rg_ba[l], rg_wx[l],
                            rg_bx[l], rg_lam[l], na_rpb[l], gdn_alog[l], gdn_dtb[l], gdn_nw[l], w_out[l],
                            ln_g[l], ln_b[l], l < DEPTH - 1)
    return x
```

```cpp
#include <hip/hip_runtime.h>
#include <stdint.h>

namespace {
constexpr int D = 1024, NB = 4, SEQ = 4096, DEPTH = 4, CTX = 256;
constexpr int SEQT = CTX + SEQ;
constexpr int T = NB * SEQT;
constexpr int DIN = 3344, LDP = 3344;
constexpr int CONV_CH = 1152;
constexpr int C_XA = 0, C_QG = 384, C_KG = 640, C_VG = 896, C_ZA = 1152, C_QN = 1536, C_KN = 1920, C_VN = 2304,
              C_ZN = 2688, C_ZG = 3072, C_BR = 3328, C_AR = 3336;
constexpr float ALPHA = 1.681792830507429f;

typedef unsigned short bf16_t;
__device__ __forceinline__ bf16_t f2bf(float f) { unsigned u = __float_as_uint(f); u += 0x7FFFu + ((u >> 16) & 1u); return (bf16_t)(u >> 16); }
__device__ __forceinline__ float bf2f(bf16_t b) { return __uint_as_float(((unsigned)b) << 16); }
__device__ __forceinline__ float sigmoidf_(float x) { return 1.0f / (1.0f + expf(-x)); }
__device__ __forceinline__ float siluf_(float x) { return x / (1.0f + expf(-x)); }
__device__ __forceinline__ float softplusf_(float x) { return x > 20.f ? x : log1pf(expf(x)); }
__device__ __forceinline__ float wave_sum(float v) { for (int o = 32; o >= 1; o >>= 1) v += __shfl_xor(v, o); return v; }
__device__ __forceinline__ float wave_max(float v) { for (int o = 32; o >= 1; o >>= 1) v = fmaxf(v, __shfl_xor(v, o)); return v; }

__global__ void k_mod(const float* __restrict__ c, const float* __restrict__ cctx, const float* __restrict__ w_mod,
                      const float* __restrict__ b_mod, float* __restrict__ mod) {
    int idx = blockIdx.x * blockDim.x + threadIdx.x;
    if (idx >= DEPTH * 3072) return;
    int l = idx / 3072, n = idx % 3072;
    float a0 = 0, a1 = 0, a2 = 0, a3 = 0, a4 = 0;
    const float* w = w_mod + (size_t)l * 1024 * 3072 + n;
    for (int k = 0; k < 1024; ++k) {
        float wv = w[(size_t)k * 3072];
        a0 += siluf_(c[k]) * wv; a1 += siluf_(c[1024 + k]) * wv; a2 += siluf_(c[2048 + k]) * wv; a3 += siluf_(c[3072 + k]) * wv;
        a4 += siluf_(cctx[k]) * wv;
    }
    float bm = b_mod[l * 3072 + n];
    mod[(l * 5 + 0) * 3072 + n] = a0 + bm; mod[(l * 5 + 1) * 3072 + n] = a1 + bm; mod[(l * 5 + 2) * 3072 + n] = a2 + bm;
    mod[(l * 5 + 3) * 3072 + n] = a3 + bm; mod[(l * 5 + 4) * 3072 + n] = a4 + bm;
}

__global__ void k_copyx(const float* __restrict__ x, const float* __restrict__ ctx, float* __restrict__ X) {
    size_t i = (size_t)blockIdx.x * blockDim.x + threadIdx.x;
    if (i >= (size_t)T * 256) return;
    int t = (int)(i / 256), k4 = (int)(i % 256);
    int b = t / SEQT, sp = t % SEQT;
    const float4* src = sp < CTX ? (const float4*)(ctx + ((size_t)b * CTX + sp) * D) : (const float4*)(x + ((size_t)b * SEQ + (sp - CTX)) * D);
    ((float4*)X)[i] = src[k4];
}

__global__ void k_prep(const float* __restrict__ X, const float* __restrict__ modl, bf16_t* __restrict__ U) {
    size_t i = (size_t)blockIdx.x * blockDim.x + threadIdx.x;
    if (i >= (size_t)T * 256) return;
    int t = (int)(i / 256), k = (int)(i % 256) * 4;
    int j = (t % SEQT) < CTX ? 4 : t / SEQT;
    float4 xv = ((const float4*)X)[i];
    const float* sh = modl + j * 3072 + k; const float* sc = sh + 1024;
    ushort4 o;
    o.x = f2bf(xv.x * (1.f + sc[0]) + sh[0]); o.y = f2bf(xv.y * (1.f + sc[1]) + sh[1]);
    o.z = f2bf(xv.z * (1.f + sc[2]) + sh[2]); o.w = f2bf(xv.w * (1.f + sc[3]) + sh[3]);
    ((ushort4*)U)[i] = o;
}

template <int MODE>
__global__ __launch_bounds__(256) void k_sgemm(const bf16_t* __restrict__ A, const float* __restrict__ B, int M, int N, int K,
                                               bf16_t* __restrict__ Pout, int ldp, float* __restrict__ Z, const float* __restrict__ modl) {
    __shared__ float As[16][132];
    __shared__ float Bs[16][132];
    const int bm = blockIdx.y * 128, bn = blockIdx.x * 128;
    const int tid = threadIdx.x, ty = tid / 16, tx = tid % 16;
    float acc[8][8];
#pragma unroll
    for (int i = 0; i < 8; ++i)
#pragma unroll
        for (int j = 0; j < 8; ++j) acc[i][j] = 0.f;
    const int arow = tid / 2, akc = (tid % 2) * 8;
    const int brow = tid / 16, bnc = (tid % 16) * 8;
    for (int k0 = 0; k0 < K; k0 += 16) {
        uint4 av = *(const uint4*)(A + (size_t)(bm + arow) * K + k0 + akc);
        unsigned aw[4] = {av.x, av.y, av.z, av.w};
        float4 b0 = make_float4(0, 0, 0, 0), b1 = b0;
        if (bn + bnc < N) { const float* bp = B + (size_t)(k0 + brow) * N + bn + bnc; b0 = *(const float4*)bp; b1 = *(const float4*)(bp + 4); }
        __syncthreads();
#pragma unroll
        for (int i = 0; i < 4; ++i) { As[akc + 2 * i][arow] = __uint_as_float(aw[i] << 16); As[akc + 2 * i + 1][arow] = __uint_as_float(aw[i] & 0xffff0000u); }
        *(float4*)&Bs[brow][bnc] = b0; *(float4*)&Bs[brow][bnc + 4] = b1;
        __syncthreads();
#pragma unroll
        for (int kk = 0; kk < 16; ++kk) {
            float4 a0 = *(const float4*)&As[kk][ty * 8], a1 = *(const float4*)&As[kk][ty * 8 + 4];
            float4 c0 = *(const float4*)&Bs[kk][tx * 8], c1 = *(const float4*)&Bs[kk][tx * 8 + 4];
            float a[8] = {a0.x, a0.y, a0.z, a0.w, a1.x, a1.y, a1.z, a1.w};
            float b[8] = {c0.x, c0.y, c0.z, c0.w, c1.x, c1.y, c1.z, c1.w};
#pragma unroll
            for (int i = 0; i < 8; ++i)
#pragma unroll
                for (int j = 0; j < 8; ++j) acc[i][j] += a[i] * b[j];
        }
    }
    const int col0 = bn + tx * 8;
    if (col0 >= N) return;
#pragma unroll
    for (int i = 0; i < 8; ++i) {
        const int row = bm + ty * 8 + i;
        if (MODE == 0) {
            uint4 o;
            o.x = f2bf(acc[i][0]) | ((unsigned)f2bf(acc[i][1]) << 16); o.y = f2bf(acc[i][2]) | ((unsigned)f2bf(acc[i][3]) << 16);
            o.z = f2bf(acc[i][4]) | ((unsigned)f2bf(acc[i][5]) << 16); o.w = f2bf(acc[i][6]) | ((unsigned)f2bf(acc[i][7]) << 16);
            *(uint4*)(Pout + (size_t)row * ldp + col0) = o;
        } else {
            const int j = (row % SEQT) < CTX ? 4 : row / SEQT;
            const float* gate = modl + j * 3072 + 2048 + col0;
            float* zp = Z + (size_t)row * N + col0;
#pragma unroll
            for (int q = 0; q < 8; ++q) zp[q] = ALPHA * zp[q] + gate[q] * acc[i][q];
        }
    }
}

__device__ __forceinline__ float conv_at(const bf16_t* __restrict__ P, const float* __restrict__ cw, int t, int c) {
    const int sp = t % SEQT;
    const int lo = sp < CTX ? 0 : CTX, hi = sp < CTX ? CTX : SEQT;
    float acc = 0.f;
#pragma unroll
    for (int j = 0; j < 4; ++j) { const int s2 = sp + j - 2; if (s2 >= lo && s2 < hi) acc += cw[j * CONV_CH + c] * bf2f(P[(size_t)(t + j - 2) * LDP + c]); }
    return acc;
}
__device__ __forceinline__ int step_to_sp(int step, int d) { return d == 0 ? step : (step < CTX ? CTX - 1 - step : SEQT - 1 - (step - CTX)); }

__global__ __launch_bounds__(64) void k_rg(const bf16_t* __restrict__ P, const float* __restrict__ cw, const float* __restrict__ wa,
                                            const float* __restrict__ ba, const float* __restrict__ wx, const float* __restrict__ bx,
                                            const float* __restrict__ lam, float* __restrict__ H0, bf16_t* __restrict__ F, int d) {
    const int b = blockIdx.x / 6, n = blockIdx.x % 6, e = threadIdx.x, ch = n * 64 + e;
    __shared__ float us[64];
    const float* wap = wa + ((size_t)(d * 6 + n) * 64) * 64 + e;
    const float* wxp = wx + ((size_t)(d * 6 + n) * 64) * 64 + e;
    const float ls = -log1pf(expf(-lam[d * 384 + ch]));
    const float bav = ba[d * 384 + ch], bxv = bx[d * 384 + ch];
    float h = 0.f;
    for (int step = 0; step < SEQT; ++step) {
        const int sp = step_to_sp(step, d);
        const int t = b * SEQT + sp;
        const float u = conv_at(P, cw, t, C_XA + ch);
        __syncthreads(); us[e] = u; __syncthreads();
        float ra = bav, ri = bxv;
#pragma unroll 8
        for (int dd = 0; dd < 64; ++dd) { const float uu = us[dd]; ra += uu * wap[dd * 64]; ri += uu * wxp[dd * 64]; }
        const float r = sigmoidf_(ra), ig = sigmoidf_(ri);
        const float log_a = 8.0f * r * ls;
        const float a = expf(log_a);
        const float bb = sqrtf(-expm1f(2.0f * log_a)) * (ig * u);
        h = a * h + bb;
        if (d == 0) H0[(size_t)t * 384 + ch] = h;
        else { const float hs = H0[(size_t)t * 384 + ch] + h; const float za = bf2f(P[(size_t)t * LDP + C_ZA + ch]); F[(size_t)t * 1024 + ch] = f2bf(hs * siluf_(za)); }
    }
}

__global__ __launch_bounds__(64) void k_gdn(const bf16_t* __restrict__ P, const float* __restrict__ cw, const float* __restrict__ alog,
                                             const float* __restrict__ dtb, const float* __restrict__ nw, float* __restrict__ O0,
                                             bf16_t* __restrict__ F, int d) {
    const int b = blockIdx.x / 4, hh = blockIdx.x % 4, lane = threadIdx.x;
    __shared__ float ks[64], qs[64];
    float S[64];
#pragma unroll
    for (int i = 0; i < 64; ++i) S[i] = 0.f;
    const float Aneg = -expf(alog[d * 4 + hh]); const float dtbv = dtb[d * 4 + hh];
    const int half = lane >> 5, i32 = lane & 31, fi = i32 & 15;
    const float invf = expf(-(float)fi * (9.210340371976184f / 16.0f));
    const int partner = i32 < 16 ? lane + 16 : lane - 16;
    for (int step = 0; step < SEQT; ++step) {
        const int sp = step_to_sp(step, d);
        const int t = b * SEQT + sp;
        float qv = siluf_(conv_at(P, cw, t, C_QG + hh * 64 + lane));
        float kv = siluf_(conv_at(P, cw, t, C_KG + hh * 64 + lane));
        const float vv = siluf_(conv_at(P, cw, t, C_VG + hh * 64 + lane));
        const float qq = wave_sum(qv * qv), kk = wave_sum(kv * kv);
        qv *= rsqrtf(qq + 1e-6f); kv *= rsqrtf(kk + 1e-6f);
        if (sp >= CTX) {
            const int s = sp - CTX; const int pos = half == 0 ? (s >> 6) : (s & 63);
            const float ang = (float)pos * invf; const float cs = cosf(ang), sn = sinf(ang);
            const float qp = __shfl(qv, partner), kp = __shfl(kv, partner);
            if (i32 < 16) { qv = qv * cs - qp * sn; kv = kv * cs - kp * sn; } else { qv = qv * cs + qp * sn; kv = kv * cs + kp * sn; }
        }
        qv *= 0.125f;
        __syncthreads(); ks[lane] = kv; qs[lane] = qv; __syncthreads();
        const float beta = sigmoidf_(bf2f(P[(size_t)t * LDP + C_BR + d * 4 + hh]));
        const float g = Aneg * softplusf_(bf2f(P[(size_t)t * LDP + C_AR + d * 4 + hh]) + dtbv);
        const float eg = expf(g);
        float kS = 0.f;
#pragma unroll
        for (int i = 0; i < 64; ++i) kS += ks[i] * S[i];
        float o = 0.f;
#pragma unroll
        for (int i = 0; i < 64; ++i) { const float bk = beta * ks[i]; S[i] = eg * (S[i] - bk * kS) + bk * vv; o += qs[i] * S[i]; }
        if (d == 0) O0[(size_t)t * 256 + hh * 64 + lane] = o;
        else {
            o += O0[(size_t)t * 256 + hh * 64 + lane];
            const float ms = wave_sum(o * o) * (1.0f / 64.0f);
            const float zg = bf2f(P[(size_t)t * LDP + C_ZG + hh * 64 + lane]);
            F[(size_t)t * 1024 + 768 + hh * 64 + lane] = f2bf(o * rsqrtf(ms + 1e-6f) * nw[lane] * siluf_(zg));
        }
    }
}

__global__ __launch_bounds__(256) void k_na(const bf16_t* __restrict__ P, const float* __restrict__ rpb, bf16_t* __restrict__ F, int n_waves) {
    __shared__ float qsh[4][64];
    __shared__ float psh[4][384];
    __shared__ int tsh[4][384];
    const int w = threadIdx.x >> 6, lane = threadIdx.x & 63;
    int wave = blockIdx.x * 4 + w;
    if (wave >= n_waves) wave = n_waves - 1;
    int hh, b, s, t; bool latent;
    if (wave < NB * SEQ * 6) { hh = wave % 6; const int qi = wave / 6; b = qi / SEQ; s = qi % SEQ; t = b * SEQT + CTX + s; latent = true; }
    else { const int w2 = wave - NB * SEQ * 6; hh = w2 % 6; const int qi = w2 / 6; b = qi / CTX; s = qi % CTX; t = b * SEQT + s; latent = false; }
    qsh[w][lane] = bf2f(P[(size_t)t * LDP + C_QN + hh * 64 + lane]) * 0.125f;
    __syncthreads();
    const int r = s >> 6, jq = s & 63;
    const int r0 = min(max(r - 4, 0), 56), cs0 = min(max(jq - 8, 0), 48);
    float sc[6];
#pragma unroll
    for (int i = 0; i < 6; ++i) {
        const int kk = lane + 64 * i;
        int tk = -1; float bias = 0.f;
        if (latent) {
            if (i < 2) { const int wr = kk >> 4, m = kk & 15; const int kr = r0 + wr, kc = cs0 + m; tk = b * SEQT + CTX + kr * 64 + kc; bias = rpb[(hh * 15 + (kr - r + 7)) * 31 + (kc - jq + 15)]; }
            else tk = b * SEQT + (kk - 128);
        } else if (i < 4) tk = b * SEQT + kk;
        float dot = -INFINITY;
        if (tk >= 0) {
            const uint4* kp = (const uint4*)(P + (size_t)tk * LDP + C_KN + hh * 64);
            float acc = 0.f;
#pragma unroll
            for (int c8 = 0; c8 < 8; ++c8) {
                const uint4 kv = kp[c8]; const unsigned kw[4] = {kv.x, kv.y, kv.z, kv.w};
#pragma unroll
                for (int q = 0; q < 4; ++q) { acc += qsh[w][c8 * 8 + 2 * q] * __uint_as_float(kw[q] << 16); acc += qsh[w][c8 * 8 + 2 * q + 1] * __uint_as_float(kw[q] & 0xffff0000u); }
            }
            dot = acc + bias;
        }
        sc[i] = dot; tsh[w][kk] = tk;
    }
    float m = sc[0];
#pragma unroll
    for (int i = 1; i < 6; ++i) m = fmaxf(m, sc[i]);
    m = wave_max(m);
    float sum = 0.f;
#pragma unroll
    for (int i = 0; i < 6; ++i) { sc[i] = expf(sc[i] - m); sum += sc[i]; }
    sum = wave_sum(sum);
    const float inv = 1.0f / sum;
#pragma unroll
    for (int i = 0; i < 6; ++i) psh[w][lane + 64 * i] = sc[i] * inv;
    __syncthreads();
    const int nk = latent ? 384 : 256;
    float o = 0.f;
    for (int kk = 0; kk < nk; ++kk) o += psh[w][kk] * bf2f(P[(size_t)tsh[w][kk] * LDP + C_VN + hh * 64 + lane]);
    const float zn = bf2f(P[(size_t)t * LDP + C_ZN + hh * 64 + lane]);
    F[(size_t)t * 1024 + 384 + hh * 64 + lane] = f2bf(o * siluf_(zn));
}

__global__ __launch_bounds__(256) void k_ln(const float* __restrict__ Z, const float* __restrict__ g, const float* __restrict__ bta,
                                             float* __restrict__ Xout, float* __restrict__ final_out) {
    __shared__ float red[4];
    const int t = blockIdx.x, tid = threadIdx.x;
    const float4 v = ((const float4*)(Z + (size_t)t * D))[tid];
    float s = wave_sum(v.x + v.y + v.z + v.w);
    if ((tid & 63) == 0) red[tid >> 6] = s;
    __syncthreads();
    const float mean = (red[0] + red[1] + red[2] + red[3]) * (1.0f / 1024.0f);
    __syncthreads();
    const float dx = v.x - mean, dy = v.y - mean, dz = v.z - mean, dw = v.w - mean;
    float q = wave_sum(dx * dx + dy * dy + dz * dz + dw * dw);
    if ((tid & 63) == 0) red[tid >> 6] = q;
    __syncthreads();
    const float rstd = rsqrtf((red[0] + red[1] + red[2] + red[3]) * (1.0f / 1024.0f) + 1e-5f);
    const float4 gv = ((const float4*)g)[tid], bv = ((const float4*)bta)[tid];
    float4 o; o.x = dx * rstd * gv.x + bv.x; o.y = dy * rstd * gv.y + bv.y; o.z = dz * rstd * gv.z + bv.z; o.w = dw * rstd * gv.w + bv.w;
    if (final_out) { const int b = t / SEQT, sp = t % SEQT; if (sp >= CTX) ((float4*)(final_out + ((size_t)b * SEQ + (sp - CTX)) * D))[tid] = o; }
    else ((float4*)(Xout + (size_t)t * D))[tid] = o;
}
}

extern "C" void kernel_launch(void* const* d_in, const int* in_sizes, int n_in, void* d_out, int out_size, void* d_ws, size_t ws_size,
                              hipStream_t stream) {
    const float* x = (const float*)d_in[0]; const float* c = (const float*)d_in[1]; const float* ctx = (const float*)d_in[2];
    const float* c_ctx = (const float*)d_in[3]; const float* w_mod = (const float*)d_in[4]; const float* b_mod = (const float*)d_in[5];
    const float* w_in = (const float*)d_in[6]; const float* conv_w = (const float*)d_in[7]; const float* rg_wa = (const float*)d_in[8];
    const float* rg_ba = (const float*)d_in[9]; const float* rg_wx = (const float*)d_in[10]; const float* rg_bx = (const float*)d_in[11];
    const float* rg_lam = (const float*)d_in[12]; const float* na_rpb = (const float*)d_in[13]; const float* gdn_alog = (const float*)d_in[14];
    const float* gdn_dtb = (const float*)d_in[15]; const float* gdn_nw = (const float*)d_in[16]; const float* w_out = (const float*)d_in[17];
    const float* ln_g = (const float*)d_in[18]; const float* ln_b = (const float*)d_in[19];
    float* out = (float*)d_out;

    char* ws = (char*)d_ws; size_t off = 0;
    auto carve = [&](size_t bytes) { char* p = ws + off; off += (bytes + 255) & ~(size_t)255; return p; };
    float* mod = (float*)carve((size_t)DEPTH * 5 * 3072 * 4);
    float* X = (float*)carve((size_t)T * D * 4);
    bf16_t* UF = (bf16_t*)carve((size_t)T * D * 2);
    bf16_t* P = (bf16_t*)carve((size_t)T * LDP * 2);
    float* H0 = out;
    float* O0 = out + (size_t)T * 384;

    k_mod<<<(DEPTH * 3072 + 255) / 256, 256, 0, stream>>>(c, c_ctx, w_mod, b_mod, mod);
    k_copyx<<<(T * 256 + 255) / 256, 256, 0, stream>>>(x, ctx, X);
    for (int l = 0; l < DEPTH; ++l) {
        const float* modl = mod + (size_t)l * 5 * 3072;
        const float* cw = conv_w + (size_t)l * 4 * CONV_CH;
        k_prep<<<(T * 256 + 255) / 256, 256, 0, stream>>>(X, modl, UF);
        k_sgemm<0><<<dim3((DIN + 127) / 128, T / 128), 256, 0, stream>>>(UF, w_in + (size_t)l * D * DIN, T, DIN, D, P, LDP, nullptr, nullptr);
        for (int d = 0; d < 2; ++d)
            k_rg<<<NB * 6, 64, 0, stream>>>(P, cw, rg_wa + (size_t)l * 2 * 6 * 64 * 64, rg_ba + (size_t)l * 2 * 384, rg_wx + (size_t)l * 2 * 6 * 64 * 64,
                                            rg_bx + (size_t)l * 2 * 384, rg_lam + (size_t)l * 2 * 384, H0, UF, d);
        for (int d = 0; d < 2; ++d)
            k_gdn<<<NB * 4, 64, 0, stream>>>(P, cw, gdn_alog + l * 8, gdn_dtb + l * 8, gdn_nw + l * 64, O0, UF, d);
        const int n_waves = NB * SEQ * 6 + (l < DEPTH - 1 ? NB * CTX * 6 : 0);
        k_na<<<(n_waves + 3) / 4, 256, 0, stream>>>(P, na_rpb + (size_t)l * 6 * 15 * 31, UF, n_waves);
        k_sgemm<1><<<dim3(D / 128, T / 128), 256, 0, stream>>>(UF, w_out + (size_t)l * D * D, T, D, D, nullptr, 0, X, modl);
        k_ln<<<T, 256, 0, stream>>>(X, ln_g + l * D, ln_b + l * D, X, l == DEPTH - 1 ? out : nullptr);
    }
}
```

```cpp
#include <hip/hip_runtime.h>
#include <hip/hip_cooperative_groups.h>
#include <cstdio>
#include <cstdint>
namespace cg = cooperative_groups;

namespace {
constexpr int D = 1024, NB = 4, SEQ = 4096, DEPTH = 4, CTX = 256;
constexpr int SEQT = CTX + SEQ;
constexpr int T = NB * SEQT;
constexpr int DIN = 3344, LDP = 3360, NPAD = 3584;
constexpr int CONV_CH = 1152;
constexpr int C_XA = 0, C_QG = 384, C_KG = 640, C_VG = 896, C_ZA = 1152, C_QN = 1536, C_KN = 1920, C_VN = 2304,
              C_ZN = 2688, C_ZG = 3072, C_BR = 3328, C_AR = 3336;
constexpr float ALPHA = 1.681792830507429f;
}
namespace pg8 {
#define PG8_LAS __attribute__((address_space(3)))
typedef unsigned short bf16_t;
typedef short bf16x8 __attribute__((ext_vector_type(8)));
typedef float f32x4 __attribute__((ext_vector_type(4)));
typedef unsigned u32x4 __attribute__((ext_vector_type(4)));
constexpr int BM = 256, BK = 64, HALF = 128, HTB = HALF * BK * 2  , STAGE_BYTES = 8 * HTB, NXCD = 8, WGM = 8;

__host__ __device__ __forceinline__ int lds_byte(int r, int c) { const int st = (r >> 4) * 2 + (c >> 5), rr = r & 15, cc = c & 31, ob = rr * 64 + cc * 2; return st * 1024 + (ob ^ (((ob >> 9) & 1) << 5)); }
__host__ __device__ __forceinline__ void stage_rc(int b, int& R, int& C) { const int st = b / 1024, sb = b % 1024, swz = sb ^ (((sb >> 9) & 1) << 5); R = (st >> 1) * 16 + swz / 64; C = (st & 1) * 32 + (swz % 64) / 2; }
__host__ __device__ __forceinline__ int perm32(int rho) { const int n = rho >> 4, i = rho & 15; return 8 * (i >> 2) + 4 * n + (i & 3); }

struct Unit { int pm, pn; };
struct Gemm { const bf16_t* A; const bf16_t* Bt; int M, N, K; };

struct StaticOrder {
    int nM, nN, nwg, G, c;
    __host__ __device__ void init(int M, int N, int G_, int c_) { nM = M / BM; nN = N / BM; nwg = nM * nN; G = G_; c = c_; }
    __host__ __device__ bool next(int i, Unit& u) const {
        const long L = (long)i * G + c; if (L >= nwg) return false;
        int wgid = (int)L; { const int q = nwg / NXCD, r = nwg % NXCD, xcd = wgid % NXCD, off = wgid / NXCD; wgid = (xcd < r ? xcd * (q + 1) : r * (q + 1) + (xcd - r) * q) + off; }
        const int nig = WGM * nN, gid = wgid / nig, fm = gid * WGM, gsz = (nM - fm) < WGM ? (nM - fm) : WGM;
        u.pm = fm + ((wgid % nig) % gsz); u.pn = (wgid % nig) / gsz; return true;
    }
    __device__ __forceinline__ void a_ready(const Unit&) const {}
    __device__ __forceinline__ void done(const Unit&) const {}
};

__device__ __forceinline__ unsigned cvt_pk_bf16(float lo, float hi) { unsigned r; asm volatile("v_cvt_pk_bf16_f32 %0, %1, %2" : "=v"(r) : "v"(lo), "v"(hi)); return r; }
struct EpiP {
    static constexpr bool PERM = true, AFTER_DRAIN = false;
    bf16_t* P;
    __device__ __forceinline__ void operator()(const f32x4 (&acc)[2][2][4][2], const Unit& u, int wr, int wc, int fr, int fq) const {
        asm volatile("" : "+v"(fr), "+v"(fq));
        const int row0 = u.pm * BM + wr * 64 + fr, col0 = u.pn * BM + wc * 32 + 8 * fq;
#pragma unroll
        for (int ai = 0; ai < 2; ++ai)
#pragma unroll
            for (int m = 0; m < 4; ++m) { bf16_t* rowp = P + (size_t)(row0 + ai * HALF + m * 16) * LDP + col0;
#pragma unroll
                for (int bj = 0; bj < 2; ++bj) { if (col0 + bj * HALF < LDP) { const f32x4 v0 = acc[ai][bj][m][0], v1 = acc[ai][bj][m][1];
                    u32x4 w; w.x = cvt_pk_bf16(v0[0], v0[1]); w.y = cvt_pk_bf16(v0[2], v0[3]); w.z = cvt_pk_bf16(v1[0], v1[1]); w.w = cvt_pk_bf16(v1[2], v1[3]);
                    *(u32x4*)(rowp + bj * HALF) = w; } } }
    }
};
struct EpiZ {
    static constexpr bool PERM = false, AFTER_DRAIN = false;
    const float* x_in; const float* ctx_in; float* X; const float* modl; int layer0;
    __device__ __forceinline__ void operator()(const f32x4 (&acc)[2][2][4][2], const Unit& u, int wr, int wc, int fr, int fq) const {
        asm volatile("" : "+v"(fr), "+v"(fq));
        const int row0 = u.pm * BM + wr * 64 + fr, col0 = u.pn * BM + wc * 32 + 4 * fq;
#pragma unroll
        for (int ai = 0; ai < 2; ++ai)
#pragma unroll
            for (int m = 0; m < 4; ++m) { const int r = row0 + ai * HALF + m * 16; const int b = r / SEQT, sp = r - b * SEQT; const int j = sp < CTX ? 4 : b;
                const float* xs = layer0 ? (sp < CTX ? ctx_in + ((size_t)b * CTX + sp) * D : x_in + ((size_t)b * SEQ + (sp - CTX)) * D) : X + (size_t)r * D;
                float* zo = X + (size_t)r * D; const float* gp = modl + j * 3072 + 2048;
#pragma unroll
                for (int bj = 0; bj < 2; ++bj)
#pragma unroll
                    for (int n = 0; n < 2; ++n) { const int c = col0 + bj * HALF + n * 16; const f32x4 xv = *(const f32x4*)(xs + c), gv = *(const f32x4*)(gp + c);
                        *(f32x4*)(zo + c) = xv * ALPHA + gv * acc[ai][bj][m][n]; } }
    }
};

template <class Epi, class Sched, bool ALIGN_EPI = false, bool SP2 = false>
__device__ __forceinline__ void gemm_phase(PG8_LAS unsigned char* lds, const Gemm g, const Sched& S, const Epi& E) {
    const int tid = threadIdx.x, wid = __builtin_amdgcn_readfirstlane(tid >> 6), lane = tid & 63, wr = wid >> 2, wc = wid & 3, fr = lane & 15, fq = lane >> 4;
    const int K = g.K, nt = K / BK;
    unsigned voffA[2], voffB[2];
#pragma unroll
    for (int i = 0; i < 2; ++i) { int R, C; stage_rc(tid * 16 + i * 8192, R, C); const int Rb = Epi::PERM ? ((R & ~31) + perm32(R & 31)) : R;
        voffA[i] = (unsigned)(R * K + C) * 2u; voffB[i] = (unsigned)(Rb * K + C) * 2u; }
    const size_t kstep = (size_t)(BK * 2);
    const size_t hstep = (size_t)HALF * K * 2;
    const size_t tstep = 2 * hstep;
    const unsigned ldsw = (unsigned)wid * 1024u;
    const int aoff = lds_byte(wr * 64 + fr, fq * 8), boff = lds_byte(wc * 32 + fr, fq * 8);
#define PG8_SA(b, h) (((b) * 2 + (h)) * HTB)
#define PG8_SB(b, h) ((4 + (b) * 2 + (h)) * HTB)
#define PG8_STAGE(bufoff, gbase, voff) do { _Pragma("unroll") for (int _i = 0; _i < 2; ++_i) \
        __builtin_amdgcn_global_load_lds((const unsigned*)((const char*)(gbase) + (voff)[_i]), (PG8_LAS unsigned*)(lds + (bufoff) + ldsw + _i * 8192), 16, 0, 0); } while (0)
#define PG8_LDA(dst, b, h) do { _Pragma("unroll") for (int m = 0; m < 4; ++m) _Pragma("unroll") for (int k = 0; k < 2; ++k) dst[m][k] = *(const PG8_LAS bf16x8*)(lds + PG8_SA(b, h) + aoff + m * 2048 + k * 1024); } while (0)
#define PG8_LDB(dst, b, h) do { _Pragma("unroll") for (int n = 0; n < 2; ++n) _Pragma("unroll") for (int k = 0; k < 2; ++k) dst[n][k] = *(const PG8_LAS bf16x8*)(lds + PG8_SB(b, h) + boff + n * 2048 + k * 1024); } while (0)
#define PG8_MMA(ai, bj, At, Bt) do { __builtin_amdgcn_s_setprio(1); _Pragma("unroll") for (int m = 0; m < 4; ++m) _Pragma("unroll") for (int n = 0; n < 2; ++n) _Pragma("unroll") for (int k = 0; k < 2; ++k) \
        acc[ai][bj][m][n] = __builtin_amdgcn_mfma_f32_16x16x32_bf16(Bt[n][k], At[m][k], acc[ai][bj][m][n], 0, 0, 0); __builtin_amdgcn_s_setprio(0); } while (0)
#define PG8_WAIT_V(n) asm volatile("s_waitcnt vmcnt(" #n ")" ::: "memory")
#define PG8_WAIT_L(n) asm volatile("s_waitcnt lgkmcnt(" #n ")" ::: "memory")
#define PG8_BAR __builtin_amdgcn_s_barrier()
#define PG8_SCHED __builtin_amdgcn_sched_barrier(0)
    Unit cur, nxt; int ui = 0;
    if (!S.next(0, cur)) return;
    f32x4 acc[2][2][4][2];
#pragma unroll
    for (int a = 0; a < 2; ++a)
#pragma unroll
        for (int b = 0; b < 2; ++b)
#pragma unroll
            for (int m = 0; m < 4; ++m)
#pragma unroll
                for (int n = 0; n < 2; ++n) acc[a][b][m][n] = (f32x4){0.f, 0.f, 0.f, 0.f};
    bf16x8 At[4][2], B0[2][2], B1[2][2];
    const char* cA = (const char*)g.A + (size_t)cur.pm * tstep; const char* cB = (const char*)g.Bt + (size_t)cur.pn * tstep;
    S.a_ready(cur);
    if constexpr (SP2) {
        PG8_STAGE(PG8_SB(0, 0), cB, voffB); PG8_STAGE(PG8_SB(0, 1), cB + hstep, voffB); PG8_STAGE(PG8_SA(0, 0), cA, voffA); PG8_STAGE(PG8_SA(0, 1), cA + hstep, voffA);
        if (wr == 1) PG8_BAR;
        PG8_WAIT_V(2); PG8_BAR;
        PG8_STAGE(PG8_SB(1, 0), cB + kstep, voffB); PG8_STAGE(PG8_SA(1, 0), cA + kstep, voffA); PG8_STAGE(PG8_SB(1, 1), cB + hstep + kstep, voffB);
        PG8_WAIT_V(6); PG8_BAR;
    } else {
        PG8_STAGE(PG8_SB(0, 0), cB, voffB); PG8_STAGE(PG8_SA(0, 0), cA, voffA); PG8_STAGE(PG8_SB(0, 1), cB + hstep, voffB); PG8_STAGE(PG8_SA(0, 1), cA + hstep, voffA);
        if (wr == 1) PG8_BAR;
        PG8_WAIT_V(4); PG8_BAR;
        PG8_STAGE(PG8_SB(1, 0), cB + kstep, voffB); PG8_STAGE(PG8_SA(1, 0), cA + kstep, voffA); PG8_STAGE(PG8_SB(1, 1), cB + hstep + kstep, voffB);
        PG8_WAIT_V(6); PG8_BAR;
    }
    for (;;) {
        const bool has_next = S.next(ui + 1, nxt);
        const char* nA = has_next ? (const char*)g.A + (size_t)nxt.pm * tstep : cA; const char* nB = has_next ? (const char*)g.Bt + (size_t)nxt.pn * tstep : cB;
        for (int t = 0; t < nt; t += 2) {
            const bool last = (t == nt - 2);
            const char* a1 = cA + (size_t)(t + 1) * kstep;
            const char* a2 = last ? nA : cA + (size_t)(t + 2) * kstep; const char* b2 = last ? nB : cB + (size_t)(t + 2) * kstep;
            const char* a3 = a2 + kstep; const char* b3 = b2 + kstep;
            if (last && has_next) S.a_ready(nxt);
            if constexpr (SP2) {
            PG8_LDB(B0, 0, 0); PG8_LDB(B1, 0, 1); PG8_SCHED; PG8_LDA(At, 0, 0); PG8_STAGE(PG8_SA(1, 1), a1 + hstep, voffA);
            PG8_WAIT_V(8); PG8_WAIT_L(0); PG8_BAR; PG8_MMA(0, 0, At, B0); PG8_MMA(0, 1, At, B1); PG8_BAR; PG8_SCHED;
            PG8_LDA(At, 0, 1); PG8_STAGE(PG8_SB(0, 0), b2, voffB); PG8_STAGE(PG8_SB(0, 1), b2 + hstep, voffB); PG8_STAGE(PG8_SA(0, 0), a2, voffA);
            PG8_WAIT_V(8); PG8_WAIT_L(0); PG8_BAR; PG8_MMA(1, 0, At, B0); PG8_MMA(1, 1, At, B1); PG8_BAR; PG8_SCHED;
            PG8_LDB(B0, 1, 0); PG8_LDB(B1, 1, 1); PG8_SCHED; PG8_LDA(At, 1, 0); PG8_STAGE(PG8_SA(0, 1), a2 + hstep, voffA);
            PG8_WAIT_V(8); PG8_WAIT_L(0); PG8_BAR; PG8_MMA(0, 0, At, B0); PG8_MMA(0, 1, At, B1); PG8_BAR; PG8_SCHED;
            PG8_LDA(At, 1, 1); PG8_STAGE(PG8_SB(1, 0), b3, voffB); PG8_STAGE(PG8_SB(1, 1), b3 + hstep, voffB); PG8_STAGE(PG8_SA(1, 0), a3, voffA);
            PG8_WAIT_V(8); PG8_WAIT_L(0); PG8_BAR; PG8_MMA(1, 0, At, B0); PG8_MMA(1, 1, At, B1); PG8_BAR; PG8_SCHED;
            } else {
            PG8_LDB(B0, 0, 0); PG8_SCHED; PG8_LDA(At, 0, 0); PG8_STAGE(PG8_SA(1, 1), a1 + hstep, voffA);
            PG8_WAIT_L(8); PG8_BAR; PG8_WAIT_L(0); PG8_MMA(0, 0, At, B0); PG8_BAR; PG8_SCHED;
            PG8_LDB(B1, 0, 1); PG8_STAGE(PG8_SB(0, 0), b2, voffB);
            PG8_BAR; PG8_WAIT_L(0); PG8_MMA(0, 1, At, B1); PG8_BAR;
            PG8_LDA(At, 0, 1); PG8_STAGE(PG8_SA(0, 0), a2, voffA);
            PG8_BAR; PG8_WAIT_L(0); PG8_MMA(1, 0, At, B0); PG8_BAR; PG8_SCHED;
            PG8_STAGE(PG8_SB(0, 1), b2 + hstep, voffB);
            PG8_WAIT_V(6); PG8_BAR; PG8_MMA(1, 1, At, B1); PG8_BAR;
            PG8_LDB(B0, 1, 0); PG8_SCHED; PG8_LDA(At, 1, 0); PG8_STAGE(PG8_SA(0, 1), a2 + hstep, voffA);
            PG8_WAIT_L(8); PG8_BAR; PG8_WAIT_L(0); PG8_MMA(0, 0, At, B0); PG8_BAR; PG8_SCHED;
            PG8_LDB(B1, 1, 1); PG8_STAGE(PG8_SB(1, 0), b3, voffB);
            PG8_BAR; PG8_WAIT_L(0); PG8_MMA(0, 1, At, B1); PG8_BAR;
            PG8_LDA(At, 1, 1); PG8_STAGE(PG8_SA(1, 0), a3, voffA);
            PG8_BAR; PG8_WAIT_L(0); PG8_MMA(1, 0, At, B0); PG8_BAR; PG8_SCHED;
            PG8_STAGE(PG8_SB(1, 1), b3 + hstep, voffB);
            PG8_WAIT_V(6); PG8_BAR; PG8_MMA(1, 1, At, B1); PG8_BAR;
            }
        }
        if constexpr (ALIGN_EPI) { if (wr == 0) PG8_BAR; }
        if constexpr (!Epi::AFTER_DRAIN) { E(acc, cur, wr, wc, fr, fq); S.done(cur); }
        if (!has_next) break;
#pragma unroll
        for (int a = 0; a < 2; ++a)
#pragma unroll
            for (int b = 0; b < 2; ++b)
#pragma unroll
                for (int m = 0; m < 4; ++m)
#pragma unroll
                    for (int n = 0; n < 2; ++n) acc[a][b][m][n] = (f32x4){0.f, 0.f, 0.f, 0.f};
        cur = nxt; cA = nA; cB = nB; ++ui;
        if constexpr (ALIGN_EPI) { if (wr == 1) PG8_BAR; }
    }
    PG8_WAIT_V(0);
    if constexpr (!ALIGN_EPI) { if (wr == 0) PG8_BAR; }
    PG8_BAR;
    if constexpr (Epi::AFTER_DRAIN) { E.fused(acc, cur, wr, wc, fr, fq, lds, wid, lane); S.done(cur); }
#undef PG8_SA
#undef PG8_SB
#undef PG8_STAGE
#undef PG8_LDA
#undef PG8_LDB
#undef PG8_MMA
#undef PG8_WAIT_V
#undef PG8_WAIT_L
#undef PG8_BAR
#undef PG8_SCHED
}
}

namespace {
#define LAS __attribute__((address_space(3)))
typedef unsigned short bf16_t;
typedef unsigned v4u __attribute__((ext_vector_type(4)));
typedef float f32x4 __attribute__((ext_vector_type(4)));
#define LDS_WAIT() asm volatile("s_waitcnt lgkmcnt(0)" ::: "memory")

__device__ __forceinline__ unsigned f2bf(float f) { unsigned u = __float_as_uint(f); return (u + 0x7fffu + ((u >> 16) & 1u)) >> 16; }
__device__ __forceinline__ unsigned pk2(float lo, float hi) { return f2bf(lo) | (f2bf(hi) << 16); }
__device__ __forceinline__ float bf2f(bf16_t b) { return __uint_as_float(((unsigned)b) << 16); }
__device__ __forceinline__ float sigmoidf_(float x) { return 1.0f / (1.0f + expf(-x)); }
__device__ __forceinline__ float siluf_(float x) { return x / (1.0f + expf(-x)); }
__device__ __forceinline__ float softplusf_(float x) { return x > 20.f ? x : log1pf(expf(x)); }
__device__ __forceinline__ float wave_sum(float v) {
#pragma unroll
    for (int o = 32; o >= 1; o >>= 1) v += __shfl_xor(v, o);
    return v; }
__device__ __forceinline__ float wave_max(float v) {
#pragma unroll
    for (int o = 32; o >= 1; o >>= 1) v = fmaxf(v, __shfl_xor(v, o));
    return v; }

constexpr size_t MiB = 1u << 20;
constexpr size_t WS_CTL = 0, CTL_ZERO_BYTES = 65536;
constexpr size_t WS_MOD = 1 * MiB;
constexpr size_t WS_WTIN = 2 * MiB;
constexpr size_t WS_WTOUT = 10 * MiB;
constexpr size_t WS_X = 12 * MiB;
constexpr size_t WS_UF = 80 * MiB;
constexpr size_t WS_P = 114 * MiB;
constexpr size_t WS_END = 226 * MiB;
constexpr int LDS_BYTES = 147456;

struct Params { const float* in[20]; float* out; unsigned char* ws; };

__device__ __forceinline__ void phase_mods(const float* c, const float* cctx, const float* w_mod, const float* b_mod, float* mod, LAS float* sc, int wid, int lane) {
    for (int item = blockIdx.x; item < DEPTH * 48; item += gridDim.x) {
        const int l = item / 48, n = (item % 48) * 64 + lane;
        float a0 = 0, a1 = 0, a2 = 0, a3 = 0, a4 = 0;
        const float* w = w_mod + (size_t)l * 1024 * 3072 + n;
        for (int k = wid * 128; k < wid * 128 + 128; ++k) {
            const float wv = w[(size_t)k * 3072];
            a0 += siluf_(c[k]) * wv; a1 += siluf_(c[1024 + k]) * wv; a2 += siluf_(c[2048 + k]) * wv; a3 += siluf_(c[3072 + k]) * wv; a4 += siluf_(cctx[k]) * wv;
        }
        sc[(wid * 5 + 0) * 64 + lane] = a0; sc[(wid * 5 + 1) * 64 + lane] = a1; sc[(wid * 5 + 2) * 64 + lane] = a2; sc[(wid * 5 + 3) * 64 + lane] = a3; sc[(wid * 5 + 4) * 64 + lane] = a4;
        __syncthreads();
        if (wid < 5) { float s = 0.f;
#pragma unroll
            for (int w8 = 0; w8 < 8; ++w8) s += sc[(w8 * 5 + wid) * 64 + lane];
            mod[(size_t)(l * 5 + wid) * 3072 + n] = s + b_mod[l * 3072 + n]; }
        __syncthreads();
    }
}
__device__ __forceinline__ void transpose_item(const float* W, int K, int N, int nblk, bf16_t* WT, LAS float* scr, int item, int lane) {
    const int kb = item / nblk, nb = item % nblk, k0 = 64 * kb, n0 = 32 * nb;
    const int nn = n0 + (lane & 31);
#pragma unroll 8
    for (int i = 0; i < 32; ++i) { const int kk = 2 * i + (lane >> 5); scr[kk * 33 + (lane & 31)] = nn < N ? W[(size_t)(k0 + kk) * N + nn] : 0.f; }
    LDS_WAIT();
    const int c = lane & 7;
#pragma unroll
    for (int j = 0; j < 4; ++j) { const int n = (lane >> 3) + 8 * j; const LAS float* s = scr + (8 * c) * 33 + n;
        v4u o; o.x = pk2(s[0 * 33], s[1 * 33]); o.y = pk2(s[2 * 33], s[3 * 33]); o.z = pk2(s[4 * 33], s[5 * 33]); o.w = pk2(s[6 * 33], s[7 * 33]);
        *(v4u*)(WT + (size_t)(n0 + n) * K + k0 + 8 * c) = o; }
    LDS_WAIT();
}
__device__ __forceinline__ void convert_weights(const float* w_in_l, const float* w_out_l, bf16_t* WTIN, bf16_t* WTOUT, LAS float* scr, int gw, int NGW, int lane) {
    constexpr int I_IN = 16 * 105, I_OUT = 16 * 32;
    for (int it = gw; it < I_IN + I_OUT; it += NGW) {
        if (it < I_IN) transpose_item(w_in_l, 1024, DIN, 105, WTIN, scr, it, lane);
        else transpose_item(w_out_l, 1024, 1024, 32, WTOUT, scr, it - I_IN, lane);
    }
}
__device__ __forceinline__ void prep_rows0(const float* x, const float* ctx, const float* modl, bf16_t* U, int gw, int NGW, int lane) {
    for (int t = gw; t < T; t += NGW) {
        const int b = t / SEQT, sp = t - b * SEQT, j = sp < CTX ? 4 : b;
        const float* xs = sp < CTX ? ctx + ((size_t)b * CTX + sp) * D : x + ((size_t)b * SEQ + (sp - CTX)) * D;
        const float* sh = modl + j * 3072; const float* sc = sh + 1024;
#pragma unroll
        for (int q = 0; q < 4; ++q) { const int k = (q * 64 + lane) * 4; const f32x4 v = *(const f32x4*)(xs + k), s1 = *(const f32x4*)(sc + k), s0 = *(const f32x4*)(sh + k);
            const f32x4 u = v * (s1 + 1.0f) + s0; uint2 o; o.x = pk2(u[0], u[1]); o.y = pk2(u[2], u[3]); *(uint2*)(U + (size_t)t * D + k) = o; }
    }
}
__device__ __forceinline__ void ln_rows(float* X, const float* g, const float* bta, float* final_out, const float* modn, bf16_t* U, int gw, int NGW, int lane) {
    for (int t = gw; t < T; t += NGW) {
        const int b = t / SEQT, sp = t - b * SEQT, j = sp < CTX ? 4 : b;
        if (final_out && sp < CTX) continue;
        float* xr = X + (size_t)t * D;
        f32x4 v[4]; float s = 0.f;
#pragma unroll
        for (int q = 0; q < 4; ++q) { v[q] = *(const f32x4*)(xr + (q * 64 + lane) * 4); s += (v[q][0] + v[q][1]) + (v[q][2] + v[q][3]); }
        const float mean = wave_sum(s) * (1.0f / D); float s2 = 0.f;
#pragma unroll
        for (int q = 0; q < 4; ++q) { v[q] = v[q] - mean; s2 += (v[q][0] * v[q][0] + v[q][1] * v[q][1]) + (v[q][2] * v[q][2] + v[q][3] * v[q][3]); }
        const float rstd = rsqrtf(wave_sum(s2) * (1.0f / D) + 1e-5f);
#pragma unroll
        for (int q = 0; q < 4; ++q) { const int k = (q * 64 + lane) * 4; const f32x4 y = v[q] * rstd * *(const f32x4*)(g + k) + *(const f32x4*)(bta + k);
            if (final_out) *(f32x4*)(final_out + ((size_t)b * SEQ + (sp - CTX)) * D + k) = y;
            else { *(f32x4*)(xr + k) = y; const f32x4 u = y * (*(const f32x4*)(modn + j * 3072 + 1024 + k) + 1.0f) + *(const f32x4*)(modn + j * 3072 + k);
                uint2 o; o.x = pk2(u[0], u[1]); o.y = pk2(u[2], u[3]); *(uint2*)(U + (size_t)t * D + k) = o; } }
    }
}

__device__ __forceinline__ float conv_at(const bf16_t* P, const float* cw, int t, int c) {
    const int sp = t % SEQT;
    const int lo = sp < CTX ? 0 : CTX, hi = sp < CTX ? CTX : SEQT;
    float acc = 0.f;
#pragma unroll
    for (int j = 0; j < 4; ++j) { const int s2 = sp + j - 2; if (s2 >= lo && s2 < hi) acc += cw[j * CONV_CH + c] * bf2f(P[(size_t)(t + j - 2) * LDP + c]); }
    return acc;
}
__device__ __forceinline__ int step_to_sp(int step, int d) { return d == 0 ? step : (step < CTX ? CTX - 1 - step : SEQT - 1 - (step - CTX)); }

__device__ __forceinline__ void rg_chain(const bf16_t* P, const float* cw, const float* wa, const float* ba, const float* wx, const float* bx, const float* lam,
                                         bf16_t* Hb, int item, LAS float* us, LAS float* wl, int lane) {
    const int d = item / 24, b = (item % 24) / 6, n = item % 6, ch = n * 64 + lane;
    {   const float* wap = wa + ((size_t)(d * 6 + n) * 64) * 64 + lane;
        const float* wxp = wx + ((size_t)(d * 6 + n) * 64) * 64 + lane;
        for (int dd = 0; dd < 64; ++dd) { wl[dd * 64 + lane] = wap[dd * 64]; wl[4096 + dd * 64 + lane] = wxp[dd * 64]; }
        LDS_WAIT(); }
    const float ls = -log1pf(expf(-lam[d * 384 + ch]));
    const float bav = ba[d * 384 + ch], bxv = bx[d * 384 + ch];
    bf16_t* H = Hb + (size_t)d * T * 384;
    float h = 0.f;
    for (int step = 0; step < SEQT; ++step) {
        const int sp = step_to_sp(step, d), t = b * SEQT + sp;
        const float u = conv_at(P, cw, t, C_XA + ch);
        LDS_WAIT(); us[lane] = u; LDS_WAIT();
        float ra = bav, ri = bxv;
#pragma unroll 8
        for (int dd = 0; dd < 64; ++dd) { const float uu = us[dd]; ra += uu * wl[dd * 64 + lane]; ri += uu * wl[4096 + dd * 64 + lane]; }
        const float r = sigmoidf_(ra), ig = sigmoidf_(ri);
        const float log_a = 8.0f * r * ls;
        h = expf(log_a) * h + sqrtf(-expm1f(2.0f * log_a)) * (ig * u);
        H[(size_t)t * 384 + ch] = (bf16_t)f2bf(h);
    }
}
__device__ __forceinline__ void gdn_chain(const bf16_t* P, const float* cw, const float* alog, const float* dtb, bf16_t* Ob, int item, LAS float* ks, int lane) {
    const int d = item / 16, b = (item % 16) / 4, hh = item % 4;
    LAS float* qs = ks + 64;
    float S[64];
#pragma unroll
    for (int i = 0; i < 64; ++i) S[i] = 0.f;
    const float Aneg = -expf(alog[d * 4 + hh]); const float dtbv = dtb[d * 4 + hh];
    const int half = lane >> 5, i32 = lane & 31, fi = i32 & 15;
    const float invf = expf(-(float)fi * (9.210340371976184f / 16.0f));
    const int partner = i32 < 16 ? lane + 16 : lane - 16;
    bf16_t* O = Ob + (size_t)d * T * 256;
    for (int step = 0; step < SEQT; ++step) {
        const int sp = step_to_sp(step, d), t = b * SEQT + sp;
        float qv = siluf_(conv_at(P, cw, t, C_QG + hh * 64 + lane));
        float kv = siluf_(conv_at(P, cw, t, C_KG + hh * 64 + lane));
        const float vv = siluf_(conv_at(P, cw, t, C_VG + hh * 64 + lane));
        const float qq = wave_sum(qv * qv), kk = wave_sum(kv * kv);
        qv *= rsqrtf(qq + 1e-6f); kv *= rsqrtf(kk + 1e-6f);
        if (sp >= CTX) {
            const int s = sp - CTX; const int pos = half == 0 ? (s >> 6) : (s & 63);
            const float ang = (float)pos * invf; const float cs = cosf(ang), sn = sinf(ang);
            const float qp = __shfl(qv, partner), kp = __shfl(kv, partner);
            if (i32 < 16) { qv = qv * cs - qp * sn; kv = kv * cs - kp * sn; } else { qv = qv * cs + qp * sn; kv = kv * cs + kp * sn; }
        }
        qv *= 0.125f;
        LDS_WAIT(); ks[lane] = kv; qs[lane] = qv; LDS_WAIT();
        const float beta = sigmoidf_(bf2f(P[(size_t)t * LDP + C_BR + d * 4 + hh]));
        const float g = Aneg * softplusf_(bf2f(P[(size_t)t * LDP + C_AR + d * 4 + hh]) + dtbv);
        const float eg = expf(g);
        float kS = 0.f;
#pragma unroll
        for (int i = 0; i < 64; ++i) { kS += ks[i] * S[i]; if ((i & 7) == 7) __builtin_amdgcn_sched_barrier(0); }
        float o = 0.f;
#pragma unroll
        for (int i = 0; i < 64; ++i) { const float bk = beta * ks[i]; S[i] = eg * (S[i] - bk * kS) + bk * vv; o += qs[i] * S[i]; if ((i & 7) == 7) __builtin_amdgcn_sched_barrier(0); }
        O[(size_t)t * 256 + hh * 64 + lane] = (bf16_t)f2bf(o);
    }
}
__device__ __forceinline__ void na_item(const bf16_t* P, const float* rpb, bf16_t* F, int item, LAS float* wl, int lane) {
    LAS float* qsh = wl; LAS float* psh = wl + 64; LAS int* tsh = (LAS int*)(wl + 64 + 384);
    int hh, b, s, t; bool latent;
    if (item < NB * SEQ * 6) { hh = item % 6; const int qi = item / 6; b = qi / SEQ; s = qi % SEQ; t = b * SEQT + CTX + s; latent = true; }
    else { const int w2 = item - NB * SEQ * 6; hh = w2 % 6; const int qi = w2 / 6; b = qi / CTX; s = qi % CTX; t = b * SEQT + s; latent = false; }
    LDS_WAIT();
    qsh[lane] = bf2f(P[(size_t)t * LDP + C_QN + hh * 64 + lane]) * 0.125f;
    LDS_WAIT();
    const int r = s >> 6, jq = s & 63;
    const int r0 = min(max(r - 4, 0), 56), cs0 = min(max(jq - 8, 0), 48);
    float sc[6];
#pragma unroll
    for (int i = 0; i < 6; ++i) {
        const int kk = lane + 64 * i;
        int tk = -1; float bias = 0.f;
        if (latent) {
            if (i < 2) { const int wr = kk >> 4, m = kk & 15; const int kr = r0 + wr, kc = cs0 + m; tk = b * SEQT + CTX + kr * 64 + kc; bias = rpb[(hh * 15 + (kr - r + 7)) * 31 + (kc - jq + 15)]; }
            else tk = b * SEQT + (kk - 128);
        } else if (i < 4) tk = b * SEQT + kk;
        float dot = -INFINITY;
        if (tk >= 0) {
            const uint4* kp = (const uint4*)(P + (size_t)tk * LDP + C_KN + hh * 64);
            float acc = 0.f;
#pragma unroll
            for (int c8 = 0; c8 < 8; ++c8) {
                const uint4 kv = kp[c8]; const unsigned kw[4] = {kv.x, kv.y, kv.z, kv.w};
#pragma unroll
                for (int q = 0; q < 4; ++q) { acc += qsh[c8 * 8 + 2 * q] * __uint_as_float(kw[q] << 16); acc += qsh[c8 * 8 + 2 * q + 1] * __uint_as_float(kw[q] & 0xffff0000u); }
            }
            dot = acc + bias;
        }
        sc[i] = dot; tsh[kk] = tk;
    }
    float m = sc[0];
#pragma unroll
    for (int i = 1; i < 6; ++i) m = fmaxf(m, sc[i]);
    m = wave_max(m);
    float sum = 0.f;
#pragma unroll
    for (int i = 0; i < 6; ++i) { sc[i] = expf(sc[i] - m); sum += sc[i]; }
    sum = wave_sum(sum);
    const float inv = 1.0f / sum;
#pragma unroll
    for (int i = 0; i < 6; ++i) psh[lane + 64 * i] = sc[i] * inv;
    LDS_WAIT();
    const int nk = latent ? 384 : 256;
    float o = 0.f;
    for (int kk = 0; kk < nk; ++kk) o += psh[kk] * bf2f(P[(size_t)tsh[kk] * LDP + C_VN + hh * 64 + lane]);
    const float zn = bf2f(P[(size_t)t * LDP + C_ZN + hh * 64 + lane]);
    F[(size_t)t * 1024 + 384 + hh * 64 + lane] = (bf16_t)f2bf(o * siluf_(zn));
}
__device__ __forceinline__ void combine_rows(const bf16_t* P, const bf16_t* Hb, const bf16_t* Ob, const float* nw, bf16_t* F, int gw, int NGW, int lane) {
    for (int t = gw; t < T; t += NGW) {
#pragma unroll
        for (int i = 0; i < 6; ++i) { const int ch = i * 64 + lane;
            const float hs = bf2f(Hb[(size_t)t * 384 + ch]) + bf2f(Hb[(size_t)T * 384 + (size_t)t * 384 + ch]);
            F[(size_t)t * 1024 + ch] = (bf16_t)f2bf(hs * siluf_(bf2f(P[(size_t)t * LDP + C_ZA + ch]))); }
#pragma unroll
        for (int hh = 0; hh < 4; ++hh) { const int c = hh * 64 + lane;
            const float o = bf2f(Ob[(size_t)t * 256 + c]) + bf2f(Ob[(size_t)T * 256 + (size_t)t * 256 + c]);
            const float ms = wave_sum(o * o) * (1.0f / 64.0f);
            F[(size_t)t * 1024 + 768 + c] = (bf16_t)f2bf(o * rsqrtf(ms + 1e-6f) * nw[lane] * siluf_(bf2f(P[(size_t)t * LDP + C_ZG + c]))); }
    }
}

__device__ __forceinline__ int opq(int i) { asm volatile("" : "+s"(i)); return i; }
#define IN(i) (p.in[opq(i)])
__device__ __forceinline__ int fresh_v(int v) { asm volatile("" : "+v"(v)); return v; }
enum { I_X = 0, I_C, I_CTX, I_CCTX, I_WMOD, I_BMOD, I_WIN, I_CONVW, I_RGWA, I_RGBA, I_RGWX, I_RGBX, I_RGLAM, I_RPB, I_ALOG, I_DTB, I_NW, I_WOUT, I_LNG, I_LNB };
__global__ void __launch_bounds__(512, 2) mega_fwd(Params p) {
    extern __shared__ __attribute__((aligned(16))) unsigned char lds_raw[];
    LAS unsigned char* lds = (LAS unsigned char*)lds_raw;
    cg::grid_group grid = cg::this_grid();
    const int tid = threadIdx.x, lane0 = tid & 63, wid = __builtin_amdgcn_readfirstlane(tid >> 6);
    const int gw0 = blockIdx.x * 8 + wid, NGW = gridDim.x * 8;
    const int lane = lane0, gw = gw0;
    unsigned char* ws = p.ws;
    unsigned* ctl = (unsigned*)(ws + WS_CTL);
    float* mod = (float*)(ws + WS_MOD); bf16_t* WTIN = (bf16_t*)(ws + WS_WTIN); bf16_t* WTOUT = (bf16_t*)(ws + WS_WTOUT);
    float* X = (float*)(ws + WS_X); bf16_t* UF = (bf16_t*)(ws + WS_UF); bf16_t* P = (bf16_t*)(ws + WS_P);
    bf16_t* Hb = (bf16_t*)p.out;
    bf16_t* Ob = Hb + (size_t)2 * T * 384;
    LAS float* wscr = (LAS float*)(lds + wid * 16384);

    phase_mods(IN(I_C), IN(I_CCTX), IN(I_WMOD), IN(I_BMOD), mod, (LAS float*)lds, wid, lane);
    convert_weights(IN(I_WIN), IN(I_WOUT), WTIN, WTOUT, wscr, gw, NGW, lane);
    grid.sync();
    prep_rows0(IN(I_X), IN(I_CTX), mod, UF, gw, NGW, lane);
    grid.sync();
#pragma unroll 1
    for (int l = 0; l < DEPTH; ++l) {
        const float* modl = mod + (size_t)l * 5 * 3072;
        { pg8::Gemm g{UF, WTIN, T, NPAD, D}; pg8::StaticOrder S; S.init(T, NPAD, (int)gridDim.x, (int)blockIdx.x);
          pg8::EpiP E{P};
#ifndef ABL_G1
          pg8::gemm_phase<pg8::EpiP, pg8::StaticOrder, true, true>(lds, g, S, E);
#endif
        }
        grid.sync();
        { const int lane = fresh_v(lane0); LAS float* nscr = (LAS float*)(lds + wid * 4096);
#ifndef ABL_RG
            if (wid == 0 && blockIdx.x < 48)
                rg_chain(P, IN(I_CONVW) + (size_t)l * 4 * CONV_CH, IN(I_RGWA) + (size_t)l * 2 * 6 * 64 * 64, IN(I_RGBA) + (size_t)l * 2 * 384, IN(I_RGWX) + (size_t)l * 2 * 6 * 64 * 64, IN(I_RGBX) + (size_t)l * 2 * 384,
                         IN(I_RGLAM) + (size_t)l * 2 * 384, Hb, (int)blockIdx.x, nscr, (LAS float*)(lds + 32768), lane);
#endif
#ifndef ABL_GDN
            if (wid == 0 && blockIdx.x >= 48 && blockIdx.x < 80)
                gdn_chain(P, IN(I_CONVW) + (size_t)l * 4 * CONV_CH, IN(I_ALOG) + l * 8, IN(I_DTB) + l * 8, Ob, (int)blockIdx.x - 48, nscr, lane);
#endif
            const int n_items = NB * SEQ * 6 + (l < DEPTH - 1 ? NB * CTX * 6 : 0);
            unsigned* cnt = ctl + 64 * (l + 1);
            const float* rpb = IN(I_RPB) + (size_t)l * 6 * 15 * 31;
            for (;;) {
                int base = 0;
                if (lane == 0) base = (int)__hip_atomic_fetch_add(cnt, 16u, __ATOMIC_RELAXED, __HIP_MEMORY_SCOPE_AGENT);
                base = __builtin_amdgcn_readfirstlane(base);
                if (base >= n_items) break;
                for (int it = base; it < base + 16 && it < n_items; ++it) na_item(P, rpb, UF, it, nscr, lane);
            }
        }
        grid.sync();
        { const int lane = fresh_v(lane0); const int gw = opq(gw0); combine_rows(P, Hb, Ob, IN(I_NW) + l * 64, UF, gw, NGW, lane); }
        grid.sync();
        { pg8::Gemm g{UF, WTOUT, T, D, D}; pg8::StaticOrder S; S.init(T, D, (int)gridDim.x, (int)blockIdx.x);
          pg8::EpiZ E{IN(I_X), IN(I_CTX), X, modl, l == 0 ? 1 : 0};
#ifndef ABL_G2
          pg8::gemm_phase<pg8::EpiZ, pg8::StaticOrder, true, true>(lds, g, S, E);
#endif
        }
        grid.sync();
        if (l < DEPTH - 1) { const int lane = fresh_v(lane0); const int gw = opq(gw0);
            ln_rows(X, IN(I_LNG) + l * D, IN(I_LNB) + l * D, nullptr, mod + (size_t)(l + 1) * 5 * 3072, UF, gw, NGW, lane);
            convert_weights(IN(I_WIN) + (size_t)(l + 1) * D * DIN, IN(I_WOUT) + (size_t)(l + 1) * D * D, WTIN, WTOUT, wscr, gw, NGW, lane);
            grid.sync();
        } else { const int lane = fresh_v(lane0); const int gw = opq(gw0); ln_rows(X, IN(I_LNG) + l * D, IN(I_LNB) + l * D, p.out, nullptr, nullptr, gw, NGW, lane); }
    }
}
}

extern "C" void kernel_launch(void* const* d_in, const int* in_sizes, int n_in, void* d_out, int out_size, void* d_ws, size_t ws_size, hipStream_t stream) {
    static int grid = 0;
    if (grid == 0) {
        if (n_in != 20 || ws_size < WS_END) { fprintf(stderr, "kernel_launch: unexpected n_in %d / ws_size %zu\n", n_in, ws_size); grid = -1; return; }
        int dev = 0, cus = 0, per_cu = 0;
        hipGetDevice(&dev);
        hipDeviceGetAttribute(&cus, hipDeviceAttributeMultiprocessorCount, dev);
        if (hipFuncSetAttribute((const void*)mega_fwd, hipFuncAttributeMaxDynamicSharedMemorySize, LDS_BYTES) != hipSuccess) { fprintf(stderr, "kernel_launch: hipFuncSetAttribute failed\n"); grid = -1; return; }
        if (hipOccupancyMaxActiveBlocksPerMultiprocessor(&per_cu, (const void*)mega_fwd, 512, LDS_BYTES) != hipSuccess || per_cu < 1) { fprintf(stderr, "kernel_launch: occupancy query gave %d\n", per_cu); per_cu = 1; }
        (void)hipGetLastError();
        grid = cus * 1;
        fprintf(stderr, "kernel_launch: cus %d per_cu %d grid %d\n", cus, per_cu, grid);
    }
    if (grid < 0) return;
    hipMemsetAsync((char*)d_ws + WS_CTL, 0, CTL_ZERO_BYTES, stream);
    Params prm{};
    for (int i = 0; i < 20; ++i) prm.in[i] = (const float*)d_in[i];
    prm.out = (float*)d_out; prm.ws = (unsigned char*)d_ws;
    void* args[] = {&prm};
    hipError_t e = hipLaunchCooperativeKernel((const void*)mega_fwd, dim3(grid), dim3(512), args, LDS_BYTES, stream);
    if (e != hipSuccess) fprintf(stderr, "cooperative launch failed: %s (grid %d)\n", hipGetErrorString(e), grid);
}
```

```cpp
#include <hip/hip_runtime.h>
#include <hip/hip_cooperative_groups.h>
#include <cstdio>
#include <cstdint>
namespace cg = cooperative_groups;

namespace {
constexpr int D = 1024, NB = 4, SEQ = 4096, DEPTH = 4, CTX = 256;
constexpr int SEQT = CTX + SEQ;
constexpr int T = NB * SEQT;
constexpr int DIN = 3344, LDP = 3360, NPAD = 3584;
constexpr int CONV_CH = 1152;
constexpr int C_XA = 0, C_QG = 384, C_KG = 640, C_VG = 896, C_ZA = 1152, C_QN = 1536, C_KN = 1920, C_VN = 2304,
              C_ZN = 2688, C_ZG = 3072, C_BR = 3328, C_AR = 3336;
constexpr float ALPHA = 1.681792830507429f;
}
namespace pg8 {
#define PG8_LAS __attribute__((address_space(3)))
typedef unsigned short bf16_t;
typedef short bf16x8 __attribute__((ext_vector_type(8)));
typedef float f32x4 __attribute__((ext_vector_type(4)));
typedef unsigned u32x4 __attribute__((ext_vector_type(4)));
constexpr int BM = 256, BK = 64, HALF = 128, HTB = HALF * BK * 2  , STAGE_BYTES = 8 * HTB, NXCD = 8, WGM = 8;

__host__ __device__ __forceinline__ int lds_byte(int r, int c) { const int st = (r >> 4) * 2 + (c >> 5), rr = r & 15, cc = c & 31, ob = rr * 64 + cc * 2; return st * 1024 + (ob ^ (((ob >> 9) & 1) << 5)); }
__host__ __device__ __forceinline__ void stage_rc(int b, int& R, int& C) { const int st = b / 1024, sb = b % 1024, swz = sb ^ (((sb >> 9) & 1) << 5); R = (st >> 1) * 16 + swz / 64; C = (st & 1) * 32 + (swz % 64) / 2; }
__host__ __device__ __forceinline__ int perm32(int rho) { const int n = rho >> 4, i = rho & 15; return 8 * (i >> 2) + 4 * n + (i & 3); }

struct Unit { int pm, pn; };
struct Gemm { const bf16_t* A; const bf16_t* Bt; int M, N, K; };

struct StaticOrder {
    int nM, nN, nwg, G, c;
    __host__ __device__ void init(int M, int N, int G_, int c_) { nM = M / BM; nN = N / BM; nwg = nM * nN; G = G_; c = c_; }
    __host__ __device__ bool next(int i, Unit& u) const {
        const long L = (long)i * G + c; if (L >= nwg) return false;
        int wgid = (int)L; { const int q = nwg / NXCD, r = nwg % NXCD, xcd = wgid % NXCD, off = wgid / NXCD; wgid = (xcd < r ? xcd * (q + 1) : r * (q + 1) + (xcd - r) * q) + off; }
        const int nig = WGM * nN, gid = wgid / nig, fm = gid * WGM, gsz = (nM - fm) < WGM ? (nM - fm) : WGM;
        u.pm = fm + ((wgid % nig) % gsz); u.pn = (wgid % nig) / gsz; return true;
    }
    __device__ __forceinline__ void a_ready(const Unit&) const {}
    __device__ __forceinline__ void done(const Unit&) const {}
};

typedef __bf16 bf16v2 __attribute__((ext_vector_type(2)));
typedef float f32v2 __attribute__((ext_vector_type(2)));
__device__ __forceinline__ unsigned cvt_pk_bf16(float lo, float hi) { const f32v2 v = {lo, hi}; return __builtin_bit_cast(unsigned, __builtin_convertvector(v, bf16v2)); }
struct EpiP {
    static constexpr bool PERM = true, AFTER_DRAIN = false;
    bf16_t* P;
    __device__ __forceinline__ void operator()(const f32x4 (&acc)[2][2][4][2], const Unit& u, int wr, int wc, int fr, int fq) const {
        asm volatile("" : "+v"(fr), "+v"(fq));
        const int row0 = u.pm * BM + wr * 64 + fr, col0 = u.pn * BM + wc * 32 + 8 * fq;
#pragma unroll
        for (int ai = 0; ai < 2; ++ai)
#pragma unroll
            for (int m = 0; m < 4; ++m) { bf16_t* rowp = P + (size_t)(row0 + ai * HALF + m * 16) * LDP + col0;
#pragma unroll
                for (int bj = 0; bj < 2; ++bj) { if (col0 + bj * HALF < LDP) { const f32x4 v0 = acc[ai][bj][m][0], v1 = acc[ai][bj][m][1];
                    u32x4 w; w.x = cvt_pk_bf16(v0[0], v0[1]); w.y = cvt_pk_bf16(v0[2], v0[3]); w.z = cvt_pk_bf16(v1[0], v1[1]); w.w = cvt_pk_bf16(v1[2], v1[3]);
                    *(u32x4*)(rowp + bj * HALF) = w; } } }
    }
};
struct EpiZ {
    static constexpr bool PERM = false, AFTER_DRAIN = false;
    const float* x_in; const float* ctx_in; float* X; const float* modl; int layer0;
    __device__ __forceinline__ void operator()(const f32x4 (&acc)[2][2][4][2], const Unit& u, int wr, int wc, int fr, int fq) const {
        asm volatile("" : "+v"(fr), "+v"(fq));
        const int row0 = u.pm * BM + wr * 64 + fr, col0 = u.pn * BM + wc * 32 + 4 * fq;
#pragma unroll
        for (int ai = 0; ai < 2; ++ai)
#pragma unroll
            for (int m = 0; m < 4; ++m) { const int r = row0 + ai * HALF + m * 16; const int b = r / SEQT, sp = r - b * SEQT; const int j = sp < CTX ? 4 : b;
                const float* xs = layer0 ? (sp < CTX ? ctx_in + ((size_t)b * CTX + sp) * D : x_in + ((size_t)b * SEQ + (sp - CTX)) * D) : X + (size_t)r * D;
                float* zo = X + (size_t)r * D; const float* gp = modl + j * 3072 + 2048;
#pragma unroll
                for (int bj = 0; bj < 2; ++bj)
#pragma unroll
                    for (int n = 0; n < 2; ++n) { const int c = col0 + bj * HALF + n * 16; const f32x4 xv = *(const f32x4*)(xs + c), gv = *(const f32x4*)(gp + c);
                        *(f32x4*)(zo + c) = xv * ALPHA + gv * acc[ai][bj][m][n]; } }
    }
};

template <class Epi, class Sched, bool ALIGN_EPI = false, bool SP2 = false>
__device__ __forceinline__ void gemm_phase(PG8_LAS unsigned char* lds, const Gemm g, const Sched& S, const Epi& E) {
    int tid_ = threadIdx.x; asm volatile("" : "+v"(tid_));
    const int tid = tid_, wid = __builtin_amdgcn_readfirstlane(tid >> 6), lane = tid & 63, wr = wid >> 2, wc = wid & 3, fr = lane & 15, fq = lane >> 4;
    const int K = g.K, nt = K / BK;
    unsigned voffA[2], voffB[2];
#pragma unroll
    for (int i = 0; i < 2; ++i) { int R, C; stage_rc(tid * 16 + i * 8192, R, C); const int Rb = Epi::PERM ? ((R & ~31) + perm32(R & 31)) : R;
        voffA[i] = (unsigned)(R * K + C) * 2u; voffB[i] = (unsigned)(Rb * K + C) * 2u; }
    const size_t kstep = (size_t)(BK * 2);
    const size_t hstep = (size_t)HALF * K * 2;
    const size_t tstep = 2 * hstep;
    const unsigned ldsw = (unsigned)wid * 1024u;
    const int aoff = lds_byte(wr * 64 + fr, fq * 8), boff = lds_byte(wc * 32 + fr, fq * 8);
#define PG8_SA(b, h) (((b) * 2 + (h)) * HTB)
#define PG8_SB(b, h) ((4 + (b) * 2 + (h)) * HTB)
#define PG8_STAGE(bufoff, gbase, voff) do { _Pragma("unroll") for (int _i = 0; _i < 2; ++_i) \
        __builtin_amdgcn_global_load_lds((const unsigned*)((const char*)(gbase) + (voff)[_i]), (PG8_LAS unsigned*)(lds + (bufoff) + ldsw + _i * 8192), 16, 0, 0); } while (0)
#define PG8_LDA(dst, b, h) do { _Pragma("unroll") for (int m = 0; m < 4; ++m) _Pragma("unroll") for (int k = 0; k < 2; ++k) dst[m][k] = *(const PG8_LAS bf16x8*)(lds + PG8_SA(b, h) + aoff + m * 2048 + k * 1024); } while (0)
#define PG8_LDB(dst, b, h) do { _Pragma("unroll") for (int n = 0; n < 2; ++n) _Pragma("unroll") for (int k = 0; k < 2; ++k) dst[n][k] = *(const PG8_LAS bf16x8*)(lds + PG8_SB(b, h) + boff + n * 2048 + k * 1024); } while (0)
#define PG8_MMA(ai, bj, At, Bt) do { __builtin_amdgcn_s_setprio(1); _Pragma("unroll") for (int m = 0; m < 4; ++m) _Pragma("unroll") for (int n = 0; n < 2; ++n) _Pragma("unroll") for (int k = 0; k < 2; ++k) \
        acc[ai][bj][m][n] = __builtin_amdgcn_mfma_f32_16x16x32_bf16(Bt[n][k], At[m][k], acc[ai][bj][m][n], 0, 0, 0); __builtin_amdgcn_s_setprio(0); } while (0)
#define PG8_WAIT_V(n) asm volatile("s_waitcnt vmcnt(" #n ")" ::: "memory")
#define PG8_WAIT_L(n) asm volatile("s_waitcnt lgkmcnt(" #n ")" ::: "memory")
#define PG8_BAR __builtin_amdgcn_s_barrier()
#define PG8_SCHED __builtin_amdgcn_sched_barrier(0)
    Unit cur, nxt; int ui = 0;
    if (!S.next(0, cur)) return;
    f32x4 acc[2][2][4][2];
#pragma unroll
    for (int a = 0; a < 2; ++a)
#pragma unroll
        for (int b = 0; b < 2; ++b)
#pragma unroll
            for (int m = 0; m < 4; ++m)
#pragma unroll
                for (int n = 0; n < 2; ++n) acc[a][b][m][n] = (f32x4){0.f, 0.f, 0.f, 0.f};
    bf16x8 At[4][2], B0[2][2], B1[2][2];
    const char* cA = (const char*)g.A + (size_t)cur.pm * tstep; const char* cB = (const char*)g.Bt + (size_t)cur.pn * tstep;
    S.a_ready(cur);
    if constexpr (SP2) {
        PG8_STAGE(PG8_SB(0, 0), cB, voffB); PG8_STAGE(PG8_SB(0, 1), cB + hstep, voffB); PG8_STAGE(PG8_SA(0, 0), cA, voffA); PG8_STAGE(PG8_SA(0, 1), cA + hstep, voffA);
        if (wr == 1) PG8_BAR;
        PG8_WAIT_V(2); PG8_BAR;
        PG8_STAGE(PG8_SB(1, 0), cB + kstep, voffB); PG8_STAGE(PG8_SA(1, 0), cA + kstep, voffA); PG8_STAGE(PG8_SB(1, 1), cB + hstep + kstep, voffB);
        PG8_WAIT_V(6); PG8_BAR;
    } else {
        PG8_STAGE(PG8_SB(0, 0), cB, voffB); PG8_STAGE(PG8_SA(0, 0), cA, voffA); PG8_STAGE(PG8_SB(0, 1), cB + hstep, voffB); PG8_STAGE(PG8_SA(0, 1), cA + hstep, voffA);
        if (wr == 1) PG8_BAR;
        PG8_WAIT_V(4); PG8_BAR;
        PG8_STAGE(PG8_SB(1, 0), cB + kstep, voffB); PG8_STAGE(PG8_SA(1, 0), cA + kstep, voffA); PG8_STAGE(PG8_SB(1, 1), cB + hstep + kstep, voffB);
        PG8_WAIT_V(6); PG8_BAR;
    }
    for (;;) {
        const bool has_next = S.next(ui + 1, nxt);
        const char* nA = has_next ? (const char*)g.A + (size_t)nxt.pm * tstep : cA; const char* nB = has_next ? (const char*)g.Bt + (size_t)nxt.pn * tstep : cB;
        for (int t = 0; t < nt; t += 2) {
            const bool last = (t == nt - 2);
            const char* a1 = cA + (size_t)(t + 1) * kstep;
            const char* a2 = last ? nA : cA + (size_t)(t + 2) * kstep; const char* b2 = last ? nB : cB + (size_t)(t + 2) * kstep;
            const char* a3 = a2 + kstep; const char* b3 = b2 + kstep;
            if (last && has_next) S.a_ready(nxt);
            if constexpr (SP2) {
            PG8_LDB(B0, 0, 0); PG8_LDB(B1, 0, 1); PG8_SCHED; PG8_LDA(At, 0, 0); PG8_STAGE(PG8_SA(1, 1), a1 + hstep, voffA);
            PG8_WAIT_V(8); PG8_WAIT_L(0); PG8_BAR; PG8_MMA(0, 0, At, B0); PG8_MMA(0, 1, At, B1); PG8_BAR; PG8_SCHED;
            PG8_LDA(At, 0, 1); PG8_STAGE(PG8_SB(0, 0), b2, voffB); PG8_STAGE(PG8_SB(0, 1), b2 + hstep, voffB); PG8_STAGE(PG8_SA(0, 0), a2, voffA);
            PG8_WAIT_V(8); PG8_WAIT_L(0); PG8_BAR; PG8_MMA(1, 0, At, B0); PG8_MMA(1, 1, At, B1); PG8_BAR; PG8_SCHED;
            PG8_LDB(B0, 1, 0); PG8_LDB(B1, 1, 1); PG8_SCHED; PG8_LDA(At, 1, 0); PG8_STAGE(PG8_SA(0, 1), a2 + hstep, voffA);
            PG8_WAIT_V(8); PG8_WAIT_L(0); PG8_BAR; PG8_MMA(0, 0, At, B0); PG8_MMA(0, 1, At, B1); PG8_BAR; PG8_SCHED;
            PG8_LDA(At, 1, 1); PG8_STAGE(PG8_SB(1, 0), b3, voffB); PG8_STAGE(PG8_SB(1, 1), b3 + hstep, voffB); PG8_STAGE(PG8_SA(1, 0), a3, voffA);
            PG8_WAIT_V(8); PG8_WAIT_L(0); PG8_BAR; PG8_MMA(1, 0, At, B0); PG8_MMA(1, 1, At, B1); PG8_BAR; PG8_SCHED;
            } else {
            PG8_LDB(B0, 0, 0); PG8_SCHED; PG8_LDA(At, 0, 0); PG8_STAGE(PG8_SA(1, 1), a1 + hstep, voffA);
            PG8_WAIT_L(8); PG8_BAR; PG8_WAIT_L(0); PG8_MMA(0, 0, At, B0); PG8_BAR; PG8_SCHED;
            PG8_LDB(B1, 0, 1); PG8_STAGE(PG8_SB(0, 0), b2, voffB);
            PG8_BAR; PG8_WAIT_L(0); PG8_MMA(0, 1, At, B1); PG8_BAR;
            PG8_LDA(At, 0, 1); PG8_STAGE(PG8_SA(0, 0), a2, voffA);
            PG8_BAR; PG8_WAIT_L(0); PG8_MMA(1, 0, At, B0); PG8_BAR; PG8_SCHED;
            PG8_STAGE(PG8_SB(0, 1), b2 + hstep, voffB);
            PG8_WAIT_V(6); PG8_BAR; PG8_MMA(1, 1, At, B1); PG8_BAR;
            PG8_LDB(B0, 1, 0); PG8_SCHED; PG8_LDA(At, 1, 0); PG8_STAGE(PG8_SA(0, 1), a2 + hstep, voffA);
            PG8_WAIT_L(8); PG8_BAR; PG8_WAIT_L(0); PG8_MMA(0, 0, At, B0); PG8_BAR; PG8_SCHED;
            PG8_LDB(B1, 1, 1); PG8_STAGE(PG8_SB(1, 0), b3, voffB);
            PG8_BAR; PG8_WAIT_L(0); PG8_MMA(0, 1, At, B1); PG8_BAR;
            PG8_LDA(At, 1, 1); PG8_STAGE(PG8_SA(1, 0), a3, voffA);
            PG8_BAR; PG8_WAIT_L(0); PG8_MMA(1, 0, At, B0); PG8_BAR; PG8_SCHED;
            PG8_STAGE(PG8_SB(1, 1), b3 + hstep, voffB);
            PG8_WAIT_V(6); PG8_BAR; PG8_MMA(1, 1, At, B1); PG8_BAR;
            }
        }
        if constexpr (ALIGN_EPI) { if (wr == 0) PG8_BAR; }
        if constexpr (!Epi::AFTER_DRAIN) { E(acc, cur, wr, wc, fr, fq); S.done(cur); }
        if (!has_next) break;
#pragma unroll
        for (int a = 0; a < 2; ++a)
#pragma unroll
            for (int b = 0; b < 2; ++b)
#pragma unroll
                for (int m = 0; m < 4; ++m)
#pragma unroll
                    for (int n = 0; n < 2; ++n) acc[a][b][m][n] = (f32x4){0.f, 0.f, 0.f, 0.f};
        cur = nxt; cA = nA; cB = nB; ++ui;
        if constexpr (ALIGN_EPI) { if (wr == 1) PG8_BAR; }
    }
    PG8_WAIT_V(0);
    if constexpr (!ALIGN_EPI) { if (wr == 0) PG8_BAR; }
    PG8_BAR;
    if constexpr (Epi::AFTER_DRAIN) { E.fused(acc, cur, wr, wc, fr, fq, lds, wid, lane); S.done(cur); }
#undef PG8_SA
#undef PG8_SB
#undef PG8_STAGE
#undef PG8_LDA
#undef PG8_LDB
#undef PG8_MMA
#undef PG8_WAIT_V
#undef PG8_WAIT_L
#undef PG8_BAR
#undef PG8_SCHED
}
}

namespace {
#define LAS __attribute__((address_space(3)))
typedef unsigned short bf16_t;
typedef unsigned v4u __attribute__((ext_vector_type(4)));
typedef float f32x4 __attribute__((ext_vector_type(4)));
#define LDS_WAIT() asm volatile("s_waitcnt lgkmcnt(0)" ::: "memory")

__device__ __forceinline__ unsigned f2bf(float f) { unsigned u = __float_as_uint(f); return (u + 0x7fffu + ((u >> 16) & 1u)) >> 16; }
__device__ __forceinline__ unsigned pk2(float lo, float hi) { return f2bf(lo) | (f2bf(hi) << 16); }
__device__ __forceinline__ float bf2f(bf16_t b) { return __uint_as_float(((unsigned)b) << 16); }
__device__ __forceinline__ float sigmoidf_(float x) { return 1.0f / (1.0f + expf(-x)); }
__device__ __forceinline__ float siluf_(float x) { return x / (1.0f + expf(-x)); }
__device__ __forceinline__ float softplusf_(float x) { return x > 20.f ? x : log1pf(expf(x)); }
__device__ __forceinline__ float wave_sum(float v) {
#pragma unroll
    for (int o = 32; o >= 1; o >>= 1) v += __shfl_xor(v, o);
    return v; }
__device__ __forceinline__ float wave_max(float v) {
#pragma unroll
    for (int o = 32; o >= 1; o >>= 1) v = fmaxf(v, __shfl_xor(v, o));
    return v; }

constexpr size_t MiB = 1u << 20;
constexpr size_t WS_CTL = 0, CTL_ZERO_BYTES = 65536;
constexpr size_t WS_MOD = 1 * MiB;
constexpr size_t WS_WTIN = 2 * MiB;
constexpr size_t WS_WTOUT = 10 * MiB;
constexpr size_t WS_X = 12 * MiB;
constexpr size_t WS_UF = 80 * MiB;
constexpr size_t WS_P = 114 * MiB;
constexpr size_t WS_GDNX = 226 * MiB;
constexpr size_t WS_OB = 230 * MiB;
constexpr size_t WS_RGS = 247 * MiB;
constexpr size_t WS_END = 250 * MiB;
constexpr size_t WS_RGWT = 1 * MiB + 576 * 1024;
constexpr size_t WS_RGTAB = 1 * MiB + 768 * 1024;
constexpr size_t WS_ROPE = 1 * MiB + 512 * 1024;
constexpr int LDS_BYTES = 147456;

struct Params { const void* ptr[22]; };

__device__ __forceinline__ void phase_mods(const float* c, const float* cctx, const float* w_mod, const float* b_mod, float* mod, LAS float* sc, int wid, int lane) {
    for (int item = blockIdx.x; item < DEPTH * 48; item += gridDim.x) {
        const int l = item / 48, n = (item % 48) * 64 + lane;
        float a0 = 0, a1 = 0, a2 = 0, a3 = 0, a4 = 0;
        const float* w = w_mod + (size_t)l * 1024 * 3072 + n;
        for (int k = wid * 128; k < wid * 128 + 128; ++k) {
            const float wv = w[(size_t)k * 3072];
            a0 += siluf_(c[k]) * wv; a1 += siluf_(c[1024 + k]) * wv; a2 += siluf_(c[2048 + k]) * wv; a3 += siluf_(c[3072 + k]) * wv; a4 += siluf_(cctx[k]) * wv;
        }
        sc[(wid * 5 + 0) * 64 + lane] = a0; sc[(wid * 5 + 1) * 64 + lane] = a1; sc[(wid * 5 + 2) * 64 + lane] = a2; sc[(wid * 5 + 3) * 64 + lane] = a3; sc[(wid * 5 + 4) * 64 + lane] = a4;
        __syncthreads();
        if (wid < 5) { float s = 0.f;
#pragma unroll
            for (int w8 = 0; w8 < 8; ++w8) s += sc[(w8 * 5 + wid) * 64 + lane];
            mod[(size_t)(l * 5 + wid) * 3072 + n] = s + b_mod[l * 3072 + n]; }
        __syncthreads();
    }
}
__device__ __forceinline__ void transpose_item(const float* W, int K, int N, int nblk, bf16_t* WT, LAS float* scr, int item, int lane) {
    const int kb = item / nblk, nb = item % nblk, k0 = 64 * kb, n0 = 32 * nb;
    const int nn = n0 + (lane & 31);
#pragma unroll 8
    for (int i = 0; i < 32; ++i) { const int kk = 2 * i + (lane >> 5); scr[kk * 33 + (lane & 31)] = nn < N ? W[(size_t)(k0 + kk) * N + nn] : 0.f; }
    LDS_WAIT();
    const int c = lane & 7;
#pragma unroll
    for (int j = 0; j < 4; ++j) { const int n = (lane >> 3) + 8 * j; const LAS float* s = scr + (8 * c) * 33 + n;
        v4u o; o.x = pk2(s[0 * 33], s[1 * 33]); o.y = pk2(s[2 * 33], s[3 * 33]); o.z = pk2(s[4 * 33], s[5 * 33]); o.w = pk2(s[6 * 33], s[7 * 33]);
        *(v4u*)(WT + (size_t)(n0 + n) * K + k0 + 8 * c) = o; }
    LDS_WAIT();
}
__device__ __forceinline__ void convert_weights(const float* w_in_l, const float* w_out_l, bf16_t* WTIN, bf16_t* WTOUT, LAS float* scr, int gw, int NGW, int lane) {
    constexpr int I_IN = 16 * 105, I_OUT = 16 * 32;
    for (int it = gw; it < I_IN + I_OUT; it += NGW) {
        if (it < I_IN) transpose_item(w_in_l, 1024, DIN, 105, WTIN, scr, it, lane);
        else transpose_item(w_out_l, 1024, 1024, 32, WTOUT, scr, it - I_IN, lane);
    }
}
__device__ __forceinline__ void convert_rg(const float* wa, const float* ba, const float* wx, const float* bx, const float* lam, bf16_t* RGWT, float* rgtab, int gtid, int ngt) {
    for (int idx = gtid; idx < 24 * 4096 + 768; idx += ngt) {
        if (idx < 24 * 4096) { const int dd = idx & 63, e = (idx >> 6) & 63, m = idx >> 12, kind = m & 1, dn = m >> 1;
            RGWT[idx] = (bf16_t)f2bf((kind ? wx : wa)[((size_t)dn * 64 + dd) * 64 + e]); }
        else { const int k = idx - 24 * 4096; rgtab[k] = ba[k]; rgtab[768 + k] = bx[k]; rgtab[1536 + k] = -8.0f * log1pf(expf(-lam[k])); }
    }
}
__device__ __forceinline__ void prep_rows0(const float* x, const float* ctx, const float* modl, bf16_t* U, int gw, int NGW, int lane) {
    for (int t = gw; t < T; t += NGW) {
        const int b = t / SEQT, sp = t - b * SEQT, j = sp < CTX ? 4 : b;
        const float* xs = sp < CTX ? ctx + ((size_t)b * CTX + sp) * D : x + ((size_t)b * SEQ + (sp - CTX)) * D;
        const float* sh = modl + j * 3072; const float* sc = sh + 1024;
#pragma unroll
        for (int q = 0; q < 4; ++q) { const int k = (q * 64 + lane) * 4; const f32x4 v = *(const f32x4*)(xs + k), s1 = *(const f32x4*)(sc + k), s0 = *(const f32x4*)(sh + k);
            const f32x4 u = v * (s1 + 1.0f) + s0; uint2 o; o.x = pk2(u[0], u[1]); o.y = pk2(u[2], u[3]); *(uint2*)(U + (size_t)t * D + k) = o; }
    }
}
__device__ __forceinline__ void ln_rows(float* X, const float* g, const float* bta, float* final_out, const float* modn, bf16_t* U, int gw, int NGW, int lane) {
    for (int t = gw; t < T; t += NGW) {
        const int b = t / SEQT, sp = t - b * SEQT, j = sp < CTX ? 4 : b;
        if (final_out && sp < CTX) continue;
        float* xr = X + (size_t)t * D;
        f32x4 v[4]; float s = 0.f;
#pragma unroll
        for (int q = 0; q < 4; ++q) { v[q] = *(const f32x4*)(xr + (q * 64 + lane) * 4); s += (v[q][0] + v[q][1]) + (v[q][2] + v[q][3]); }
        const float mean = wave_sum(s) * (1.0f / D); float s2 = 0.f;
#pragma unroll
        for (int q = 0; q < 4; ++q) { v[q] = v[q] - mean; s2 += (v[q][0] * v[q][0] + v[q][1] * v[q][1]) + (v[q][2] * v[q][2] + v[q][3] * v[q][3]); }
        const float rstd = rsqrtf(wave_sum(s2) * (1.0f / D) + 1e-5f);
#pragma unroll
        for (int q = 0; q < 4; ++q) { const int k = (q * 64 + lane) * 4; const f32x4 y = v[q] * rstd * *(const f32x4*)(g + k) + *(const f32x4*)(bta + k);
            if (final_out) *(f32x4*)(final_out + ((size_t)b * SEQ + (sp - CTX)) * D + k) = y;
            else { *(f32x4*)(xr + k) = y; const f32x4 u = y * (*(const f32x4*)(modn + j * 3072 + 1024 + k) + 1.0f) + *(const f32x4*)(modn + j * 3072 + k);
                uint2 o; o.x = pk2(u[0], u[1]); o.y = pk2(u[2], u[3]); *(uint2*)(U + (size_t)t * D + k) = o; } }
    }
}

__device__ __forceinline__ float conv_at(const bf16_t* P, const float* cw, int t, int c) {
    const int sp = t % SEQT;
    const int lo = sp < CTX ? 0 : CTX, hi = sp < CTX ? CTX : SEQT;
    float acc = 0.f;
#pragma unroll
    for (int j = 0; j < 4; ++j) { const int s2 = sp + j - 2; if (s2 >= lo && s2 < hi) acc += cw[j * CONV_CH + c] * bf2f(P[(size_t)(t + j - 2) * LDP + c]); }
    return acc;
}
__device__ __forceinline__ int step_to_sp(int step, int d) { return d == 0 ? step : (step < CTX ? CTX - 1 - step : SEQT - 1 - (step - CTX)); }

__device__ __forceinline__ void na_item(const bf16_t* P, const float* rpb, bf16_t* F, int item, LAS float* wl, int lane) {
    LAS float* qsh = wl; LAS float* psh = wl + 64; LAS int* tsh = (LAS int*)(wl + 64 + 384);
    int hh, b, s, t; bool latent;
    if (item < NB * SEQ * 6) { hh = item % 6; const int qi = item / 6; b = qi / SEQ; s = qi % SEQ; t = b * SEQT + CTX + s; latent = true; }
    else { const int w2 = item - NB * SEQ * 6; hh = w2 % 6; const int qi = w2 / 6; b = qi / CTX; s = qi % CTX; t = b * SEQT + s; latent = false; }
    LDS_WAIT();
    qsh[lane] = bf2f(P[(size_t)t * LDP + C_QN + hh * 64 + lane]) * 0.125f;
    LDS_WAIT();
    const int r = s >> 6, jq = s & 63;
    const int r0 = min(max(r - 4, 0), 56), cs0 = min(max(jq - 8, 0), 48);
    float sc[6];
#pragma unroll
    for (int i = 0; i < 6; ++i) {
        const int kk = lane + 64 * i;
        int tk = -1; float bias = 0.f;
        if (latent) {
            if (i < 2) { const int wr = kk >> 4, m = kk & 15; const int kr = r0 + wr, kc = cs0 + m; tk = b * SEQT + CTX + kr * 64 + kc; bias = rpb[(hh * 15 + (kr - r + 7)) * 31 + (kc - jq + 15)]; }
            else tk = b * SEQT + (kk - 128);
        } else if (i < 4) tk = b * SEQT + kk;
        float dot = -INFINITY;
        if (tk >= 0) {
            const uint4* kp = (const uint4*)(P + (size_t)tk * LDP + C_KN + hh * 64);
            float acc = 0.f;
#pragma unroll
            for (int c8 = 0; c8 < 8; ++c8) {
                const uint4 kv = kp[c8]; const unsigned kw[4] = {kv.x, kv.y, kv.z, kv.w};
#pragma unroll
                for (int q = 0; q < 4; ++q) { acc += qsh[c8 * 8 + 2 * q] * __uint_as_float(kw[q] << 16); acc += qsh[c8 * 8 + 2 * q + 1] * __uint_as_float(kw[q] & 0xffff0000u); }
            }
            dot = acc + bias;
        }
        sc[i] = dot; tsh[kk] = tk;
    }
    float m = sc[0];
#pragma unroll
    for (int i = 1; i < 6; ++i) m = fmaxf(m, sc[i]);
    m = wave_max(m);
    float sum = 0.f;
#pragma unroll
    for (int i = 0; i < 6; ++i) { sc[i] = expf(sc[i] - m); sum += sc[i]; }
    sum = wave_sum(sum);
    const float inv = 1.0f / sum;
#pragma unroll
    for (int i = 0; i < 6; ++i) psh[lane + 64 * i] = sc[i] * inv;
    LDS_WAIT();
    const int nk = latent ? 384 : 256;
    float o = 0.f;
    for (int kk = 0; kk < nk; ++kk) o += psh[kk] * bf2f(P[(size_t)tsh[kk] * LDP + C_VN + hh * 64 + lane]);
    const float zn = bf2f(P[(size_t)t * LDP + C_ZN + hh * 64 + lane]);
    F[(size_t)t * 1024 + 384 + hh * 64 + lane] = (bf16_t)f2bf(o * siluf_(zn));
}
__device__ __forceinline__ void combine_rows(const bf16_t* P, const bf16_t* Ob, const float* nw, bf16_t* F, int gw, int NGW, int lane) {
    for (int t = gw; t < T; t += NGW) {
#pragma unroll
        for (int hh = 0; hh < 4; ++hh) { const int c = hh * 64 + lane;
            const float o = bf2f(Ob[(size_t)t * 256 + c]) + bf2f(Ob[(size_t)T * 256 + (size_t)t * 256 + c]);
            const float ms = wave_sum(o * o) * (1.0f / 64.0f);
            F[(size_t)t * 1024 + 768 + c] = (bf16_t)f2bf(o * rsqrtf(ms + 1e-6f) * nw[lane] * siluf_(bf2f(P[(size_t)t * LDP + C_ZG + c]))); }
    }
}


constexpr int LS = 72;
constexpr int G_KN = 0, G_KNT = 9216, G_QN = 18432, G_QK = 27648, G_XT = 36864, G_LM = 55296, G_SM = 72704, G_HALF = 73728;
constexpr int LMS = 68;
constexpr int GDN_ITEMS = NB * 4 * 2 * 68;
constexpr size_t GDN_ITEM_BYTES = 32768;
typedef short bf16x8_t __attribute__((ext_vector_type(8)));
typedef unsigned v2u __attribute__((ext_vector_type(2)));
typedef float f32x4_t __attribute__((ext_vector_type(4)));

typedef __bf16 bf16v2_t __attribute__((ext_vector_type(2)));
typedef float f32v2_t __attribute__((ext_vector_type(2)));
__device__ __forceinline__ unsigned cvtpk(float lo, float hi) { const f32v2_t v = {lo, hi}; return __builtin_bit_cast(unsigned, __builtin_convertvector(v, bf16v2_t)); }
__device__ __forceinline__ bf16x8_t lds_frag(const LAS unsigned char* base, int row, int col) { return *(const LAS bf16x8_t*)(base + (row * LS + col) * 2); }
__device__ __forceinline__ unsigned char* gdn_item_ptr(unsigned char* dout, unsigned char* wsx, int it) { return it < 2048 ? dout + (size_t)it * GDN_ITEM_BYTES : wsx + (size_t)(it - 2048) * GDN_ITEM_BYTES; }
__device__ __forceinline__ int gdn_sp(int c, int i, int d) {
    if (c < 4) { const int s = c * 64 + i; return d == 0 ? s : CTX - 1 - s; }
    const int s = (c - 4) * 64 + i; return d == 0 ? CTX + s : SEQT - 1 - s;
}

__device__ __forceinline__ void gdn_pass1(const bf16_t* P, const float* cw, const float* alog, const float* dtb, const float* rcos, const float* rsin,
                                          unsigned char* dout, unsigned char* wsx, LAS unsigned char* lds, int tid) {
    const int n_iter = (GDN_ITEMS + 2 * (int)gridDim.x - 1) / (2 * (int)gridDim.x);
#pragma unroll 1
    for (int iter = 0; iter < n_iter; ++iter) {
        int tidf = tid; asm volatile("" : "+v"(tidf));
        const int half = __builtin_amdgcn_readfirstlane(tidf >> 8), t256 = tidf & 255, w = __builtin_amdgcn_readfirstlane(t256 >> 6), lane = tidf & 63, g = lane >> 4, l15 = lane & 15;
        LAS unsigned char* hb = lds + half * G_HALF;
        LAS float* sm = (LAS float*)(hb + G_SM);
        LAS float* LM = (LAS float*)(hb + G_LM);
        const int it = (iter * (int)gridDim.x + (int)blockIdx.x) * 2 + half;
        const bool valid = it < GDN_ITEMS;
        const int c = it % 68, bhd = it / 68, d = bhd & 1, hh = (bhd >> 1) & 3, b = bhd >> 3;
        if (valid) {
            if (t256 < 64) {
                const int t2 = b * SEQT + gdn_sp(c, lane, d);
                const float beta = sigmoidf_(bf2f(P[(size_t)t2 * LDP + C_BR + d * 4 + hh]));
                const float gg = -expf(alog[d * 4 + hh]) * softplusf_(bf2f(P[(size_t)t2 * LDP + C_AR + d * 4 + hh]) + dtb[d * 4 + hh]);
                float G = gg;
#pragma unroll
                for (int o = 1; o < 64; o <<= 1) { const float v = __shfl_up(G, o); if (lane >= o) G += v; }
                const float gl = __shfl(G, 63);
                sm[lane] = beta; sm[64 + lane] = G; sm[128 + lane] = expf(G); sm[192 + lane] = expf(gl - G);
            }
        }
        const int i = t256 >> 2, qd = t256 & 3;
        float qv[16], kv[16], vv[16];
        if (valid) {
            const int sp = gdn_sp(c, i, d), t = b * SEQT + sp;
            const int lo = sp < CTX ? 0 : CTX, hi = sp < CTX ? CTX : SEQT;
#pragma unroll
            for (int e = 0; e < 16; ++e) { qv[e] = 0.f; kv[e] = 0.f; vv[e] = 0.f; }
#pragma unroll
            for (int j = 0; j < 4; ++j) {
                const int s2 = sp + j - 2;
                if (s2 >= lo && s2 < hi) {
                    const bf16_t* pr = P + (size_t)(t + j - 2) * LDP + hh * 64 + 16 * qd;
                    const float* wr_ = cw + j * CONV_CH + hh * 64 + 16 * qd;
#pragma unroll
                    for (int m3 = 0; m3 < 3; ++m3) {
                        const int cb = m3 == 0 ? C_QG : (m3 == 1 ? C_KG : C_VG);
                        const v4u a0 = *(const v4u*)(pr + cb), a1 = *(const v4u*)(pr + cb + 8);
                        const unsigned aw[8] = {a0.x, a0.y, a0.z, a0.w, a1.x, a1.y, a1.z, a1.w};
#pragma unroll
                        for (int e2 = 0; e2 < 8; ++e2) {
                            const float x0 = __uint_as_float(aw[e2] << 16), x1 = __uint_as_float(aw[e2] & 0xffff0000u);
                            const float w0 = wr_[cb + 2 * e2], w1 = wr_[cb + 2 * e2 + 1];
                            if (m3 == 0) { qv[2 * e2] += w0 * x0; qv[2 * e2 + 1] += w1 * x1; }
                            else if (m3 == 1) { kv[2 * e2] += w0 * x0; kv[2 * e2 + 1] += w1 * x1; }
                            else { vv[2 * e2] += w0 * x0; vv[2 * e2 + 1] += w1 * x1; }
                        }
                    }
                }
            }
            float sq = 0.f, sk = 0.f;
#pragma unroll
            for (int e = 0; e < 16; ++e) { qv[e] = siluf_(qv[e]); kv[e] = siluf_(kv[e]); vv[e] = siluf_(vv[e]); sq += qv[e] * qv[e]; sk += kv[e] * kv[e]; }
            sq += __shfl_xor(sq, 1); sq += __shfl_xor(sq, 2); sk += __shfl_xor(sk, 1); sk += __shfl_xor(sk, 2);
            const float rq = rsqrtf(sq + 1e-6f), rk = rsqrtf(sk + 1e-6f);
            const bool lat = sp >= CTX;
            const int s = sp - CTX, pos = qd < 2 ? (s >> 6) : (s & 63);
#pragma unroll
            for (int e = 0; e < 16; ++e) {
                float q1 = qv[e] * rq, k1 = kv[e] * rk;
                const float qp = __shfl_xor(q1, 1), kp = __shfl_xor(k1, 1);
                if (lat) { const float cs = rcos[pos * 16 + e], sn = rsin[pos * 16 + e];
                    if (qd & 1) { q1 = q1 * cs + qp * sn; k1 = k1 * cs + kp * sn; } else { q1 = q1 * cs - qp * sn; k1 = k1 * cs - kp * sn; } }
                qv[e] = q1 * 0.125f; kv[e] = k1;
            }
        }
        __syncthreads();
        if (valid) {
            const float beta = sm[i], eG = sm[128 + i], eGl = sm[192 + i];
            v4u o0, o1;
            o0.x = cvtpk(kv[0], kv[1]); o0.y = cvtpk(kv[2], kv[3]); o0.z = cvtpk(kv[4], kv[5]); o0.w = cvtpk(kv[6], kv[7]);
            o1.x = cvtpk(kv[8], kv[9]); o1.y = cvtpk(kv[10], kv[11]); o1.z = cvtpk(kv[12], kv[13]); o1.w = cvtpk(kv[14], kv[15]);
            *(LAS v4u*)(hb + G_KN + (i * LS + 16 * qd) * 2) = o0; *(LAS v4u*)(hb + G_KN + (i * LS + 16 * qd + 8) * 2) = o1;
            o0.x = cvtpk(qv[0], qv[1]); o0.y = cvtpk(qv[2], qv[3]); o0.z = cvtpk(qv[4], qv[5]); o0.w = cvtpk(qv[6], qv[7]);
            o1.x = cvtpk(qv[8], qv[9]); o1.y = cvtpk(qv[10], qv[11]); o1.z = cvtpk(qv[12], qv[13]); o1.w = cvtpk(qv[14], qv[15]);
            *(LAS v4u*)(hb + G_QN + (i * LS + 16 * qd) * 2) = o0; *(LAS v4u*)(hb + G_QN + (i * LS + 16 * qd + 8) * 2) = o1;
            const float bw = beta * eG;
#pragma unroll
            for (int e = 0; e < 16; ++e) {
                const int f = 16 * qd + e;
                *(LAS bf16_t*)(hb + G_KNT + (f * LS + i) * 2) = (bf16_t)f2bf(kv[e] * eGl);
                *(LAS bf16_t*)(hb + G_XT + (f * LS + i) * 2) = (bf16_t)f2bf(beta * vv[e]);
                *(LAS bf16_t*)(hb + G_XT + ((64 + f) * LS + i) * 2) = (bf16_t)f2bf(bw * kv[e]);
            }
        }
        __syncthreads();
        if (valid) {
            const bf16x8_t ak0 = lds_frag(hb + G_KN, 16 * w + l15, 8 * g), ak1 = lds_frag(hb + G_KN, 16 * w + l15, 32 + 8 * g);
            const bf16x8_t aq0 = lds_frag(hb + G_QN, 16 * w + l15, 8 * g), aq1 = lds_frag(hb + G_QN, 16 * w + l15, 32 + 8 * g);
            const f32x4_t Gi = *(const LAS f32x4_t*)(sm + 64 + 16 * w + 4 * g), Bi = *(const LAS f32x4_t*)(sm + 16 * w + 4 * g);
#pragma unroll
            for (int nt = 0; nt < 4; ++nt) {
                const bf16x8_t b0 = lds_frag(hb + G_KN, 16 * nt + l15, 8 * g), b1 = lds_frag(hb + G_KN, 16 * nt + l15, 32 + 8 * g);
                f32x4_t kk = {0.f, 0.f, 0.f, 0.f}, qk = {0.f, 0.f, 0.f, 0.f};
                kk = __builtin_amdgcn_mfma_f32_16x16x32_bf16(ak0, b0, kk, 0, 0, 0); kk = __builtin_amdgcn_mfma_f32_16x16x32_bf16(ak1, b1, kk, 0, 0, 0);
                qk = __builtin_amdgcn_mfma_f32_16x16x32_bf16(aq0, b0, qk, 0, 0, 0); qk = __builtin_amdgcn_mfma_f32_16x16x32_bf16(aq1, b1, qk, 0, 0, 0);
                const int jj = 16 * nt + l15; const float Gj = sm[64 + jj];
#pragma unroll
                for (int r = 0; r < 4; ++r) {
                    const int ii = 16 * w + 4 * g + r;
                    const float e = expf(fminf(Gi[r] - Gj, 0.f));
                    LM[ii * LMS + jj] = jj < ii ? Bi[r] * kk[r] * e : 0.f;
                    *(LAS bf16_t*)(hb + G_QK + (ii * LS + jj) * 2) = (bf16_t)f2bf(jj <= ii ? qk[r] * e : 0.f);
                }
            }
        }
        __syncthreads();
        if (valid && w < 2) {
            const int col = 64 * w + lane;
            LAS unsigned char* xr = hb + G_XT + col * LS * 2;
            float x[64];
#pragma unroll
            for (int q8 = 0; q8 < 8; ++q8) { const v4u rv = *(const LAS v4u*)(xr + q8 * 16); const unsigned rw[4] = {rv.x, rv.y, rv.z, rv.w};
#pragma unroll
                for (int e = 0; e < 4; ++e) { x[q8 * 8 + 2 * e] = __uint_as_float(rw[e] << 16); x[q8 * 8 + 2 * e + 1] = __uint_as_float(rw[e] & 0xffff0000u); } }
#pragma unroll
            for (int ii = 1; ii < 64; ++ii) {
                float acc = x[ii];
#pragma unroll
                for (int j4 = 0; j4 < (ii + 3) / 4; ++j4) { const f32x4_t lv = *(const LAS f32x4_t*)(LM + ii * LMS + 4 * j4);
#define NFMA(l_, x_) asm("v_fma_f32 %0, -%1, %2, %0" : "+v"(acc) : "v"(l_), "v"(x_))
                    NFMA(lv[0], x[4 * j4]); if (4 * j4 + 1 < ii) NFMA(lv[1], x[4 * j4 + 1]); if (4 * j4 + 2 < ii) NFMA(lv[2], x[4 * j4 + 2]); if (4 * j4 + 3 < ii) NFMA(lv[3], x[4 * j4 + 3]); }
#undef NFMA
                x[ii] = acc;
            }
#pragma unroll
            for (int q8 = 0; q8 < 8; ++q8) { v4u o; o.x = cvtpk(x[q8 * 8], x[q8 * 8 + 1]); o.y = cvtpk(x[q8 * 8 + 2], x[q8 * 8 + 3]); o.z = cvtpk(x[q8 * 8 + 4], x[q8 * 8 + 5]); o.w = cvtpk(x[q8 * 8 + 6], x[q8 * 8 + 7]);
                *(LAS v4u*)(xr + q8 * 16) = o; }
        }
        __syncthreads();
        if (valid) {
            unsigned char* blk = gdn_item_ptr(dout, wsx, it);
            bf16_t* gM = (bf16_t*)blk; bf16_t* gP = gM + 4096; bf16_t* gN = gM + 8192; bf16_t* gQ = gM + 12288;
            const bf16x8_t akd0 = lds_frag(hb + G_KNT, 16 * w + l15, 8 * g), akd1 = lds_frag(hb + G_KNT, 16 * w + l15, 32 + 8 * g);
            const bf16x8_t aqk0 = lds_frag(hb + G_QK, 16 * w + l15, 8 * g), aqk1 = lds_frag(hb + G_QK, 16 * w + l15, 32 + 8 * g);
            const bf16x8_t aw0 = lds_frag(hb + G_XT, 64 + 16 * w + l15, 8 * g), aw1 = lds_frag(hb + G_XT, 64 + 16 * w + l15, 32 + 8 * g);
            const float egl = sm[128 + 63];
            const int pcol = 16 * w + 4 * g;
#pragma unroll
            for (int nt = 0; nt < 4; ++nt) {
                const bf16x8_t bu0 = lds_frag(hb + G_XT, 16 * nt + l15, 8 * g), bu1 = lds_frag(hb + G_XT, 16 * nt + l15, 32 + 8 * g);
                f32x4_t nn = {0.f, 0.f, 0.f, 0.f}, qm = {0.f, 0.f, 0.f, 0.f};
                nn = __builtin_amdgcn_mfma_f32_16x16x32_bf16(akd0, bu0, nn, 0, 0, 0); nn = __builtin_amdgcn_mfma_f32_16x16x32_bf16(akd1, bu1, nn, 0, 0, 0);
                qm = __builtin_amdgcn_mfma_f32_16x16x32_bf16(aqk0, bu0, qm, 0, 0, 0); qm = __builtin_amdgcn_mfma_f32_16x16x32_bf16(aqk1, bu1, qm, 0, 0, 0);
                const int cc = 16 * nt + l15;
                v2u o; o.x = cvtpk(nn[0], nn[1]); o.y = cvtpk(nn[2], nn[3]); *(v2u*)(gN + cc * 64 + 16 * w + 4 * g) = o;
                o.x = cvtpk(qm[0], qm[1]); o.y = cvtpk(qm[2], qm[3]); *(v2u*)(gQ + cc * 64 + 16 * w + 4 * g) = o;
                const bf16x8_t bk0 = lds_frag(hb + G_KNT, 16 * nt + l15, 8 * g), bk1 = lds_frag(hb + G_KNT, 16 * nt + l15, 32 + 8 * g);
                const bf16x8_t bq0 = lds_frag(hb + G_QK, 16 * nt + l15, 8 * g), bq1 = lds_frag(hb + G_QK, 16 * nt + l15, 32 + 8 * g);
                f32x4_t mm = {0.f, 0.f, 0.f, 0.f}, pm = {0.f, 0.f, 0.f, 0.f};
                mm = __builtin_amdgcn_mfma_f32_16x16x32_bf16(aw0, bk0, mm, 0, 0, 0); mm = __builtin_amdgcn_mfma_f32_16x16x32_bf16(aw1, bk1, mm, 0, 0, 0);
                pm = __builtin_amdgcn_mfma_f32_16x16x32_bf16(aw0, bq0, pm, 0, 0, 0); pm = __builtin_amdgcn_mfma_f32_16x16x32_bf16(aw1, bq1, pm, 0, 0, 0);
                const int frow = 16 * nt + l15;
                float mv[4], pv[4];
                const v2u qraw = *(const LAS v2u*)(hb + G_QN + (frow * LS + 16 * w + 4 * g) * 2);
                const float qf[4] = {__uint_as_float(qraw.x << 16), __uint_as_float(qraw.x & 0xffff0000u), __uint_as_float(qraw.y << 16), __uint_as_float(qraw.y & 0xffff0000u)};
                const float eGi = sm[128 + frow];
#pragma unroll
                for (int r = 0; r < 4; ++r) { mv[r] = ((16 * w + 4 * g + r) == frow ? egl : 0.f) - mm[r]; pv[r] = qf[r] * eGi - pm[r]; }
                o.x = cvtpk(mv[0], mv[1]); o.y = cvtpk(mv[2], mv[3]); *(v2u*)(gM + frow * 64 + pcol) = o;
                o.x = cvtpk(pv[0], pv[1]); o.y = cvtpk(pv[2], pv[3]); *(v2u*)(gP + frow * 64 + pcol) = o;
            }
        }
        __syncthreads();
    }
}

__device__ __forceinline__ void gdn_chain(unsigned char* dout, unsigned char* wsx, bf16_t* Ob, int bhd, bool valid, LAS unsigned char* sbuf, int w, int lane) {
    const int d = bhd & 1, hh = (bhd >> 1) & 3, b = bhd >> 3, g = lane >> 4, l15 = lane & 15;
    bf16_t* O = Ob + (size_t)d * T * 256 + hh * 64 + l15;
    bf16x8_t aM[4][2], aP[4][2]; v2u nN[4][4], nQ[4][4];
#define GDN_LOAD(st_, c_) do { const bf16_t* blk_ = (const bf16_t*)gdn_item_ptr(dout, wsx, bhd * 68 + (c_)); \
        _Pragma("unroll") for (int s = 0; s < 2; ++s) { aM[st_][s] = *(const bf16x8_t*)(blk_ + (16 * w + l15) * 64 + 32 * s + 8 * g); aP[st_][s] = *(const bf16x8_t*)(blk_ + 4096 + (16 * w + l15) * 64 + 32 * s + 8 * g); } \
        _Pragma("unroll") for (int nt = 0; nt < 4; ++nt) { nN[st_][nt] = *(const v2u*)(blk_ + 8192 + (16 * nt + l15) * 64 + 16 * w + 4 * g); nQ[st_][nt] = *(const v2u*)(blk_ + 12288 + (16 * nt + l15) * 64 + 16 * w + 4 * g); } } while (0)
    if (valid) {
#pragma unroll
        for (int nt = 0; nt < 4; ++nt) *(LAS v2u*)(sbuf + ((16 * nt + l15) * LS + 16 * w + 4 * g) * 2) = (v2u){0u, 0u};
        GDN_LOAD(0, 0); GDN_LOAD(1, 1); GDN_LOAD(2, 2); GDN_LOAD(3, 3);
    }
    __syncthreads();
#pragma unroll 1
    for (int c4 = 0; c4 < 17; ++c4) {
#pragma unroll
        for (int u = 0; u < 4; ++u) {
            const int c = 4 * c4 + u;
            if (valid) {
                const LAS unsigned char* rb = sbuf + (c & 1) * 9216; LAS unsigned char* wb = sbuf + ((c + 1) & 1) * 9216;
                f32x4_t Sn[4], Oc[4];
#pragma unroll
                for (int nt = 0; nt < 4; ++nt) {
                    const bf16x8_t b0 = lds_frag(rb, 16 * nt + l15, 8 * g), b1 = lds_frag(rb, 16 * nt + l15, 32 + 8 * g);
                    Sn[nt] = (f32x4_t){__uint_as_float(nN[u][nt].x << 16), __uint_as_float(nN[u][nt].x & 0xffff0000u), __uint_as_float(nN[u][nt].y << 16), __uint_as_float(nN[u][nt].y & 0xffff0000u)};
                    Oc[nt] = (f32x4_t){__uint_as_float(nQ[u][nt].x << 16), __uint_as_float(nQ[u][nt].x & 0xffff0000u), __uint_as_float(nQ[u][nt].y << 16), __uint_as_float(nQ[u][nt].y & 0xffff0000u)};
                    Sn[nt] = __builtin_amdgcn_mfma_f32_16x16x32_bf16(aM[u][0], b0, Sn[nt], 0, 0, 0); Sn[nt] = __builtin_amdgcn_mfma_f32_16x16x32_bf16(aM[u][1], b1, Sn[nt], 0, 0, 0);
                    Oc[nt] = __builtin_amdgcn_mfma_f32_16x16x32_bf16(aP[u][0], b0, Oc[nt], 0, 0, 0); Oc[nt] = __builtin_amdgcn_mfma_f32_16x16x32_bf16(aP[u][1], b1, Oc[nt], 0, 0, 0);
                }
#pragma unroll
                for (int nt = 0; nt < 4; ++nt) { v2u o; o.x = cvtpk(Sn[nt][0], Sn[nt][1]); o.y = cvtpk(Sn[nt][2], Sn[nt][3]); *(LAS v2u*)(wb + ((16 * nt + l15) * LS + 16 * w + 4 * g) * 2) = o; }
                if (c + 4 < 68) GDN_LOAD(u, c + 4);
#pragma unroll
                for (int r = 0; r < 4; ++r) { const int t = b * SEQT + gdn_sp(c, 16 * w + 4 * g + r, d);
#pragma unroll
                    for (int nt = 0; nt < 4; ++nt) O[(size_t)t * 256 + 16 * nt] = (bf16_t)f2bf(Oc[nt][r]); }
            }
            __syncthreads();
        }
    }
#undef GDN_LOAD
}

constexpr int R_U = 0, R_A = 9216, R_B0 = R_A + 17408, R_B1 = R_B0 + 17408;
constexpr int RS = 68;
constexpr int RG_ITEMS = NB * 68 * 6;
constexpr int RG_SUM = 2 * NB * 68 * 384;

template <int MODE>
__device__ __forceinline__ void rg_pass(const bf16_t* P, const float* cw, const bf16_t* RGWT, const float* rgtab  ,
                                        float* SUMA, float* SUMH, const float* HIN, bf16_t* F, LAS unsigned char* lds, int tid) {
    const int n_iter = (RG_ITEMS + 2 * (int)gridDim.x - 1) / (2 * (int)gridDim.x);
#pragma unroll 1
    for (int iter = 0; iter < n_iter; ++iter) {
        int tidf = tid; asm volatile("" : "+v"(tidf));
        const int half = __builtin_amdgcn_readfirstlane(tidf >> 8), t256 = tidf & 255, w = __builtin_amdgcn_readfirstlane(t256 >> 6), lane = tidf & 63, g = lane >> 4, l15 = lane & 15;
        LAS unsigned char* hb = lds + half * G_HALF;
        LAS float* Aa = (LAS float*)(hb + R_A);
        const int it = (iter * (int)gridDim.x + (int)blockIdx.x) * 2 + half;
        const bool valid = it < RG_ITEMS;
        const int n = it % 6, tc = (it / 6) % 68, b = it / 408;
        const int i = t256 >> 2, qd = t256 & 3;
        const int t = b * SEQT + tc * 64 + i;
        if (valid) {
            const int sp = tc * 64 + i, lo = sp < CTX ? 0 : CTX, hi = sp < CTX ? CTX : SEQT;
            float u[16];
#pragma unroll
            for (int e = 0; e < 16; ++e) u[e] = 0.f;
#pragma unroll
            for (int j = 0; j < 4; ++j) { const int s2 = sp + j - 2;
                if (s2 >= lo && s2 < hi) { const bf16_t* pr = P + (size_t)(t + j - 2) * LDP + C_XA + n * 64 + 16 * qd; const float* wr_ = cw + j * CONV_CH + C_XA + n * 64 + 16 * qd;
                    const v4u a0 = *(const v4u*)pr, a1 = *(const v4u*)(pr + 8); const unsigned aw[8] = {a0.x, a0.y, a0.z, a0.w, a1.x, a1.y, a1.z, a1.w};
#pragma unroll
                    for (int e2 = 0; e2 < 8; ++e2) { u[2 * e2] += wr_[2 * e2] * __uint_as_float(aw[e2] << 16); u[2 * e2 + 1] += wr_[2 * e2 + 1] * __uint_as_float(aw[e2] & 0xffff0000u); } } }
            v4u o0, o1;
            o0.x = cvtpk(u[0], u[1]); o0.y = cvtpk(u[2], u[3]); o0.z = cvtpk(u[4], u[5]); o0.w = cvtpk(u[6], u[7]);
            o1.x = cvtpk(u[8], u[9]); o1.y = cvtpk(u[10], u[11]); o1.z = cvtpk(u[12], u[13]); o1.w = cvtpk(u[14], u[15]);
            *(LAS v4u*)(hb + R_U + (i * LS + 16 * qd) * 2) = o0; *(LAS v4u*)(hb + R_U + (i * LS + 16 * qd + 8) * 2) = o1;
        }
        __syncthreads();
#pragma unroll
        for (int d = 0; d < 2; ++d) {
            LAS float* Bd = (LAS float*)(hb + (d == 0 ? R_B0 : R_B1));
            if (valid) {
                const bf16x8_t a0 = lds_frag(hb + R_U, 16 * w + l15, 8 * g), a1 = lds_frag(hb + R_U, 16 * w + l15, 32 + 8 * g);
                const bf16_t* wa_t = RGWT + (size_t)((d * 6 + n) * 2) * 4096; const bf16_t* wx_t = wa_t + 4096;
#pragma unroll
                for (int nt = 0; nt < 4; ++nt) {
                    const int e = 16 * nt + l15, ch = n * 64 + e;
                    const bf16x8_t ba0 = *(const bf16x8_t*)(wa_t + e * 64 + 8 * g), ba1 = *(const bf16x8_t*)(wa_t + e * 64 + 32 + 8 * g);
                    const bf16x8_t bx0 = *(const bf16x8_t*)(wx_t + e * 64 + 8 * g), bx1 = *(const bf16x8_t*)(wx_t + e * 64 + 32 + 8 * g);
                    f32x4_t ra = {0.f, 0.f, 0.f, 0.f}, ri = {0.f, 0.f, 0.f, 0.f};
                    ra = __builtin_amdgcn_mfma_f32_16x16x32_bf16(a0, ba0, ra, 0, 0, 0); ra = __builtin_amdgcn_mfma_f32_16x16x32_bf16(a1, ba1, ra, 0, 0, 0);
                    ri = __builtin_amdgcn_mfma_f32_16x16x32_bf16(a0, bx0, ri, 0, 0, 0); ri = __builtin_amdgcn_mfma_f32_16x16x32_bf16(a1, bx1, ri, 0, 0, 0);
                    const float bav = rgtab[d * 384 + ch], bxv = rgtab[768 + d * 384 + ch], ls8 = rgtab[1536 + d * 384 + ch];
#pragma unroll
                    for (int r = 0; r < 4; ++r) {
                        const int tok = 16 * w + 4 * g + r;
                        const float uu = bf2f(*(const LAS bf16_t*)(hb + R_U + (tok * LS + e) * 2));
                        const float rr = 1.0f / (1.0f + __expf(-(ra[r] + bav))), ig = 1.0f / (1.0f + __expf(-(ri[r] + bxv)));
                        const float log_a = rr * ls8, y = 2.0f * log_a;
                        const float om = -y * (1.0f + y * (0.5f + y * ((1.0f / 6.0f) + y * ((1.0f / 24.0f) + y * ((1.0f / 120.0f) + y * ((1.0f / 720.0f) + y * (1.0f / 5040.0f)))))));
                        Aa[tok * RS + e] = expf(log_a); Bd[tok * RS + e] = sqrtf(om) * (ig * uu);
                    }
                }
            }
            __syncthreads();
            if (valid && w == 0) {
                const int ch = n * 64 + lane; const size_t si = ((size_t)(d * NB + b) * 68 + tc) * 384 + ch;
                float h = MODE == 3 ? HIN[si] : 0.f, ap = 1.f;
#pragma unroll 8
                for (int step = 0; step < 64; ++step) { const int tok = d ? 63 - step : step; const float a = Aa[tok * RS + lane];
                    h = a * h + Bd[tok * RS + lane]; if (MODE == 3) Bd[tok * RS + lane] = h; else ap *= a; }
                if (MODE == 1) { SUMA[si] = ap; SUMH[si] = h; }
            }
            __syncthreads();
        }
        if (MODE == 3 && valid) {
            const LAS float* B0 = (const LAS float*)(hb + R_B0); const LAS float* B1 = (const LAS float*)(hb + R_B1);
            const bf16_t* zp = P + (size_t)t * LDP + C_ZA + n * 64 + 16 * qd;
            const v4u z0 = *(const v4u*)zp, z1 = *(const v4u*)(zp + 8); const unsigned zw[8] = {z0.x, z0.y, z0.z, z0.w, z1.x, z1.y, z1.z, z1.w};
            unsigned ow[8];
#pragma unroll
            for (int e2 = 0; e2 < 8; ++e2) { const int e = 16 * qd + 2 * e2;
                const float h0 = B0[i * RS + e] + B1[i * RS + e], h1 = B0[i * RS + e + 1] + B1[i * RS + e + 1];
                ow[e2] = cvtpk(h0 * siluf_(__uint_as_float(zw[e2] << 16)), h1 * siluf_(__uint_as_float(zw[e2] & 0xffff0000u))); }
            v4u o0 = {ow[0], ow[1], ow[2], ow[3]}, o1 = {ow[4], ow[5], ow[6], ow[7]};
            bf16_t* fp = F + (size_t)t * 1024 + n * 64 + 16 * qd;
            *(v4u*)fp = o0; *(v4u*)(fp + 8) = o1;
        }
        __syncthreads();
    }
}
__device__ __forceinline__ void rg_carry(const float* SUMA, const float* SUMH, float* HIN, int idx) {
    const int ch = idx % 384, b = (idx / 384) % NB, d = idx / (384 * NB);
    const size_t base = ((size_t)(d * NB + b) * 68) * 384 + ch;
    float h = 0.f;
#pragma unroll 4
    for (int s = 0; s < 68; ++s) { const int tc = d == 0 ? s : (s < 4 ? 3 - s : 71 - s);
        const size_t k = base + (size_t)tc * 384; HIN[k] = h; h = SUMA[k] * h + SUMH[k]; }
}
__device__ __forceinline__ int opq(int i) { asm volatile("" : "+s"(i)); return i; }
#define IN(i) ((const float*)p.ptr[opq(i)])
#define WSB ((unsigned char*)p.ptr[opq(21)])
#define OUTP ((float*)p.ptr[opq(20)])
#define ctl ((unsigned*)(WSB + WS_CTL))
#define mod ((float*)(WSB + WS_MOD))
#define WTIN ((bf16_t*)(WSB + WS_WTIN))
#define WTOUT ((bf16_t*)(WSB + WS_WTOUT))
#define X ((float*)(WSB + WS_X))
#define UF ((bf16_t*)(WSB + WS_UF))
#define P ((bf16_t*)(WSB + WS_P))
#define gdn0 ((unsigned char*)OUTP)
#define gdnx (WSB + WS_GDNX)
#define Ob ((bf16_t*)(WSB + WS_OB))
#define rcos ((float*)(WSB + WS_ROPE))
#define rsin ((float*)(WSB + WS_ROPE) + 1024)
#define RGWT ((bf16_t*)(WSB + WS_RGWT))
#define rgtab ((float*)(WSB + WS_RGTAB))
#define SUMA ((float*)(WSB + WS_RGS))
#define SUMH ((float*)(WSB + WS_RGS) + (1 << 18))
#define HIN ((float*)(WSB + WS_RGS) + (2 << 18))
__device__ __forceinline__ int fresh_v(int v) { asm volatile("" : "+v"(v)); return v; }
enum { I_X = 0, I_C, I_CTX, I_CCTX, I_WMOD, I_BMOD, I_WIN, I_CONVW, I_RGWA, I_RGBA, I_RGWX, I_RGBX, I_RGLAM, I_RPB, I_ALOG, I_DTB, I_NW, I_WOUT, I_LNG, I_LNB };
__global__ void __launch_bounds__(512, 2) mega_fwd(Params p) {
    extern __shared__ __attribute__((aligned(16))) unsigned char lds_raw[];
    LAS unsigned char* lds = (LAS unsigned char*)lds_raw;
    cg::grid_group grid = cg::this_grid();
    const int tid = threadIdx.x, lane0 = tid & 63, wid = __builtin_amdgcn_readfirstlane(tid >> 6);
    const int gw0 = blockIdx.x * 8 + wid, NGW = gridDim.x * 8;
    const int lane = lane0, gw = gw0;
    LAS float* wscr = (LAS float*)(lds + wid * 16384);

    phase_mods(IN(I_C), IN(I_CCTX), IN(I_WMOD), IN(I_BMOD), mod, (LAS float*)lds, wid, lane);
    convert_weights(IN(I_WIN), IN(I_WOUT), WTIN, WTOUT, wscr, gw, NGW, lane);
    convert_rg(IN(I_RGWA), IN(I_RGBA), IN(I_RGWX), IN(I_RGBX), IN(I_RGLAM), RGWT, rgtab, (int)blockIdx.x * 512 + tid, (int)gridDim.x * 512);
    if (blockIdx.x == 0) { for (int e = tid; e < 1024; e += 512) { const float ang = (float)(e >> 4) * expf(-(float)(e & 15) * (9.210340371976184f / 16.0f)); rcos[e] = cosf(ang); rsin[e] = sinf(ang); } }
    grid.sync();
    prep_rows0(IN(I_X), IN(I_CTX), mod, UF, gw, NGW, lane);
    grid.sync();
#pragma unroll 1
    for (int l = 0; l < DEPTH; ++l) {
        const float* modl = mod + (size_t)l * 5 * 3072;
        { pg8::Gemm g{UF, WTIN, T, NPAD, D}; pg8::StaticOrder S; S.init(T, NPAD, (int)gridDim.x, (int)blockIdx.x);
          pg8::EpiP E{P};
#ifndef ABL_G1
          pg8::gemm_phase<pg8::EpiP, pg8::StaticOrder, true, true>(lds, g, S, E);
#endif
        }
        grid.sync();
#ifndef ABL_P1
        gdn_pass1(P, IN(I_CONVW) + (size_t)l * 4 * CONV_CH, IN(I_ALOG) + l * 8, IN(I_DTB) + l * 8, rcos, rsin, gdn0, gdnx, lds, fresh_v(tid));
#endif
        rg_pass<1>(P, IN(I_CONVW) + (size_t)l * 4 * CONV_CH, RGWT, rgtab, SUMA, SUMH, nullptr, nullptr, lds, fresh_v(tid));
        grid.sync();
        { const int lane = fresh_v(lane0); LAS float* nscr = (LAS float*)(lds + wid * 4096);
#ifndef ABL_CH
            if (blockIdx.x < 16) gdn_chain(gdn0, gdnx, Ob, (int)blockIdx.x * 2 + (wid >> 2), true, lds + 65536 + (wid >> 2) * 18432, wid & 3, lane);
#endif
            if (blockIdx.x >= 16 && blockIdx.x < 22) rg_carry(SUMA, SUMH, HIN, ((int)blockIdx.x - 16) * 512 + fresh_v(tid));
            const int n_items = NB * SEQ * 6 + (l < DEPTH - 1 ? NB * CTX * 6 : 0);
            unsigned* cnt = ctl + 64 * (l + 1);
            const float* rpb = IN(I_RPB) + (size_t)l * 6 * 15 * 31;
            for (;;) {
                int base = 0;
                if (lane == 0) base = (int)__hip_atomic_fetch_add(cnt, 16u, __ATOMIC_RELAXED, __HIP_MEMORY_SCOPE_AGENT);
                base = __builtin_amdgcn_readfirstlane(base);
                if (base >= n_items) break;
                for (int it = base; it < base + 16 && it < n_items; ++it) na_item(P, rpb, UF, it, nscr, lane);
            }
        }
        grid.sync();
        rg_pass<3>(P, IN(I_CONVW) + (size_t)l * 4 * CONV_CH, RGWT, rgtab, nullptr, nullptr, HIN, UF, lds, fresh_v(tid));
        { const int lane = fresh_v(lane0); const int gw = opq(gw0); combine_rows(P, Ob, IN(I_NW) + l * 64, UF, gw, NGW, lane); }
        grid.sync();
        { pg8::Gemm g{UF, WTOUT, T, D, D}; pg8::StaticOrder S; S.init(T, D, (int)gridDim.x, (int)blockIdx.x);
          pg8::EpiZ E{IN(I_X), IN(I_CTX), X, modl, l == 0 ? 1 : 0};
#ifndef ABL_G2
          pg8::gemm_phase<pg8::EpiZ, pg8::StaticOrder, true, true>(lds, g, S, E);
#endif
        }
        grid.sync();
        if (l < DEPTH - 1) { const int lane = fresh_v(lane0); const int gw = opq(gw0);
            ln_rows(X, IN(I_LNG) + l * D, IN(I_LNB) + l * D, nullptr, mod + (size_t)(l + 1) * 5 * 3072, UF, gw, NGW, lane);
            convert_weights(IN(I_WIN) + (size_t)(l + 1) * D * DIN, IN(I_WOUT) + (size_t)(l + 1) * D * D, WTIN, WTOUT, wscr, gw, NGW, lane);
            convert_rg(IN(I_RGWA) + (size_t)(l + 1) * 49152, IN(I_RGBA) + (l + 1) * 768, IN(I_RGWX) + (size_t)(l + 1) * 49152, IN(I_RGBX) + (l + 1) * 768, IN(I_RGLAM) + (l + 1) * 768, RGWT, rgtab, (int)blockIdx.x * 512 + fresh_v(tid), (int)gridDim.x * 512);
            grid.sync();
        } else { const int lane = fresh_v(lane0); const int gw = opq(gw0); ln_rows(X, IN(I_LNG) + l * D, IN(I_LNB) + l * D, OUTP, nullptr, nullptr, gw, NGW, lane); }
    }
}
#undef ctl
#undef mod
#undef WTIN
#undef WTOUT
#undef X
#undef UF
#undef P
#undef gdn0
#undef gdnx
#undef Ob
#undef rcos
#undef rsin
#undef RGWT
#undef rgtab
#undef SUMA
#undef SUMH
#undef HIN
}

extern "C" void kernel_launch(void* const* d_in, const int* in_sizes, int n_in, void* d_out, int out_size, void* d_ws, size_t ws_size, hipStream_t stream) {
    static int grid = 0;
    if (grid == 0) {
        if (n_in != 20 || ws_size < WS_END) { fprintf(stderr, "kernel_launch: unexpected n_in %d / ws_size %zu\n", n_in, ws_size); grid = -1; return; }
        int dev = 0, cus = 0, per_cu = 0;
        hipGetDevice(&dev);
        hipDeviceGetAttribute(&cus, hipDeviceAttributeMultiprocessorCount, dev);
        if (hipFuncSetAttribute((const void*)mega_fwd, hipFuncAttributeMaxDynamicSharedMemorySize, LDS_BYTES) != hipSuccess) { fprintf(stderr, "kernel_launch: hipFuncSetAttribute failed\n"); grid = -1; return; }
        if (hipOccupancyMaxActiveBlocksPerMultiprocessor(&per_cu, (const void*)mega_fwd, 512, LDS_BYTES) != hipSuccess || per_cu < 1) { fprintf(stderr, "kernel_launch: occupancy query gave %d\n", per_cu); per_cu = 1; }
        (void)hipGetLastError();
        grid = cus * 1;
        fprintf(stderr, "kernel_launch: cus %d per_cu %d grid %d\n", cus, per_cu, grid);
    }
    if (grid < 0) return;
    hipMemsetAsync((char*)d_ws + WS_CTL, 0, CTL_ZERO_BYTES, stream);
    Params prm{};
    for (int i = 0; i < 20; ++i) prm.ptr[i] = d_in[i];
    prm.ptr[20] = d_out; prm.ptr[21] = d_ws;
    void* args[] = {&prm};
    hipError_t e = hipLaunchCooperativeKernel((const void*)mega_fwd, dim3(grid), dim3(512), args, LDS_BYTES, stream);
    if (e != hipSuccess) fprintf(stderr, "cooperative launch failed: %s (grid %d)\n", hipGetErrorString(e), grid);
}
```

```cpp
#include <hip/hip_runtime.h>
#include <hip/hip_cooperative_groups.h>
#include <cstdio>
#include <cstdint>
namespace cg = cooperative_groups;

namespace {
constexpr int D = 1024, NB = 4, SEQ = 4096, DEPTH = 4, CTX = 256;
constexpr int SEQT = CTX + SEQ;
constexpr int T = NB * SEQT;
constexpr int DIN = 3344, LDP = 3360, NPAD = 3584;
constexpr int CONV_CH = 1152;
constexpr int C_XA = 0, C_QG = 384, C_KG = 640, C_VG = 896, C_ZA = 1152, C_QN = 1536, C_KN = 1920, C_VN = 2304,
              C_ZN = 2688, C_ZG = 3072, C_BR = 3328, C_AR = 3336;
constexpr float ALPHA = 1.681792830507429f;
}
namespace pg8 {
#define PG8_LAS __attribute__((address_space(3)))
typedef unsigned short bf16_t;
typedef short bf16x8 __attribute__((ext_vector_type(8)));
typedef float f32x4 __attribute__((ext_vector_type(4)));
typedef unsigned u32x4 __attribute__((ext_vector_type(4)));
constexpr int BM = 256, BK = 64, HALF = 128, HTB = HALF * BK * 2  , STAGE_BYTES = 8 * HTB, NXCD = 8, WGM = 8;

__host__ __device__ __forceinline__ int lds_byte(int r, int c) { const int st = (r >> 4) * 2 + (c >> 5), rr = r & 15, cc = c & 31, ob = rr * 64 + cc * 2; return st * 1024 + (ob ^ (((ob >> 9) & 1) << 5)); }
__host__ __device__ __forceinline__ void stage_rc(int b, int& R, int& C) { const int st = b / 1024, sb = b % 1024, swz = sb ^ (((sb >> 9) & 1) << 5); R = (st >> 1) * 16 + swz / 64; C = (st & 1) * 32 + (swz % 64) / 2; }
__host__ __device__ __forceinline__ int perm32(int rho) { const int n = rho >> 4, i = rho & 15; return 8 * (i >> 2) + 4 * n + (i & 3); }

struct Unit { int pm, pn; };
struct Gemm { const bf16_t* A; const bf16_t* Bt; int M, N, K; };

struct StaticOrder {
    int nM, nN, nwg, G, c;
    __host__ __device__ void init(int M, int N, int G_, int c_) { nM = M / BM; nN = N / BM; nwg = nM * nN; G = G_; c = c_; }
    __host__ __device__ bool next(int i, Unit& u) const {
        const long L = (long)i * G + c; if (L >= nwg) return false;
        int wgid = (int)L; { const int q = nwg / NXCD, r = nwg % NXCD, xcd = wgid % NXCD, off = wgid / NXCD; wgid = (xcd < r ? xcd * (q + 1) : r * (q + 1) + (xcd - r) * q) + off; }
        const int nig = WGM * nN, gid = wgid / nig, fm = gid * WGM, gsz = (nM - fm) < WGM ? (nM - fm) : WGM;
        u.pm = fm + ((wgid % nig) % gsz); u.pn = (wgid % nig) / gsz; return true;
    }
    __device__ __forceinline__ void a_ready(const Unit&) const {}
    __device__ __forceinline__ void done(const Unit&) const {}
};

typedef __bf16 bf16v2 __attribute__((ext_vector_type(2)));
typedef float f32v2 __attribute__((ext_vector_type(2)));
__device__ __forceinline__ unsigned cvt_pk_bf16(float lo, float hi) { const f32v2 v = {lo, hi}; return __builtin_bit_cast(unsigned, __builtin_convertvector(v, bf16v2)); }
struct EpiP {
    static constexpr bool PERM = true, AFTER_DRAIN = false;
    bf16_t* P;
    __device__ __forceinline__ void operator()(const f32x4 (&acc)[2][2][4][2], const Unit& u, int wr, int wc, int fr, int fq) const {
        asm volatile("" : "+v"(fr), "+v"(fq));
        const int row0 = u.pm * BM + wr * 64 + fr, col0 = u.pn * BM + wc * 32 + 8 * fq;
#pragma unroll
        for (int ai = 0; ai < 2; ++ai)
#pragma unroll
            for (int m = 0; m < 4; ++m) { bf16_t* rowp = P + (size_t)(row0 + ai * HALF + m * 16) * LDP + col0;
#pragma unroll
                for (int bj = 0; bj < 2; ++bj) { if (col0 + bj * HALF < LDP) { const f32x4 v0 = acc[ai][bj][m][0], v1 = acc[ai][bj][m][1];
                    u32x4 w; w.x = cvt_pk_bf16(v0[0], v0[1]); w.y = cvt_pk_bf16(v0[2], v0[3]); w.z = cvt_pk_bf16(v1[0], v1[1]); w.w = cvt_pk_bf16(v1[2], v1[3]);
                    *(u32x4*)(rowp + bj * HALF) = w; } } }
    }
};
struct EpiZ {
    static constexpr bool PERM = false, AFTER_DRAIN = false;
    const float* x_in; const float* ctx_in; float* X; const float* modl; int layer0;
    __device__ __forceinline__ void operator()(const f32x4 (&acc)[2][2][4][2], const Unit& u, int wr, int wc, int fr, int fq) const {
        asm volatile("" : "+v"(fr), "+v"(fq));
        const int row0 = u.pm * BM + wr * 64 + fr, col0 = u.pn * BM + wc * 32 + 4 * fq;
#pragma unroll
        for (int ai = 0; ai < 2; ++ai)
#pragma unroll
            for (int m = 0; m < 4; ++m) { const int r = row0 + ai * HALF + m * 16; const int b = r / SEQT, sp = r - b * SEQT; const int j = sp < CTX ? 4 : b;
                const float* xs = layer0 ? (sp < CTX ? ctx_in + ((size_t)b * CTX + sp) * D : x_in + ((size_t)b * SEQ + (sp - CTX)) * D) : X + (size_t)r * D;
                float* zo = X + (size_t)r * D; const float* gp = modl + j * 3072 + 2048;
#pragma unroll
                for (int bj = 0; bj < 2; ++bj)
#pragma unroll
                    for (int n = 0; n < 2; ++n) { const int c = col0 + bj * HALF + n * 16; const f32x4 xv = *(const f32x4*)(xs + c), gv = *(const f32x4*)(gp + c);
                        *(f32x4*)(zo + c) = xv * ALPHA + gv * acc[ai][bj][m][n]; } }
    }
};

template <class Epi, class Sched, bool ALIGN_EPI = false, bool SP2 = false>
__device__ __forceinline__ void gemm_phase(PG8_LAS unsigned char* lds, const Gemm g, const Sched& S, const Epi& E) {
    int tid_ = threadIdx.x; asm volatile("" : "+v"(tid_));
    const int tid = tid_, wid = __builtin_amdgcn_readfirstlane(tid >> 6), lane = tid & 63, wr = wid >> 2, wc = wid & 3, fr = lane & 15, fq = lane >> 4;
    const int K = g.K, nt = K / BK;
    unsigned voffA[2], voffB[2];
#pragma unroll
    for (int i = 0; i < 2; ++i) { int R, C; stage_rc(tid * 16 + i * 8192, R, C); const int Rb = Epi::PERM ? ((R & ~31) + perm32(R & 31)) : R;
        voffA[i] = (unsigned)(R * K + C) * 2u; voffB[i] = (unsigned)(Rb * K + C) * 2u; }
    const size_t kstep = (size_t)(BK * 2);
    const size_t hstep = (size_t)HALF * K * 2;
    const size_t tstep = 2 * hstep;
    const unsigned ldsw = (unsigned)wid * 1024u;
    const int aoff = lds_byte(wr * 64 + fr, fq * 8), boff = lds_byte(wc * 32 + fr, fq * 8);
#define PG8_SA(b, h) (((b) * 2 + (h)) * HTB)
#define PG8_SB(b, h) ((4 + (b) * 2 + (h)) * HTB)
#define PG8_STAGE(bufoff, gbase, voff) do { _Pragma("unroll") for (int _i = 0; _i < 2; ++_i) \
        __builtin_amdgcn_global_load_lds((const unsigned*)((const char*)(gbase) + (voff)[_i]), (PG8_LAS unsigned*)(lds + (bufoff) + ldsw + _i * 8192), 16, 0, 0); } while (0)
#define PG8_LDA(dst, b, h) do { _Pragma("unroll") for (int m = 0; m < 4; ++m) _Pragma("unroll") for (int k = 0; k < 2; ++k) dst[m][k] = *(const PG8_LAS bf16x8*)(lds + PG8_SA(b, h) + aoff + m * 2048 + k * 1024); } while (0)
#define PG8_LDB(dst, b, h) do { _Pragma("unroll") for (int n = 0; n < 2; ++n) _Pragma("unroll") for (int k = 0; k < 2; ++k) dst[n][k] = *(const PG8_LAS bf16x8*)(lds + PG8_SB(b, h) + boff + n * 2048 + k * 1024); } while (0)
#define PG8_MMA(ai, bj, At, Bt) do { __builtin_amdgcn_s_setprio(1); _Pragma("unroll") for (int m = 0; m < 4; ++m) _Pragma("unroll") for (int n = 0; n < 2; ++n) _Pragma("unroll") for (int k = 0; k < 2; ++k) \
        acc[ai][bj][m][n] = __builtin_amdgcn_mfma_f32_16x16x32_bf16(Bt[n][k], At[m][k], acc[ai][bj][m][n], 0, 0, 0); __builtin_amdgcn_s_setprio(0); } while (0)
#define PG8_WAIT_V(n) asm volatile("s_waitcnt vmcnt(" #n ")" ::: "memory")
#define PG8_WAIT_L(n) asm volatile("s_waitcnt lgkmcnt(" #n ")" ::: "memory")
#define PG8_BAR __builtin_amdgcn_s_barrier()
#define PG8_SCHED __builtin_amdgcn_sched_barrier(0)
    Unit cur, nxt; int ui = 0;
    if (!S.next(0, cur)) return;
    f32x4 acc[2][2][4][2];
#pragma unroll
    for (int a = 0; a < 2; ++a)
#pragma unroll
        for (int b = 0; b < 2; ++b)
#pragma unroll
            for (int m = 0; m < 4; ++m)
#pragma unroll
                for (int n = 0; n < 2; ++n) acc[a][b][m][n] = (f32x4){0.f, 0.f, 0.f, 0.f};
    bf16x8 At[4][2], B0[2][2], B1[2][2];
    const char* cA = (const char*)g.A + (size_t)cur.pm * tstep; const char* cB = (const char*)g.Bt + (size_t)cur.pn * tstep;
    S.a_ready(cur);
    if constexpr (SP2) {
        PG8_STAGE(PG8_SB(0, 0), cB, voffB); PG8_STAGE(PG8_SB(0, 1), cB + hstep, voffB); PG8_STAGE(PG8_SA(0, 0), cA, voffA); PG8_STAGE(PG8_SA(0, 1), cA + hstep, voffA);
        if (wr == 1) PG8_BAR;
        PG8_WAIT_V(2); PG8_BAR;
        PG8_STAGE(PG8_SB(1, 0), cB + kstep, voffB); PG8_STAGE(PG8_SA(1, 0), cA + kstep, voffA); PG8_STAGE(PG8_SB(1, 1), cB + hstep + kstep, voffB);
        PG8_WAIT_V(6); PG8_BAR;
    } else {
        PG8_STAGE(PG8_SB(0, 0), cB, voffB); PG8_STAGE(PG8_SA(0, 0), cA, voffA); PG8_STAGE(PG8_SB(0, 1), cB + hstep, voffB); PG8_STAGE(PG8_SA(0, 1), cA + hstep, voffA);
        if (wr == 1) PG8_BAR;
        PG8_WAIT_V(4); PG8_BAR;
        PG8_STAGE(PG8_SB(1, 0), cB + kstep, voffB); PG8_STAGE(PG8_SA(1, 0), cA + kstep, voffA); PG8_STAGE(PG8_SB(1, 1), cB + hstep + kstep, voffB);
        PG8_WAIT_V(6); PG8_BAR;
    }
    for (;;) {
        const bool has_next = S.next(ui + 1, nxt);
        const char* nA = has_next ? (const char*)g.A + (size_t)nxt.pm * tstep : cA; const char* nB = has_next ? (const char*)g.Bt + (size_t)nxt.pn * tstep : cB;
        for (int t = 0; t < nt; t += 2) {
            const bool last = (t == nt - 2);
            const char* a1 = cA + (size_t)(t + 1) * kstep;
            const char* a2 = last ? nA : cA + (size_t)(t + 2) * kstep; const char* b2 = last ? nB : cB + (size_t)(t + 2) * kstep;
            const char* a3 = a2 + kstep; const char* b3 = b2 + kstep;
            if (last && has_next) S.a_ready(nxt);
            if constexpr (SP2) {
            PG8_LDB(B0, 0, 0); PG8_LDB(B1, 0, 1); PG8_SCHED; PG8_LDA(At, 0, 0); PG8_STAGE(PG8_SA(1, 1), a1 + hstep, voffA);
            PG8_WAIT_V(8); PG8_WAIT_L(0); PG8_BAR; PG8_MMA(0, 0, At, B0); PG8_MMA(0, 1, At, B1); PG8_BAR; PG8_SCHED;
            PG8_LDA(At, 0, 1); PG8_STAGE(PG8_SB(0, 0), b2, voffB); PG8_STAGE(PG8_SB(0, 1), b2 + hstep, voffB); PG8_STAGE(PG8_SA(0, 0), a2, voffA);
            PG8_WAIT_V(8); PG8_WAIT_L(0); PG8_BAR; PG8_MMA(1, 0, At, B0); PG8_MMA(1, 1, At, B1); PG8_BAR; PG8_SCHED;
            PG8_LDB(B0, 1, 0); PG8_LDB(B1, 1, 1); PG8_SCHED; PG8_LDA(At, 1, 0); PG8_STAGE(PG8_SA(0, 1), a2 + hstep, voffA);
            PG8_WAIT_V(8); PG8_WAIT_L(0); PG8_BAR; PG8_MMA(0, 0, At, B0); PG8_MMA(0, 1, At, B1); PG8_BAR; PG8_SCHED;
            PG8_LDA(At, 1, 1); PG8_STAGE(PG8_SB(1, 0), b3, voffB); PG8_STAGE(PG8_SB(1, 1), b3 + hstep, voffB); PG8_STAGE(PG8_SA(1, 0), a3, voffA);
            PG8_WAIT_V(8); PG8_WAIT_L(0); PG8_BAR; PG8_MMA(1, 0, At, B0); PG8_MMA(1, 1, At, B1); PG8_BAR; PG8_SCHED;
            } else {
            PG8_LDB(B0, 0, 0); PG8_SCHED; PG8_LDA(At, 0, 0); PG8_STAGE(PG8_SA(1, 1), a1 + hstep, voffA);
            PG8_WAIT_L(8); PG8_BAR; PG8_WAIT_L(0); PG8_MMA(0, 0, At, B0); PG8_BAR; PG8_SCHED;
            PG8_LDB(B1, 0, 1); PG8_STAGE(PG8_SB(0, 0), b2, voffB);
            PG8_BAR; PG8_WAIT_L(0); PG8_MMA(0, 1, At, B1); PG8_BAR;
            PG8_LDA(At, 0, 1); PG8_STAGE(PG8_SA(0, 0), a2, voffA);
            PG8_BAR; PG8_WAIT_L(0); PG8_MMA(1, 0, At, B0); PG8_BAR; PG8_SCHED;
            PG8_STAGE(PG8_SB(0, 1), b2 + hstep, voffB);
            PG8_WAIT_V(6); PG8_BAR; PG8_MMA(1, 1, At, B1); PG8_BAR;
            PG8_LDB(B0, 1, 0); PG8_SCHED; PG8_LDA(At, 1, 0); PG8_STAGE(PG8_SA(0, 1), a2 + hstep, voffA);
            PG8_WAIT_L(8); PG8_BAR; PG8_WAIT_L(0); PG8_MMA(0, 0, At, B0); PG8_BAR; PG8_SCHED;
            PG8_LDB(B1, 1, 1); PG8_STAGE(PG8_SB(1, 0), b3, voffB);
            PG8_BAR; PG8_WAIT_L(0); PG8_MMA(0, 1, At, B1); PG8_BAR;
            PG8_LDA(At, 1, 1); PG8_STAGE(PG8_SA(1, 0), a3, voffA);
            PG8_BAR; PG8_WAIT_L(0); PG8_MMA(1, 0, At, B0); PG8_BAR; PG8_SCHED;
            PG8_STAGE(PG8_SB(1, 1), b3 + hstep, voffB);
            PG8_WAIT_V(6); PG8_BAR; PG8_MMA(1, 1, At, B1); PG8_BAR;
            }
        }
        if constexpr (ALIGN_EPI) { if (wr == 0) PG8_BAR; }
        if constexpr (!Epi::AFTER_DRAIN) { E(acc, cur, wr, wc, fr, fq); S.done(cur); }
        if (!has_next) break;
#pragma unroll
        for (int a = 0; a < 2; ++a)
#pragma unroll
            for (int b = 0; b < 2; ++b)
#pragma unroll
                for (int m = 0; m < 4; ++m)
#pragma unroll
                    for (int n = 0; n < 2; ++n) acc[a][b][m][n] = (f32x4){0.f, 0.f, 0.f, 0.f};
        cur = nxt; cA = nA; cB = nB; ++ui;
        if constexpr (ALIGN_EPI) { if (wr == 1) PG8_BAR; }
    }
    PG8_WAIT_V(0);
    if constexpr (!ALIGN_EPI) { if (wr == 0) PG8_BAR; }
    PG8_BAR;
    if constexpr (Epi::AFTER_DRAIN) { E.fused(acc, cur, wr, wc, fr, fq, lds, wid, lane); S.done(cur); }
#undef PG8_SA
#undef PG8_SB
#undef PG8_STAGE
#undef PG8_LDA
#undef PG8_LDB
#undef PG8_MMA
#undef PG8_WAIT_V
#undef PG8_WAIT_L
#undef PG8_BAR
#undef PG8_SCHED
}
}

namespace {
#define LAS __attribute__((address_space(3)))
typedef unsigned short bf16_t;
typedef unsigned v4u __attribute__((ext_vector_type(4)));
typedef float f32x4 __attribute__((ext_vector_type(4)));
#define LDS_WAIT() asm volatile("s_waitcnt lgkmcnt(0)" ::: "memory")

__device__ __forceinline__ unsigned f2bf(float f) { unsigned u = __float_as_uint(f); return (u + 0x7fffu + ((u >> 16) & 1u)) >> 16; }
__device__ __forceinline__ unsigned pk2(float lo, float hi) { return f2bf(lo) | (f2bf(hi) << 16); }
__device__ __forceinline__ float bf2f(bf16_t b) { return __uint_as_float(((unsigned)b) << 16); }
__device__ __forceinline__ float sigmoidf_(float x) { return 1.0f / (1.0f + expf(-x)); }
__device__ __forceinline__ float siluf_(float x) { return x / (1.0f + expf(-x)); }
__device__ __forceinline__ float softplusf_(float x) { return x > 20.f ? x : log1pf(expf(x)); }
__device__ __forceinline__ float wave_sum(float v) {
#pragma unroll
    for (int o = 32; o >= 1; o >>= 1) v += __shfl_xor(v, o);
    return v; }
__device__ __forceinline__ float wave_max(float v) {
#pragma unroll
    for (int o = 32; o >= 1; o >>= 1) v = fmaxf(v, __shfl_xor(v, o));
    return v; }

constexpr size_t MiB = 1u << 20;
constexpr size_t WS_CTL = 0, CTL_ZERO_BYTES = 65536;
constexpr size_t WS_MOD = 1 * MiB;
constexpr size_t WS_WTIN = 2 * MiB;
constexpr size_t WS_WTOUT = 10 * MiB;
constexpr size_t WS_X = 12 * MiB;
constexpr size_t WS_UF = 80 * MiB;
constexpr size_t WS_P = 114 * MiB;
constexpr size_t WS_GDNX = 226 * MiB;
constexpr size_t WS_VT = 230 * MiB;
constexpr size_t WS_RGS = 247 * MiB;
constexpr size_t WS_END = 250 * MiB;
constexpr size_t WS_RGWT = 1 * MiB + 576 * 1024;
constexpr size_t WS_RGTAB = 1 * MiB + 768 * 1024;
constexpr size_t WS_ROPE = 1 * MiB + 512 * 1024;
constexpr int LDS_BYTES = 147456;

struct Params { const void* ptr[22]; };

__device__ __forceinline__ void phase_mods(const float* c, const float* cctx, const float* w_mod, const float* b_mod, float* mod, LAS float* sc, int wid, int lane) {
    for (int item = blockIdx.x; item < DEPTH * 48; item += gridDim.x) {
        const int l = item / 48, n = (item % 48) * 64 + lane;
        float a0 = 0, a1 = 0, a2 = 0, a3 = 0, a4 = 0;
        const float* w = w_mod + (size_t)l * 1024 * 3072 + n;
        for (int k = wid * 128; k < wid * 128 + 128; ++k) {
            const float wv = w[(size_t)k * 3072];
            a0 += siluf_(c[k]) * wv; a1 += siluf_(c[1024 + k]) * wv; a2 += siluf_(c[2048 + k]) * wv; a3 += siluf_(c[3072 + k]) * wv; a4 += siluf_(cctx[k]) * wv;
        }
        sc[(wid * 5 + 0) * 64 + lane] = a0; sc[(wid * 5 + 1) * 64 + lane] = a1; sc[(wid * 5 + 2) * 64 + lane] = a2; sc[(wid * 5 + 3) * 64 + lane] = a3; sc[(wid * 5 + 4) * 64 + lane] = a4;
        __syncthreads();
        if (wid < 5) { float s = 0.f;
#pragma unroll
            for (int w8 = 0; w8 < 8; ++w8) s += sc[(w8 * 5 + wid) * 64 + lane];
            mod[(size_t)(l * 5 + wid) * 3072 + n] = s + b_mod[l * 3072 + n]; }
        __syncthreads();
    }
}
__device__ __forceinline__ void transpose_item(const float* W, int K, int N, int nblk, bf16_t* WT, LAS float* scr, int item, int lane) {
    const int kb = item / nblk, nb = item % nblk, k0 = 64 * kb, n0 = 32 * nb;
    const int nn = n0 + (lane & 31);
#pragma unroll 8
    for (int i = 0; i < 32; ++i) { const int kk = 2 * i + (lane >> 5); scr[kk * 33 + (lane & 31)] = nn < N ? W[(size_t)(k0 + kk) * N + nn] : 0.f; }
    LDS_WAIT();
    const int c = lane & 7;
#pragma unroll
    for (int j = 0; j < 4; ++j) { const int n = (lane >> 3) + 8 * j; const LAS float* s = scr + (8 * c) * 33 + n;
        v4u o; o.x = pk2(s[0 * 33], s[1 * 33]); o.y = pk2(s[2 * 33], s[3 * 33]); o.z = pk2(s[4 * 33], s[5 * 33]); o.w = pk2(s[6 * 33], s[7 * 33]);
        *(v4u*)(WT + (size_t)(n0 + n) * K + k0 + 8 * c) = o; }
    LDS_WAIT();
}
__device__ __forceinline__ void convert_weights(const float* w_in_l, const float* w_out_l, bf16_t* WTIN, bf16_t* WTOUT, LAS float* scr, int gw, int NGW, int lane) {
    constexpr int I_IN = 16 * 105, I_OUT = 16 * 32;
    for (int it = gw; it < I_IN + I_OUT; it += NGW) {
        if (it < I_IN) transpose_item(w_in_l, 1024, DIN, 105, WTIN, scr, it, lane);
        else transpose_item(w_out_l, 1024, 1024, 32, WTOUT, scr, it - I_IN, lane);
    }
}
__device__ __forceinline__ void convert_rg(const float* wa, const float* ba, const float* wx, const float* bx, const float* lam, bf16_t* RGWT, float* rgtab, int gtid, int ngt) {
    for (int idx = gtid; idx < 24 * 4096 + 768; idx += ngt) {
        if (idx < 24 * 4096) { const int dd = idx & 63, e = (idx >> 6) & 63, m = idx >> 12, kind = m & 1, dn = m >> 1;
            RGWT[idx] = (bf16_t)f2bf((kind ? wx : wa)[((size_t)dn * 64 + dd) * 64 + e]); }
        else { const int k = idx - 24 * 4096; rgtab[k] = ba[k]; rgtab[768 + k] = bx[k]; rgtab[1536 + k] = -8.0f * log1pf(expf(-lam[k])); }
    }
}
__device__ __forceinline__ void prep_rows0(const float* x, const float* ctx, const float* modl, bf16_t* U, int gw, int NGW, int lane) {
    for (int t = gw; t < T; t += NGW) {
        const int b = t / SEQT, sp = t - b * SEQT, j = sp < CTX ? 4 : b;
        const float* xs = sp < CTX ? ctx + ((size_t)b * CTX + sp) * D : x + ((size_t)b * SEQ + (sp - CTX)) * D;
        const float* sh = modl + j * 3072; const float* sc = sh + 1024;
#pragma unroll
        for (int q = 0; q < 4; ++q) { const int k = (q * 64 + lane) * 4; const f32x4 v = *(const f32x4*)(xs + k), s1 = *(const f32x4*)(sc + k), s0 = *(const f32x4*)(sh + k);
            const f32x4 u = v * (s1 + 1.0f) + s0; uint2 o; o.x = pk2(u[0], u[1]); o.y = pk2(u[2], u[3]); *(uint2*)(U + (size_t)t * D + k) = o; }
    }
}
__device__ __forceinline__ void ln_rows(float* X, const float* g, const float* bta, float* final_out, const float* modn, bf16_t* U, int gw, int NGW, int lane) {
    for (int t = gw; t < T; t += NGW) {
        const int b = t / SEQT, sp = t - b * SEQT, j = sp < CTX ? 4 : b;
        if (final_out && sp < CTX) continue;
        float* xr = X + (size_t)t * D;
        f32x4 v[4]; float s = 0.f;
#pragma unroll
        for (int q = 0; q < 4; ++q) { v[q] = *(const f32x4*)(xr + (q * 64 + lane) * 4); s += (v[q][0] + v[q][1]) + (v[q][2] + v[q][3]); }
        const float mean = wave_sum(s) * (1.0f / D); float s2 = 0.f;
#pragma unroll
        for (int q = 0; q < 4; ++q) { v[q] = v[q] - mean; s2 += (v[q][0] * v[q][0] + v[q][1] * v[q][1]) + (v[q][2] * v[q][2] + v[q][3] * v[q][3]); }
        const float rstd = rsqrtf(wave_sum(s2) * (1.0f / D) + 1e-5f);
#pragma unroll
        for (int q = 0; q < 4; ++q) { const int k = (q * 64 + lane) * 4; const f32x4 y = v[q] * rstd * *(const f32x4*)(g + k) + *(const f32x4*)(bta + k);
            if (final_out) *(f32x4*)(final_out + ((size_t)b * SEQ + (sp - CTX)) * D + k) = y;
            else { *(f32x4*)(xr + k) = y; const f32x4 u = y * (*(const f32x4*)(modn + j * 3072 + 1024 + k) + 1.0f) + *(const f32x4*)(modn + j * 3072 + k);
                uint2 o; o.x = pk2(u[0], u[1]); o.y = pk2(u[2], u[3]); *(uint2*)(U + (size_t)t * D + k) = o; } }
    }
}

__device__ __forceinline__ float conv_at(const bf16_t* P, const float* cw, int t, int c) {
    const int sp = t % SEQT;
    const int lo = sp < CTX ? 0 : CTX, hi = sp < CTX ? CTX : SEQT;
    float acc = 0.f;
#pragma unroll
    for (int j = 0; j < 4; ++j) { const int s2 = sp + j - 2; if (s2 >= lo && s2 < hi) acc += cw[j * CONV_CH + c] * bf2f(P[(size_t)(t + j - 2) * LDP + c]); }
    return acc;
}
__device__ __forceinline__ int step_to_sp(int step, int d) { return d == 0 ? step : (step < CTX ? CTX - 1 - step : SEQT - 1 - (step - CTX)); }

__device__ __forceinline__ void combine_rows(const bf16_t* P, const float* nw, bf16_t* F, int gw, int NGW, int lane) {
    for (int t = gw; t < T; t += NGW) {
#pragma unroll
        for (int hh = 0; hh < 4; ++hh) { const int c = hh * 64 + lane;
            const float o = bf2f(P[(size_t)t * LDP + C_QG + c]) + bf2f(P[(size_t)t * LDP + C_KG + c]);
            const float ms = wave_sum(o * o) * (1.0f / 64.0f);
            F[(size_t)t * 1024 + 768 + c] = (bf16_t)f2bf(o * rsqrtf(ms + 1e-6f) * nw[lane] * siluf_(bf2f(P[(size_t)t * LDP + C_ZG + c]))); }
    }
}


constexpr int LS = 72;
constexpr int G_KN = 0, G_KNT = 9216, G_QN = 18432, G_QK = 27648, G_XT = 36864, G_LM = 55296, G_SM = 72704, G_HALF = 73728;
constexpr int LMS = 68;
constexpr int GDN_ITEMS = NB * 4 * 2 * 68;
constexpr size_t GDN_ITEM_BYTES = 32768;
typedef short bf16x8_t __attribute__((ext_vector_type(8)));
typedef unsigned v2u __attribute__((ext_vector_type(2)));
typedef float f32x4_t __attribute__((ext_vector_type(4)));

typedef __bf16 bf16v2_t __attribute__((ext_vector_type(2)));
typedef float f32v2_t __attribute__((ext_vector_type(2)));
__device__ __forceinline__ unsigned cvtpk(float lo, float hi) { const f32v2_t v = {lo, hi}; return __builtin_bit_cast(unsigned, __builtin_convertvector(v, bf16v2_t)); }
__device__ __forceinline__ bf16x8_t lds_frag(const LAS unsigned char* base, int row, int col) { return *(const LAS bf16x8_t*)(base + (row * LS + col) * 2); }
__device__ __forceinline__ unsigned char* gdn_item_ptr(unsigned char* dout, unsigned char* wsx, int it) { return it < 2048 ? dout + (size_t)it * GDN_ITEM_BYTES : wsx + (size_t)(it - 2048) * GDN_ITEM_BYTES; }
__device__ __forceinline__ int gdn_sp(int c, int i, int d) {
    if (c < 4) { const int s = c * 64 + i; return d == 0 ? s : CTX - 1 - s; }
    const int s = (c - 4) * 64 + i; return d == 0 ? CTX + s : SEQT - 1 - s;
}

__device__ __forceinline__ void gdn_pass1(const bf16_t* P, const float* cw, const float* alog, const float* dtb, const float* rcos, const float* rsin,
                                          unsigned char* dout, unsigned char* wsx, LAS unsigned char* lds, int tid) {
    const int n_iter = (GDN_ITEMS + 2 * (int)gridDim.x - 1) / (2 * (int)gridDim.x);
#pragma unroll 1
    for (int iter = 0; iter < n_iter; ++iter) {
        int tidf = tid; asm volatile("" : "+v"(tidf));
        const int half = __builtin_amdgcn_readfirstlane(tidf >> 8), t256 = tidf & 255, w = __builtin_amdgcn_readfirstlane(t256 >> 6), lane = tidf & 63, g = lane >> 4, l15 = lane & 15;
        LAS unsigned char* hb = lds + half * G_HALF;
        LAS float* sm = (LAS float*)(hb + G_SM);
        LAS float* LM = (LAS float*)(hb + G_LM);
        const int it = (iter * (int)gridDim.x + (int)blockIdx.x) * 2 + half;
        const bool valid = it < GDN_ITEMS;
        const int c = it % 68, bhd = it / 68, d = bhd & 1, hh = (bhd >> 1) & 3, b = bhd >> 3;
        if (valid) {
            if (t256 < 64) {
                const int t2 = b * SEQT + gdn_sp(c, lane, d);
                const float beta = sigmoidf_(bf2f(P[(size_t)t2 * LDP + C_BR + d * 4 + hh]));
                const float gg = -expf(alog[d * 4 + hh]) * softplusf_(bf2f(P[(size_t)t2 * LDP + C_AR + d * 4 + hh]) + dtb[d * 4 + hh]);
                float G = gg;
#pragma unroll
                for (int o = 1; o < 64; o <<= 1) { const float v = __shfl_up(G, o); if (lane >= o) G += v; }
                const float gl = __shfl(G, 63);
                sm[lane] = beta; sm[64 + lane] = G; sm[128 + lane] = expf(G); sm[192 + lane] = expf(gl - G);
            }
        }
        const int i = t256 >> 2, qd = t256 & 3;
        float qv[16], kv[16], vv[16];
        if (valid) {
            const int sp = gdn_sp(c, i, d), t = b * SEQT + sp;
            const int lo = sp < CTX ? 0 : CTX, hi = sp < CTX ? CTX : SEQT;
#pragma unroll
            for (int e = 0; e < 16; ++e) { qv[e] = 0.f; kv[e] = 0.f; vv[e] = 0.f; }
#pragma unroll
            for (int j = 0; j < 4; ++j) {
                const int s2 = sp + j - 2;
                if (s2 >= lo && s2 < hi) {
                    const bf16_t* pr = P + (size_t)(t + j - 2) * LDP + hh * 64 + 16 * qd;
                    const float* wr_ = cw + j * CONV_CH + hh * 64 + 16 * qd;
#pragma unroll
                    for (int m3 = 0; m3 < 3; ++m3) {
                        const int cb = m3 == 0 ? C_QG : (m3 == 1 ? C_KG : C_VG);
                        const v4u a0 = *(const v4u*)(pr + cb), a1 = *(const v4u*)(pr + cb + 8);
                        const unsigned aw[8] = {a0.x, a0.y, a0.z, a0.w, a1.x, a1.y, a1.z, a1.w};
#pragma unroll
                        for (int e2 = 0; e2 < 8; ++e2) {
                            const float x0 = __uint_as_float(aw[e2] << 16), x1 = __uint_as_float(aw[e2] & 0xffff0000u);
                            const float w0 = wr_[cb + 2 * e2], w1 = wr_[cb + 2 * e2 + 1];
                            if (m3 == 0) { qv[2 * e2] += w0 * x0; qv[2 * e2 + 1] += w1 * x1; }
                            else if (m3 == 1) { kv[2 * e2] += w0 * x0; kv[2 * e2 + 1] += w1 * x1; }
                            else { vv[2 * e2] += w0 * x0; vv[2 * e2 + 1] += w1 * x1; }
                        }
                    }
                }
            }
            float sq = 0.f, sk = 0.f;
#pragma unroll
            for (int e = 0; e < 16; ++e) { qv[e] = siluf_(qv[e]); kv[e] = siluf_(kv[e]); vv[e] = siluf_(vv[e]); sq += qv[e] * qv[e]; sk += kv[e] * kv[e]; }
            sq += __shfl_xor(sq, 1); sq += __shfl_xor(sq, 2); sk += __shfl_xor(sk, 1); sk += __shfl_xor(sk, 2);
            const float rq = rsqrtf(sq + 1e-6f), rk = rsqrtf(sk + 1e-6f);
            const bool lat = sp >= CTX;
            const int s = sp - CTX, pos = qd < 2 ? (s >> 6) : (s & 63);
#pragma unroll
            for (int e = 0; e < 16; ++e) {
                float q1 = qv[e] * rq, k1 = kv[e] * rk;
                const float qp = __shfl_xor(q1, 1), kp = __shfl_xor(k1, 1);
                if (lat) { const float cs = rcos[pos * 16 + e], sn = rsin[pos * 16 + e];
                    if (qd & 1) { q1 = q1 * cs + qp * sn; k1 = k1 * cs + kp * sn; } else { q1 = q1 * cs - qp * sn; k1 = k1 * cs - kp * sn; } }
                qv[e] = q1 * 0.125f; kv[e] = k1;
            }
        }
        __syncthreads();
        if (valid) {
            const float beta = sm[i], eG = sm[128 + i], eGl = sm[192 + i];
            v4u o0, o1;
            o0.x = cvtpk(kv[0], kv[1]); o0.y = cvtpk(kv[2], kv[3]); o0.z = cvtpk(kv[4], kv[5]); o0.w = cvtpk(kv[6], kv[7]);
            o1.x = cvtpk(kv[8], kv[9]); o1.y = cvtpk(kv[10], kv[11]); o1.z = cvtpk(kv[12], kv[13]); o1.w = cvtpk(kv[14], kv[15]);
            *(LAS v4u*)(hb + G_KN + (i * LS + 16 * qd) * 2) = o0; *(LAS v4u*)(hb + G_KN + (i * LS + 16 * qd + 8) * 2) = o1;
            o0.x = cvtpk(qv[0], qv[1]); o0.y = cvtpk(qv[2], qv[3]); o0.z = cvtpk(qv[4], qv[5]); o0.w = cvtpk(qv[6], qv[7]);
            o1.x = cvtpk(qv[8], qv[9]); o1.y = cvtpk(qv[10], qv[11]); o1.z = cvtpk(qv[12], qv[13]); o1.w = cvtpk(qv[14], qv[15]);
            *(LAS v4u*)(hb + G_QN + (i * LS + 16 * qd) * 2) = o0; *(LAS v4u*)(hb + G_QN + (i * LS + 16 * qd + 8) * 2) = o1;
            const float bw = beta * eG;
#pragma unroll
            for (int e = 0; e < 16; ++e) {
                const int f = 16 * qd + e;
                *(LAS bf16_t*)(hb + G_KNT + (f * LS + i) * 2) = (bf16_t)f2bf(kv[e] * eGl);
                *(LAS bf16_t*)(hb + G_XT + (f * LS + i) * 2) = (bf16_t)f2bf(beta * vv[e]);
                *(LAS bf16_t*)(hb + G_XT + ((64 + f) * LS + i) * 2) = (bf16_t)f2bf(bw * kv[e]);
            }
        }
        __syncthreads();
        if (valid) {
            const bf16x8_t ak0 = lds_frag(hb + G_KN, 16 * w + l15, 8 * g), ak1 = lds_frag(hb + G_KN, 16 * w + l15, 32 + 8 * g);
            const bf16x8_t aq0 = lds_frag(hb + G_QN, 16 * w + l15, 8 * g), aq1 = lds_frag(hb + G_QN, 16 * w + l15, 32 + 8 * g);
            const f32x4_t Gi = *(const LAS f32x4_t*)(sm + 64 + 16 * w + 4 * g), Bi = *(const LAS f32x4_t*)(sm + 16 * w + 4 * g);
#pragma unroll
            for (int nt = 0; nt < 4; ++nt) {
                const bf16x8_t b0 = lds_frag(hb + G_KN, 16 * nt + l15, 8 * g), b1 = lds_frag(hb + G_KN, 16 * nt + l15, 32 + 8 * g);
                f32x4_t kk = {0.f, 0.f, 0.f, 0.f}, qk = {0.f, 0.f, 0.f, 0.f};
                kk = __builtin_amdgcn_mfma_f32_16x16x32_bf16(ak0, b0, kk, 0, 0, 0); kk = __builtin_amdgcn_mfma_f32_16x16x32_bf16(ak1, b1, kk, 0, 0, 0);
                qk = __builtin_amdgcn_mfma_f32_16x16x32_bf16(aq0, b0, qk, 0, 0, 0); qk = __builtin_amdgcn_mfma_f32_16x16x32_bf16(aq1, b1, qk, 0, 0, 0);
                const int jj = 16 * nt + l15; const float Gj = sm[64 + jj];
#pragma unroll
                for (int r = 0; r < 4; ++r) {
                    const int ii = 16 * w + 4 * g + r;
                    const float e = expf(fminf(Gi[r] - Gj, 0.f));
                    LM[ii * LMS + jj] = jj < ii ? Bi[r] * kk[r] * e : 0.f;
                    *(LAS bf16_t*)(hb + G_QK + (ii * LS + jj) * 2) = (bf16_t)f2bf(jj <= ii ? qk[r] * e : 0.f);
                }
            }
        }
        __syncthreads();
        if (valid && w < 2) {
            const int col = 64 * w + lane;
            LAS unsigned char* xr = hb + G_XT + col * LS * 2;
            float x[64];
#pragma unroll
            for (int q8 = 0; q8 < 8; ++q8) { const v4u rv = *(const LAS v4u*)(xr + q8 * 16); const unsigned rw[4] = {rv.x, rv.y, rv.z, rv.w};
#pragma unroll
                for (int e = 0; e < 4; ++e) { x[q8 * 8 + 2 * e] = __uint_as_float(rw[e] << 16); x[q8 * 8 + 2 * e + 1] = __uint_as_float(rw[e] & 0xffff0000u); } }
#pragma unroll
            for (int ii = 1; ii < 64; ++ii) {
                float acc = x[ii];
#pragma unroll
                for (int j4 = 0; j4 < (ii + 3) / 4; ++j4) { const f32x4_t lv = *(const LAS f32x4_t*)(LM + ii * LMS + 4 * j4);
#define NFMA(l_, x_) asm("v_fma_f32 %0, -%1, %2, %0" : "+v"(acc) : "v"(l_), "v"(x_))
                    NFMA(lv[0], x[4 * j4]); if (4 * j4 + 1 < ii) NFMA(lv[1], x[4 * j4 + 1]); if (4 * j4 + 2 < ii) NFMA(lv[2], x[4 * j4 + 2]); if (4 * j4 + 3 < ii) NFMA(lv[3], x[4 * j4 + 3]); }
#undef NFMA
                x[ii] = acc;
            }
#pragma unroll
            for (int q8 = 0; q8 < 8; ++q8) { v4u o; o.x = cvtpk(x[q8 * 8], x[q8 * 8 + 1]); o.y = cvtpk(x[q8 * 8 + 2], x[q8 * 8 + 3]); o.z = cvtpk(x[q8 * 8 + 4], x[q8 * 8 + 5]); o.w = cvtpk(x[q8 * 8 + 6], x[q8 * 8 + 7]);
                *(LAS v4u*)(xr + q8 * 16) = o; }
        }
        __syncthreads();
        if (valid) {
            unsigned char* blk = gdn_item_ptr(dout, wsx, it);
            bf16_t* gM = (bf16_t*)blk; bf16_t* gP = gM + 4096; bf16_t* gN = gM + 8192; bf16_t* gQ = gM + 12288;
            const bf16x8_t akd0 = lds_frag(hb + G_KNT, 16 * w + l15, 8 * g), akd1 = lds_frag(hb + G_KNT, 16 * w + l15, 32 + 8 * g);
            const bf16x8_t aqk0 = lds_frag(hb + G_QK, 16 * w + l15, 8 * g), aqk1 = lds_frag(hb + G_QK, 16 * w + l15, 32 + 8 * g);
            const bf16x8_t aw0 = lds_frag(hb + G_XT, 64 + 16 * w + l15, 8 * g), aw1 = lds_frag(hb + G_XT, 64 + 16 * w + l15, 32 + 8 * g);
            const float egl = sm[128 + 63];
            const int pcol = 16 * w + 4 * g;
#pragma unroll
            for (int nt = 0; nt < 4; ++nt) {
                const bf16x8_t bu0 = lds_frag(hb + G_XT, 16 * nt + l15, 8 * g), bu1 = lds_frag(hb + G_XT, 16 * nt + l15, 32 + 8 * g);
                f32x4_t nn = {0.f, 0.f, 0.f, 0.f}, qm = {0.f, 0.f, 0.f, 0.f};
                nn = __builtin_amdgcn_mfma_f32_16x16x32_bf16(akd0, bu0, nn, 0, 0, 0); nn = __builtin_amdgcn_mfma_f32_16x16x32_bf16(akd1, bu1, nn, 0, 0, 0);
                qm = __builtin_amdgcn_mfma_f32_16x16x32_bf16(aqk0, bu0, qm, 0, 0, 0); qm = __builtin_amdgcn_mfma_f32_16x16x32_bf16(aqk1, bu1, qm, 0, 0, 0);
                const int cc = 16 * nt + l15;
                v2u o; o.x = cvtpk(nn[0], nn[1]); o.y = cvtpk(nn[2], nn[3]); *(v2u*)(gN + cc * 64 + 16 * w + 4 * g) = o;
                o.x = cvtpk(qm[0], qm[1]); o.y = cvtpk(qm[2], qm[3]); *(v2u*)(gQ + cc * 64 + 16 * w + 4 * g) = o;
                const bf16x8_t bk0 = lds_frag(hb + G_KNT, 16 * nt + l15, 8 * g), bk1 = lds_frag(hb + G_KNT, 16 * nt + l15, 32 + 8 * g);
                const bf16x8_t bq0 = lds_frag(hb + G_QK, 16 * nt + l15, 8 * g), bq1 = lds_frag(hb + G_QK, 16 * nt + l15, 32 + 8 * g);
                f32x4_t mm = {0.f, 0.f, 0.f, 0.f}, pm = {0.f, 0.f, 0.f, 0.f};
                mm = __builtin_amdgcn_mfma_f32_16x16x32_bf16(aw0, bk0, mm, 0, 0, 0); mm = __builtin_amdgcn_mfma_f32_16x16x32_bf16(aw1, bk1, mm, 0, 0, 0);
                pm = __builtin_amdgcn_mfma_f32_16x16x32_bf16(aw0, bq0, pm, 0, 0, 0); pm = __builtin_amdgcn_mfma_f32_16x16x32_bf16(aw1, bq1, pm, 0, 0, 0);
                const int frow = 16 * nt + l15;
                float mv[4], pv[4];
                const v2u qraw = *(const LAS v2u*)(hb + G_QN + (frow * LS + 16 * w + 4 * g) * 2);
                const float qf[4] = {__uint_as_float(qraw.x << 16), __uint_as_float(qraw.x & 0xffff0000u), __uint_as_float(qraw.y << 16), __uint_as_float(qraw.y & 0xffff0000u)};
                const float eGi = sm[128 + frow];
#pragma unroll
                for (int r = 0; r < 4; ++r) { mv[r] = ((16 * w + 4 * g + r) == frow ? egl : 0.f) - mm[r]; pv[r] = qf[r] * eGi - pm[r]; }
                o.x = cvtpk(mv[0], mv[1]); o.y = cvtpk(mv[2], mv[3]); *(v2u*)(gM + frow * 64 + pcol) = o;
                o.x = cvtpk(pv[0], pv[1]); o.y = cvtpk(pv[2], pv[3]); *(v2u*)(gP + frow * 64 + pcol) = o;
            }
        }
        __syncthreads();
    }
}

__device__ __forceinline__ void gdn_chain(unsigned char* dout, unsigned char* wsx, bf16_t* Pw, int bhd, bool valid, LAS unsigned char* sbuf, int w, int lane) {
    const int d = bhd & 1, hh = (bhd >> 1) & 3, b = bhd >> 3, g = lane >> 4, l15 = lane & 15;
    bf16_t* O = Pw + (d == 0 ? C_QG : C_KG) + hh * 64 + l15;
    bf16x8_t aM[4][2], aP[4][2]; v2u nN[4][4], nQ[4][4];
#define GDN_LOAD(st_, c_) do { const bf16_t* blk_ = (const bf16_t*)gdn_item_ptr(dout, wsx, bhd * 68 + (c_)); \
        _Pragma("unroll") for (int s = 0; s < 2; ++s) { aM[st_][s] = *(const bf16x8_t*)(blk_ + (16 * w + l15) * 64 + 32 * s + 8 * g); aP[st_][s] = *(const bf16x8_t*)(blk_ + 4096 + (16 * w + l15) * 64 + 32 * s + 8 * g); } \
        _Pragma("unroll") for (int nt = 0; nt < 4; ++nt) { nN[st_][nt] = *(const v2u*)(blk_ + 8192 + (16 * nt + l15) * 64 + 16 * w + 4 * g); nQ[st_][nt] = *(const v2u*)(blk_ + 12288 + (16 * nt + l15) * 64 + 16 * w + 4 * g); } } while (0)
    if (valid) {
#pragma unroll
        for (int nt = 0; nt < 4; ++nt) *(LAS v2u*)(sbuf + ((16 * nt + l15) * LS + 16 * w + 4 * g) * 2) = (v2u){0u, 0u};
        GDN_LOAD(0, 0); GDN_LOAD(1, 1); GDN_LOAD(2, 2); GDN_LOAD(3, 3);
    }
    __syncthreads();
#pragma unroll 1
    for (int c4 = 0; c4 < 17; ++c4) {
#pragma unroll
        for (int u = 0; u < 4; ++u) {
            const int c = 4 * c4 + u;
            if (valid) {
                const LAS unsigned char* rb = sbuf + (c & 1) * 9216; LAS unsigned char* wb = sbuf + ((c + 1) & 1) * 9216;
                f32x4_t Sn[4], Oc[4];
#pragma unroll
                for (int nt = 0; nt < 4; ++nt) {
                    const bf16x8_t b0 = lds_frag(rb, 16 * nt + l15, 8 * g), b1 = lds_frag(rb, 16 * nt + l15, 32 + 8 * g);
                    Sn[nt] = (f32x4_t){__uint_as_float(nN[u][nt].x << 16), __uint_as_float(nN[u][nt].x & 0xffff0000u), __uint_as_float(nN[u][nt].y << 16), __uint_as_float(nN[u][nt].y & 0xffff0000u)};
                    Oc[nt] = (f32x4_t){__uint_as_float(nQ[u][nt].x << 16), __uint_as_float(nQ[u][nt].x & 0xffff0000u), __uint_as_float(nQ[u][nt].y << 16), __uint_as_float(nQ[u][nt].y & 0xffff0000u)};
                    Sn[nt] = __builtin_amdgcn_mfma_f32_16x16x32_bf16(aM[u][0], b0, Sn[nt], 0, 0, 0); Sn[nt] = __builtin_amdgcn_mfma_f32_16x16x32_bf16(aM[u][1], b1, Sn[nt], 0, 0, 0);
                    Oc[nt] = __builtin_amdgcn_mfma_f32_16x16x32_bf16(aP[u][0], b0, Oc[nt], 0, 0, 0); Oc[nt] = __builtin_amdgcn_mfma_f32_16x16x32_bf16(aP[u][1], b1, Oc[nt], 0, 0, 0);
                }
#pragma unroll
                for (int nt = 0; nt < 4; ++nt) { v2u o; o.x = cvtpk(Sn[nt][0], Sn[nt][1]); o.y = cvtpk(Sn[nt][2], Sn[nt][3]); *(LAS v2u*)(wb + ((16 * nt + l15) * LS + 16 * w + 4 * g) * 2) = o; }
                if (c + 4 < 68) GDN_LOAD(u, c + 4);
#pragma unroll
                for (int r = 0; r < 4; ++r) { const int t = b * SEQT + gdn_sp(c, 16 * w + 4 * g + r, d);
#pragma unroll
                    for (int nt = 0; nt < 4; ++nt) O[(size_t)t * LDP + 16 * nt] = (bf16_t)f2bf(Oc[nt][r]); }
            }
            __syncthreads();
        }
    }
#undef GDN_LOAD
}

constexpr int R_U = 0, R_A = 9216, R_B0 = R_A + 17408, R_B1 = R_B0 + 17408;
constexpr int RS = 68;
constexpr int RG_ITEMS = NB * 68 * 6;
constexpr int RG_SUM = 2 * NB * 68 * 384;

template <int MODE>
__device__ __forceinline__ void rg_pass(const bf16_t* P, const float* cw, const bf16_t* RGWT, const float* rgtab  ,
                                        float* SUMA, float* SUMH, const float* HIN, bf16_t* F, LAS unsigned char* lds, int tid) {
    const int n_iter = (RG_ITEMS + 2 * (int)gridDim.x - 1) / (2 * (int)gridDim.x);
#pragma unroll 1
    for (int iter = 0; iter < n_iter; ++iter) {
        int tidf = tid; asm volatile("" : "+v"(tidf));
        const int half = __builtin_amdgcn_readfirstlane(tidf >> 8), t256 = tidf & 255, w = __builtin_amdgcn_readfirstlane(t256 >> 6), lane = tidf & 63, g = lane >> 4, l15 = lane & 15;
        LAS unsigned char* hb = lds + half * G_HALF;
        LAS float* Aa = (LAS float*)(hb + R_A);
        const int it = (iter * (int)gridDim.x + (int)blockIdx.x) * 2 + half;
        const bool valid = it < RG_ITEMS;
        const int n = it % 6, tc = (it / 6) % 68, b = it / 408;
        const int i = t256 >> 2, qd = t256 & 3;
        const int t = b * SEQT + tc * 64 + i;
        if (valid) {
            const int sp = tc * 64 + i, lo = sp < CTX ? 0 : CTX, hi = sp < CTX ? CTX : SEQT;
            float u[16];
#pragma unroll
            for (int e = 0; e < 16; ++e) u[e] = 0.f;
#pragma unroll
            for (int j = 0; j < 4; ++j) { const int s2 = sp + j - 2;
                if (s2 >= lo && s2 < hi) { const bf16_t* pr = P + (size_t)(t + j - 2) * LDP + C_XA + n * 64 + 16 * qd; const float* wr_ = cw + j * CONV_CH + C_XA + n * 64 + 16 * qd;
                    const v4u a0 = *(const v4u*)pr, a1 = *(const v4u*)(pr + 8); const unsigned aw[8] = {a0.x, a0.y, a0.z, a0.w, a1.x, a1.y, a1.z, a1.w};
#pragma unroll
                    for (int e2 = 0; e2 < 8; ++e2) { u[2 * e2] += wr_[2 * e2] * __uint_as_float(aw[e2] << 16); u[2 * e2 + 1] += wr_[2 * e2 + 1] * __uint_as_float(aw[e2] & 0xffff0000u); } } }
            v4u o0, o1;
            o0.x = cvtpk(u[0], u[1]); o0.y = cvtpk(u[2], u[3]); o0.z = cvtpk(u[4], u[5]); o0.w = cvtpk(u[6], u[7]);
            o1.x = cvtpk(u[8], u[9]); o1.y = cvtpk(u[10], u[11]); o1.z = cvtpk(u[12], u[13]); o1.w = cvtpk(u[14], u[15]);
            *(LAS v4u*)(hb + R_U + (i * LS + 16 * qd) * 2) = o0; *(LAS v4u*)(hb + R_U + (i * LS + 16 * qd + 8) * 2) = o1;
        }
        __syncthreads();
#pragma unroll
        for (int d = 0; d < 2; ++d) {
            LAS float* Bd = (LAS float*)(hb + (d == 0 ? R_B0 : R_B1));
            if (valid) {
                const bf16x8_t a0 = lds_frag(hb + R_U, 16 * w + l15, 8 * g), a1 = lds_frag(hb + R_U, 16 * w + l15, 32 + 8 * g);
                const bf16_t* wa_t = RGWT + (size_t)((d * 6 + n) * 2) * 4096; const bf16_t* wx_t = wa_t + 4096;
#pragma unroll
                for (int nt = 0; nt < 4; ++nt) {
                    const int e = 16 * nt + l15, ch = n * 64 + e;
                    const bf16x8_t ba0 = *(const bf16x8_t*)(wa_t + e * 64 + 8 * g), ba1 = *(const bf16x8_t*)(wa_t + e * 64 + 32 + 8 * g);
                    const bf16x8_t bx0 = *(const bf16x8_t*)(wx_t + e * 64 + 8 * g), bx1 = *(const bf16x8_t*)(wx_t + e * 64 + 32 + 8 * g);
                    f32x4_t ra = {0.f, 0.f, 0.f, 0.f}, ri = {0.f, 0.f, 0.f, 0.f};
                    ra = __builtin_amdgcn_mfma_f32_16x16x32_bf16(a0, ba0, ra, 0, 0, 0); ra = __builtin_amdgcn_mfma_f32_16x16x32_bf16(a1, ba1, ra, 0, 0, 0);
                    ri = __builtin_amdgcn_mfma_f32_16x16x32_bf16(a0, bx0, ri, 0, 0, 0); ri = __builtin_amdgcn_mfma_f32_16x16x32_bf16(a1, bx1, ri, 0, 0, 0);
                    const float bav = rgtab[d * 384 + ch], bxv = rgtab[768 + d * 384 + ch], ls8 = rgtab[1536 + d * 384 + ch];
#pragma unroll
                    for (int r = 0; r < 4; ++r) {
                        const int tok = 16 * w + 4 * g + r;
                        const float uu = bf2f(*(const LAS bf16_t*)(hb + R_U + (tok * LS + e) * 2));
                        const float rr = 1.0f / (1.0f + __expf(-(ra[r] + bav))), ig = 1.0f / (1.0f + __expf(-(ri[r] + bxv)));
                        const float log_a = rr * ls8, y = 2.0f * log_a;
                        const float om = -y * (1.0f + y * (0.5f + y * ((1.0f / 6.0f) + y * ((1.0f / 24.0f) + y * ((1.0f / 120.0f) + y * ((1.0f / 720.0f) + y * (1.0f / 5040.0f)))))));
                        Aa[tok * RS + e] = expf(log_a); Bd[tok * RS + e] = sqrtf(om) * (ig * uu);
                    }
                }
            }
            __syncthreads();
            if (valid && w == 0) {
                const int ch = n * 64 + lane; const size_t si = ((size_t)(d * NB + b) * 68 + tc) * 384 + ch;
                float h = MODE == 3 ? HIN[si] : 0.f, ap = 1.f;
#pragma unroll 8
                for (int step = 0; step < 64; ++step) { const int tok = d ? 63 - step : step; const float a = Aa[tok * RS + lane];
                    h = a * h + Bd[tok * RS + lane]; if (MODE == 3) Bd[tok * RS + lane] = h; else ap *= a; }
                if (MODE == 1) { SUMA[si] = ap; SUMH[si] = h; }
            }
            __syncthreads();
        }
        if (MODE == 3 && valid) {
            const LAS float* B0 = (const LAS float*)(hb + R_B0); const LAS float* B1 = (const LAS float*)(hb + R_B1);
            const bf16_t* zp = P + (size_t)t * LDP + C_ZA + n * 64 + 16 * qd;
            const v4u z0 = *(const v4u*)zp, z1 = *(const v4u*)(zp + 8); const unsigned zw[8] = {z0.x, z0.y, z0.z, z0.w, z1.x, z1.y, z1.z, z1.w};
            unsigned ow[8];
#pragma unroll
            for (int e2 = 0; e2 < 8; ++e2) { const int e = 16 * qd + 2 * e2;
                const float h0 = B0[i * RS + e] + B1[i * RS + e], h1 = B0[i * RS + e + 1] + B1[i * RS + e + 1];
                ow[e2] = cvtpk(h0 * siluf_(__uint_as_float(zw[e2] << 16)), h1 * siluf_(__uint_as_float(zw[e2] & 0xffff0000u))); }
            v4u o0 = {ow[0], ow[1], ow[2], ow[3]}, o1 = {ow[4], ow[5], ow[6], ow[7]};
            bf16_t* fp = F + (size_t)t * 1024 + n * 64 + 16 * qd;
            *(v4u*)fp = o0; *(v4u*)(fp + 8) = o1;
        }
        __syncthreads();
    }
}
__device__ __forceinline__ void rg_carry(const float* SUMA, const float* SUMH, float* HIN, int idx) {
    const int ch = idx % 384, b = (idx / 384) % NB, d = idx / (384 * NB);
    const size_t base = ((size_t)(d * NB + b) * 68) * 384 + ch;
    float h = 0.f;
#pragma unroll 4
    for (int s = 0; s < 68; ++s) { const int tc = d == 0 ? s : (s < 4 ? 3 - s : 71 - s);
        const size_t k = base + (size_t)tc * 384; HIN[k] = h; h = SUMA[k] * h + SUMH[k]; }
}

constexpr int NA_LAT_ITEMS = NB * 6 * 64 * 4, NA_CTX_ITEMS = NB * 6 * 16;
__device__ __forceinline__ void na_mfma_item(const bf16_t* P, const bf16_t* VT, const LAS float* rpbl, bf16_t* F, int item, int lane) {
    const int g = lane >> 4, l15 = lane & 15;
    const bool latent = item < NA_LAT_ITEMS;
    int b, hh, r, qb;
    if (latent) { qb = item & 3; r = (item >> 2) & 63; const int bh = item >> 8; hh = bh % 6; b = bh / 6; }
    else { const int it2 = item - NA_LAT_ITEMS; qb = it2 & 15; const int bh = it2 >> 4; hh = bh % 6; b = bh / 6; r = 0; }
    const int tq = latent ? b * SEQT + CTX + r * 64 + 16 * qb + l15 : b * SEQT + 16 * qb + l15;
    const bf16_t* qp = P + (size_t)tq * LDP + C_QN + hh * 64 + 8 * g;
    const bf16x8_t bq0 = *(const bf16x8_t*)qp, bq1 = *(const bf16x8_t*)(qp + 32);
    const int c0 = qb == 0 ? 0 : (qb == 1 ? 8 : (qb == 2 ? 24 : 32));
    const int r0 = min(max(r - 4, 0), 56), jq = 16 * qb + l15, cs = min(max(jq - 8, 0), 48);
    const int ia = 8 * (l15 >> 2) + (l15 & 3);
    float sc[16][8];
#pragma unroll
    for (int G = 0; G < 16; ++G) {
        const bool loc = G < 8;
        if (loc && !latent) {
#pragma unroll
            for (int e = 0; e < 8; ++e) sc[G][e] = -1e30f;
            continue; }
        const int tok0 = loc ? b * SEQT + CTX + (r0 + G) * 64 + c0 : b * SEQT + 32 * (G - 8);
        const bf16_t* ka = P + (size_t)(tok0 + ia) * LDP + C_KN + hh * 64 + 8 * g; const bf16_t* kb = ka + 4 * LDP;
        const bf16x8_t aa0 = *(const bf16x8_t*)ka, aa1 = *(const bf16x8_t*)(ka + 32), ab0 = *(const bf16x8_t*)kb, ab1 = *(const bf16x8_t*)(kb + 32);
        f32x4_t sa = {0.f, 0.f, 0.f, 0.f}, sb = {0.f, 0.f, 0.f, 0.f};
        sa = __builtin_amdgcn_mfma_f32_16x16x32_bf16(aa0, bq0, sa, 0, 0, 0); sa = __builtin_amdgcn_mfma_f32_16x16x32_bf16(aa1, bq1, sa, 0, 0, 0);
        sb = __builtin_amdgcn_mfma_f32_16x16x32_bf16(ab0, bq0, sb, 0, 0, 0); sb = __builtin_amdgcn_mfma_f32_16x16x32_bf16(ab1, bq1, sb, 0, 0, 0);
#pragma unroll
        for (int e = 0; e < 8; ++e) {
            float v = (e < 4 ? sa[e & 3] : sb[e & 3]) * 0.125f;
            if (loc) { const int kc = c0 + 8 * g + e; const bool ok = kc >= cs && kc < cs + 16;
                const float bias = rpbl[hh * 465 + (r0 + G - r + 7) * 31 + (ok ? kc - jq + 15 : 0)];
                v = ok ? v + bias : -1e30f; }
            sc[G][e] = v;
        }
    }
    float m = -1e30f;
#pragma unroll
    for (int G = 0; G < 16; ++G)
#pragma unroll
        for (int e = 0; e < 8; ++e) m = fmaxf(m, sc[G][e]);
    m = fmaxf(m, __shfl_xor(m, 16)); m = fmaxf(m, __shfl_xor(m, 32));
    f32x4_t o[4]; float lsum = 0.f;
#pragma unroll
    for (int dt = 0; dt < 4; ++dt) o[dt] = (f32x4_t){0.f, 0.f, 0.f, 0.f};
    const bf16_t* vbase = VT + (size_t)(hh * 64 + l15) * T + 8 * g;
#pragma unroll
    for (int G = 0; G < 16; ++G) {
        const bool loc = G < 8;
        if (loc && !latent) continue;
        const int tok0 = loc ? b * SEQT + CTX + (r0 + G) * 64 + c0 : b * SEQT + 32 * (G - 8);
        float pv[8];
#pragma unroll
        for (int e = 0; e < 8; ++e) { pv[e] = __expf(sc[G][e] - m); lsum += pv[e]; }
        v4u pk; pk.x = cvtpk(pv[0], pv[1]); pk.y = cvtpk(pv[2], pv[3]); pk.z = cvtpk(pv[4], pv[5]); pk.w = cvtpk(pv[6], pv[7]);
        const bf16x8_t bp = __builtin_bit_cast(bf16x8_t, pk);
#pragma unroll
        for (int dt = 0; dt < 4; ++dt) { const bf16x8_t av = *(const bf16x8_t*)(vbase + (size_t)(16 * dt) * T + tok0);
            o[dt] = __builtin_amdgcn_mfma_f32_16x16x32_bf16(av, bp, o[dt], 0, 0, 0); }
    }
    lsum += __shfl_xor(lsum, 16); lsum += __shfl_xor(lsum, 32);
    const float inv = 1.0f / lsum;
#pragma unroll
    for (int dt = 0; dt < 4; ++dt) {
        const v2u zr = *(const v2u*)(P + (size_t)tq * LDP + C_ZN + hh * 64 + 16 * dt + 4 * g);
        const float z0 = __uint_as_float(zr.x << 16), z1 = __uint_as_float(zr.x & 0xffff0000u), z2 = __uint_as_float(zr.y << 16), z3 = __uint_as_float(zr.y & 0xffff0000u);
        v2u ov; ov.x = cvtpk(o[dt][0] * inv * siluf_(z0), o[dt][1] * inv * siluf_(z1)); ov.y = cvtpk(o[dt][2] * inv * siluf_(z2), o[dt][3] * inv * siluf_(z3));
        *(v2u*)(F + (size_t)tq * 1024 + 384 + hh * 64 + 16 * dt + 4 * g) = ov;
    }
}
__device__ __forceinline__ void vt_transpose(const bf16_t* P, bf16_t* VT, LAS unsigned char* scr, int gw, int NGW, int lane) {
    for (int it = gw; it < NB * 68 * 6; it += NGW) {
        const int hh = it % 6, tcb = it / 6, t0 = (tcb / 68) * SEQT + (tcb % 68) * 64;
        const bf16_t* src = P + (size_t)(t0 + lane) * LDP + C_VN + hh * 64;
#pragma unroll
        for (int q8 = 0; q8 < 8; ++q8) *(LAS v4u*)(scr + (lane * LS + 8 * q8) * 2) = *(const v4u*)(src + 8 * q8);
        LDS_WAIT();
        bf16_t* dst = VT + (size_t)(hh * 64 + lane) * T + t0;
#pragma unroll
        for (int q8 = 0; q8 < 8; ++q8) { unsigned w4[4];
#pragma unroll
            for (int e2 = 0; e2 < 4; ++e2) { const unsigned lo = *(const LAS bf16_t*)(scr + ((8 * q8 + 2 * e2) * LS + lane) * 2), hi = *(const LAS bf16_t*)(scr + ((8 * q8 + 2 * e2 + 1) * LS + lane) * 2); w4[e2] = lo | (hi << 16); }
            v4u o = {w4[0], w4[1], w4[2], w4[3]}; *(v4u*)(dst + 8 * q8) = o; }
        LDS_WAIT();
    }
}
__device__ __forceinline__ int opq(int i) { asm volatile("" : "+s"(i)); return i; }
#define IN(i) ((const float*)p.ptr[opq(i)])
#define WSB ((unsigned char*)p.ptr[opq(21)])
#define OUTP ((float*)p.ptr[opq(20)])
#define ctl ((unsigned*)(WSB + WS_CTL))
#define mod ((float*)(WSB + WS_MOD))
#define WTIN ((bf16_t*)(WSB + WS_WTIN))
#define WTOUT ((bf16_t*)(WSB + WS_WTOUT))
#define X ((float*)(WSB + WS_X))
#define UF ((bf16_t*)(WSB + WS_UF))
#define P ((bf16_t*)(WSB + WS_P))
#define gdn0 ((unsigned char*)OUTP)
#define gdnx (WSB + WS_GDNX)
#define VT ((bf16_t*)(WSB + WS_VT))
#define rcos ((float*)(WSB + WS_ROPE))
#define rsin ((float*)(WSB + WS_ROPE) + 1024)
#define RGWT ((bf16_t*)(WSB + WS_RGWT))
#define rgtab ((float*)(WSB + WS_RGTAB))
#define SUMA ((float*)(WSB + WS_RGS))
#define SUMH ((float*)(WSB + WS_RGS) + (1 << 18))
#define HIN ((float*)(WSB + WS_RGS) + (2 << 18))
__device__ __forceinline__ int fresh_v(int v) { asm volatile("" : "+v"(v)); return v; }
enum { I_X = 0, I_C, I_CTX, I_CCTX, I_WMOD, I_BMOD, I_WIN, I_CONVW, I_RGWA, I_RGBA, I_RGWX, I_RGBX, I_RGLAM, I_RPB, I_ALOG, I_DTB, I_NW, I_WOUT, I_LNG, I_LNB };
__global__ void __launch_bounds__(512, 2) mega_fwd(Params p) {
    extern __shared__ __attribute__((aligned(16))) unsigned char lds_raw[];
    LAS unsigned char* lds = (LAS unsigned char*)lds_raw;
    cg::grid_group grid = cg::this_grid();
    const int bid = (int)blockIdx.x; __builtin_assume(bid >= 0 && bid < 256);
    const int tid = threadIdx.x, lane0 = tid & 63, wid = __builtin_amdgcn_readfirstlane(tid >> 6);
    const int gw0 = blockIdx.x * 8 + wid, NGW = gridDim.x * 8;
    const int lane = lane0, gw = gw0;
    LAS float* wscr = (LAS float*)(lds + wid * 16384);

    phase_mods(IN(I_C), IN(I_CCTX), IN(I_WMOD), IN(I_BMOD), mod, (LAS float*)lds, wid, lane);
    convert_weights(IN(I_WIN), IN(I_WOUT), WTIN, WTOUT, wscr, gw, NGW, lane);
    convert_rg(IN(I_RGWA), IN(I_RGBA), IN(I_RGWX), IN(I_RGBX), IN(I_RGLAM), RGWT, rgtab, (int)blockIdx.x * 512 + tid, (int)gridDim.x * 512);
    if (blockIdx.x == 0) { for (int e = tid; e < 1024; e += 512) { const float ang = (float)(e >> 4) * expf(-(float)(e & 15) * (9.210340371976184f / 16.0f)); rcos[e] = cosf(ang); rsin[e] = sinf(ang); } }
    grid.sync();
    prep_rows0(IN(I_X), IN(I_CTX), mod, UF, gw, NGW, lane);
    grid.sync();
#pragma unroll 1
    for (int l = 0; l < DEPTH; ++l) {
        const float* modl = mod + (size_t)l * 5 * 3072;
        { pg8::Gemm g{UF, WTIN, T, NPAD, D}; pg8::StaticOrder S; S.init(T, NPAD, 256, bid);
          pg8::EpiP E{P};
#ifndef ABL_G1
          pg8::gemm_phase<pg8::EpiP, pg8::StaticOrder, true, true>(lds, g, S, E);
#endif
        }
        grid.sync();
#ifndef ABL_P1
        gdn_pass1(P, IN(I_CONVW) + (size_t)l * 4 * CONV_CH, IN(I_ALOG) + l * 8, IN(I_DTB) + l * 8, rcos, rsin, gdn0, gdnx, lds, fresh_v(tid));
#endif
        rg_pass<1>(P, IN(I_CONVW) + (size_t)l * 4 * CONV_CH, RGWT, rgtab, SUMA, SUMH, nullptr, nullptr, lds, fresh_v(tid));
        vt_transpose(P, VT, lds + wid * 16384, opq(gw0), NGW, fresh_v(lane0));
        grid.sync();
        { const int lane = fresh_v(lane0);
            const float* rpb = IN(I_RPB) + (size_t)l * 6 * 15 * 31;
            for (int e = fresh_v(tid); e < 6 * 465; e += 512) ((LAS float*)lds)[e] = rpb[e];
            __syncthreads();
#ifndef ABL_CH
            if (blockIdx.x < 16) gdn_chain(gdn0, gdnx, P, (int)blockIdx.x * 2 + (wid >> 2), true, lds + 65536 + (wid >> 2) * 18432, wid & 3, lane);
#endif
            if (blockIdx.x >= 16 && blockIdx.x < 22) rg_carry(SUMA, SUMH, HIN, ((int)blockIdx.x - 16) * 512 + fresh_v(tid));
            const int n_items = NA_LAT_ITEMS + (l < DEPTH - 1 ? NA_CTX_ITEMS : 0);
            unsigned* cnt = ctl + 64 * (l + 1);
            for (;;) {
                int it = 0;
                if (lane == 0) it = (int)__hip_atomic_fetch_add(cnt, 1u, __ATOMIC_RELAXED, __HIP_MEMORY_SCOPE_AGENT);
                it = __builtin_amdgcn_readfirstlane(it);
                if (it >= n_items) break;
                na_mfma_item(P, VT, (const LAS float*)lds, UF, it, lane);
            }
        }
        grid.sync();
        rg_pass<3>(P, IN(I_CONVW) + (size_t)l * 4 * CONV_CH, RGWT, rgtab, nullptr, nullptr, HIN, UF, lds, fresh_v(tid));
        { const int lane = fresh_v(lane0); const int gw = opq(gw0); combine_rows(P, IN(I_NW) + l * 64, UF, gw, NGW, lane); }
        grid.sync();
        { pg8::Gemm g{UF, WTOUT, T, D, D}; pg8::StaticOrder S; S.init(T, D, 256, bid);
          pg8::EpiZ E{IN(I_X), IN(I_CTX), X, modl, l == 0 ? 1 : 0};
#ifndef ABL_G2
          pg8::gemm_phase<pg8::EpiZ, pg8::StaticOrder, true, true>(lds, g, S, E);
#endif
        }
        grid.sync();
        if (l < DEPTH - 1) { const int lane = fresh_v(lane0); const int gw = opq(gw0);
            ln_rows(X, IN(I_LNG) + l * D, IN(I_LNB) + l * D, nullptr, mod + (size_t)(l + 1) * 5 * 3072, UF, gw, NGW, lane);
            convert_weights(IN(I_WIN) + (size_t)(l + 1) * D * DIN, IN(I_WOUT) + (size_t)(l + 1) * D * D, WTIN, WTOUT, wscr, gw, NGW, lane);
            convert_rg(IN(I_RGWA) + (size_t)(l + 1) * 49152, IN(I_RGBA) + (l + 1) * 768, IN(I_RGWX) + (size_t)(l + 1) * 49152, IN(I_RGBX) + (l + 1) * 768, IN(I_RGLAM) + (l + 1) * 768, RGWT, rgtab, (int)blockIdx.x * 512 + fresh_v(tid), (int)gridDim.x * 512);
            grid.sync();
        } else { const int lane = fresh_v(lane0); const int gw = opq(gw0); ln_rows(X, IN(I_LNG) + l * D, IN(I_LNB) + l * D, OUTP, nullptr, nullptr, gw, NGW, lane); }
    }
}
#undef ctl
#undef mod
#undef WTIN
#undef WTOUT
#undef X
#undef UF
#undef P
#undef gdn0
#undef gdnx
#undef VT
#undef rcos
#undef rsin
#undef RGWT
#undef rgtab
#undef SUMA
#undef SUMH
#undef HIN
}

extern "C" void kernel_launch(void* const* d_in, const int* in_sizes, int n_in, void* d_out, int out_size, void* d_ws, size_t ws_size, hipStream_t stream) {
    static int grid = 0;
    if (grid == 0) {
        if (n_in != 20 || ws_size < WS_END) { fprintf(stderr, "kernel_launch: unexpected n_in %d / ws_size %zu\n", n_in, ws_size); grid = -1; return; }
        int dev = 0, cus = 0, per_cu = 0;
        hipGetDevice(&dev);
        hipDeviceGetAttribute(&cus, hipDeviceAttributeMultiprocessorCount, dev);
        if (hipFuncSetAttribute((const void*)mega_fwd, hipFuncAttributeMaxDynamicSharedMemorySize, LDS_BYTES) != hipSuccess) { fprintf(stderr, "kernel_launch: hipFuncSetAttribute failed\n"); grid = -1; return; }
        if (hipOccupancyMaxActiveBlocksPerMultiprocessor(&per_cu, (const void*)mega_fwd, 512, LDS_BYTES) != hipSuccess || per_cu < 1) { fprintf(stderr, "kernel_launch: occupancy query gave %d\n", per_cu); per_cu = 1; }
        (void)hipGetLastError();
        grid = 256;
        if (cus < 256) { fprintf(stderr, "kernel_launch: needs 256 CUs, device has %d\n", cus); grid = -1; return; }
        fprintf(stderr, "kernel_launch: cus %d per_cu %d grid %d\n", cus, per_cu, grid);
    }
    if (grid < 0) return;
    hipMemsetAsync((char*)d_ws + WS_CTL, 0, CTL_ZERO_BYTES, stream);
    Params prm{};
    for (int i = 0; i < 20; ++i) prm.ptr[i] = d_in[i];
    prm.ptr[20] = d_out; prm.ptr[21] = d_ws;
    void* args[] = {&prm};
    hipError_t e = hipLaunchCooperativeKernel((const void*)mega_fwd, dim3(grid), dim3(512), args, LDS_BYTES, stream);
    if (e != hipSuccess) fprintf(stderr, "cooperative launch failed: %s (grid %d)\n", hipGetErrorString(e), grid);
}
```

```cpp
#include <hip/hip_runtime.h>
#include <hip/hip_cooperative_groups.h>
#include <cstdio>
#include <cstdint>
namespace cg = cooperative_groups;

namespace {
constexpr int D = 1024, NB = 4, SEQ = 4096, DEPTH = 4, CTX = 256;
constexpr int SEQT = CTX + SEQ;
constexpr int T = NB * SEQT;
constexpr int DIN = 3344, LDP = 3360, NPAD = 3584;
constexpr int CONV_CH = 1152;
constexpr int C_XA = 0, C_QG = 384, C_KG = 640, C_VG = 896, C_ZA = 1152, C_QN = 1536, C_KN = 1920, C_VN = 2304,
              C_ZN = 2688, C_ZG = 3072, C_BR = 3328, C_AR = 3336;
constexpr float ALPHA = 1.681792830507429f;
}
namespace pg8 {
#define PG8_LAS __attribute__((address_space(3)))
typedef unsigned short bf16_t;
typedef short bf16x8 __attribute__((ext_vector_type(8)));
typedef float f32x4 __attribute__((ext_vector_type(4)));
typedef unsigned u32x4 __attribute__((ext_vector_type(4)));
constexpr int BM = 256, BK = 64, HALF = 128, HTB = HALF * BK * 2  , STAGE_BYTES = 8 * HTB, NXCD = 8, WGM = 8;

__host__ __device__ __forceinline__ int lds_byte(int r, int c) { const int st = (r >> 4) * 2 + (c >> 5), rr = r & 15, cc = c & 31, ob = rr * 64 + cc * 2; return st * 1024 + (ob ^ (((ob >> 9) & 1) << 5)); }
__host__ __device__ __forceinline__ void stage_rc(int b, int& R, int& C) { const int st = b / 1024, sb = b % 1024, swz = sb ^ (((sb >> 9) & 1) << 5); R = (st >> 1) * 16 + swz / 64; C = (st & 1) * 32 + (swz % 64) / 2; }
__host__ __device__ __forceinline__ int perm32(int rho) { const int n = rho >> 4, i = rho & 15; return 8 * (i >> 2) + 4 * n + (i & 3); }

struct Unit { int pm, pn; };
struct Gemm { const bf16_t* A; const bf16_t* Bt; int M, N, K; };

struct StaticOrder {
    int nM, nN, nwg, G, c;
    __host__ __device__ void init(int M, int N, int G_, int c_) { nM = M / BM; nN = N / BM; nwg = nM * nN; G = G_; c = c_; }
    __host__ __device__ bool next(int i, Unit& u) const {
        const long L = (long)i * G + c; if (L >= nwg) return false;
        int wgid = (int)L; { const int q = nwg / NXCD, r = nwg % NXCD, xcd = wgid % NXCD, off = wgid / NXCD; wgid = (xcd < r ? xcd * (q + 1) : r * (q + 1) + (xcd - r) * q) + off; }
        const int nig = WGM * nN, gid = wgid / nig, fm = gid * WGM, gsz = (nM - fm) < WGM ? (nM - fm) : WGM;
        u.pm = fm + ((wgid % nig) % gsz); u.pn = (wgid % nig) / gsz; return true;
    }
    __device__ __forceinline__ void a_ready(const Unit&) const {}
    __device__ __forceinline__ void done(const Unit&) const {}
};

typedef __bf16 bf16v2 __attribute__((ext_vector_type(2)));
typedef float f32v2 __attribute__((ext_vector_type(2)));
__device__ __forceinline__ unsigned cvt_pk_bf16(float lo, float hi) { const f32v2 v = {lo, hi}; return __builtin_bit_cast(unsigned, __builtin_convertvector(v, bf16v2)); }
struct EpiP {
    static constexpr bool PERM = true, AFTER_DRAIN = false;
    bf16_t* P;
    __device__ __forceinline__ void operator()(const f32x4 (&acc)[2][2][4][2], const Unit& u, int wr, int wc, int fr, int fq) const {
        asm volatile("" : "+v"(fr), "+v"(fq));
        const int row0 = u.pm * BM + wr * 64 + fr, col0 = u.pn * BM + wc * 32 + 8 * fq;
#pragma unroll
        for (int ai = 0; ai < 2; ++ai)
#pragma unroll
            for (int m = 0; m < 4; ++m) { bf16_t* rowp = P + (size_t)(row0 + ai * HALF + m * 16) * LDP + col0;
#pragma unroll
                for (int bj = 0; bj < 2; ++bj) { if (col0 + bj * HALF < LDP) { const f32x4 v0 = acc[ai][bj][m][0], v1 = acc[ai][bj][m][1];
                    u32x4 w; w.x = cvt_pk_bf16(v0[0], v0[1]); w.y = cvt_pk_bf16(v0[2], v0[3]); w.z = cvt_pk_bf16(v1[0], v1[1]); w.w = cvt_pk_bf16(v1[2], v1[3]);
                    *(u32x4*)(rowp + bj * HALF) = w; } } }
    }
};
struct EpiZ {
    static constexpr bool PERM = false, AFTER_DRAIN = false;
    const float* x_in; const float* ctx_in; const float* X; float* Xout; const float* modl; int layer0;
    __device__ __forceinline__ void operator()(const f32x4 (&acc)[2][2][4][2], const Unit& u, int wr, int wc, int fr, int fq) const {
        asm volatile("" : "+v"(fr), "+v"(fq));
        const int row0 = u.pm * BM + wr * 64 + fr, col0 = u.pn * BM + wc * 32 + 4 * fq;
#pragma unroll
        for (int ai = 0; ai < 2; ++ai)
#pragma unroll
            for (int m = 0; m < 4; ++m) { const int r = row0 + ai * HALF + m * 16; const int b = r / SEQT, sp = r - b * SEQT; const int j = sp < CTX ? 4 : b;
                const float* xs = layer0 ? (sp < CTX ? ctx_in + ((size_t)b * CTX + sp) * D : x_in + ((size_t)b * SEQ + (sp - CTX)) * D) : X + (size_t)r * D;
                float* zo = Xout + (size_t)r * D; const float* gp = modl + j * 3072 + 2048;
#pragma unroll
                for (int bj = 0; bj < 2; ++bj)
#pragma unroll
                    for (int n = 0; n < 2; ++n) { const int c = col0 + bj * HALF + n * 16; const f32x4 xv = *(const f32x4*)(xs + c), gv = *(const f32x4*)(gp + c);
                        *(f32x4*)(zo + c) = xv * ALPHA + gv * acc[ai][bj][m][n]; } }
    }
};

template <class Epi, class Sched, bool ALIGN_EPI = false, bool SP2 = false>
__device__ __forceinline__ void gemm_phase(PG8_LAS unsigned char* lds, const Gemm g, const Sched& S, const Epi& E, const int tid  ) {
    const int wid = __builtin_amdgcn_readfirstlane(tid >> 6), lane = tid & 63, wr = wid >> 2, wc = wid & 3, fr = lane & 15, fq = lane >> 4;
    const int K = g.K, nt = K / BK;
    unsigned voffA[2], voffB[2];
#pragma unroll
    for (int i = 0; i < 2; ++i) { int R, C; stage_rc(tid * 16 + i * 8192, R, C); const int Rb = Epi::PERM ? ((R & ~31) + perm32(R & 31)) : R;
        voffA[i] = (unsigned)(R * K + C) * 2u; voffB[i] = (unsigned)(Rb * K + C) * 2u; }
    const size_t kstep = (size_t)(BK * 2);
    const size_t hstep = (size_t)HALF * K * 2;
    const size_t tstep = 2 * hstep;
    const unsigned ldsw = (unsigned)wid * 1024u;
    const int aoff = lds_byte(wr * 64 + fr, fq * 8), boff = lds_byte(wc * 32 + fr, fq * 8);
#define PG8_SA(b, h) (((b) * 2 + (h)) * HTB)
#define PG8_SB(b, h) ((4 + (b) * 2 + (h)) * HTB)
#define PG8_STAGE(bufoff, gbase, voff) do { _Pragma("unroll") for (int _i = 0; _i < 2; ++_i) \
        __builtin_amdgcn_global_load_lds((const unsigned*)((const char*)(gbase) + (voff)[_i]), (PG8_LAS unsigned*)(lds + (bufoff) + ldsw + _i * 8192), 16, 0, 0); } while (0)
#define PG8_LDA(dst, b, h) do { _Pragma("unroll") for (int m = 0; m < 4; ++m) _Pragma("unroll") for (int k = 0; k < 2; ++k) dst[m][k] = *(const PG8_LAS bf16x8*)(lds + PG8_SA(b, h) + aoff + m * 2048 + k * 1024); } while (0)
#define PG8_LDB(dst, b, h) do { _Pragma("unroll") for (int n = 0; n < 2; ++n) _Pragma("unroll") for (int k = 0; k < 2; ++k) dst[n][k] = *(const PG8_LAS bf16x8*)(lds + PG8_SB(b, h) + boff + n * 2048 + k * 1024); } while (0)
#define PG8_MMA(ai, bj, At, Bt) do { __builtin_amdgcn_s_setprio(1); _Pragma("unroll") for (int m = 0; m < 4; ++m) _Pragma("unroll") for (int n = 0; n < 2; ++n) _Pragma("unroll") for (int k = 0; k < 2; ++k) \
        acc[ai][bj][m][n] = __builtin_amdgcn_mfma_f32_16x16x32_bf16(Bt[n][k], At[m][k], acc[ai][bj][m][n], 0, 0, 0); __builtin_amdgcn_s_setprio(0); } while (0)
#define PG8_WAIT_V(n) asm volatile("s_waitcnt vmcnt(" #n ")" ::: "memory")
#define PG8_WAIT_L(n) asm volatile("s_waitcnt lgkmcnt(" #n ")" ::: "memory")
#define PG8_BAR __builtin_amdgcn_s_barrier()
#define PG8_SCHED __builtin_amdgcn_sched_barrier(0)
    Unit cur, nxt; int ui = 0;
    if (!S.next(0, cur)) return;
    f32x4 acc[2][2][4][2];
#pragma unroll
    for (int a = 0; a < 2; ++a)
#pragma unroll
        for (int b = 0; b < 2; ++b)
#pragma unroll
            for (int m = 0; m < 4; ++m)
#pragma unroll
                for (int n = 0; n < 2; ++n) acc[a][b][m][n] = (f32x4){0.f, 0.f, 0.f, 0.f};
    bf16x8 At[4][2], B0[2][2], B1[2][2];
    const char* cA = (const char*)g.A + (size_t)cur.pm * tstep; const char* cB = (const char*)g.Bt + (size_t)cur.pn * tstep;
    S.a_ready(cur);
    if constexpr (SP2) {
        PG8_STAGE(PG8_SB(0, 0), cB, voffB); PG8_STAGE(PG8_SB(0, 1), cB + hstep, voffB); PG8_STAGE(PG8_SA(0, 0), cA, voffA); PG8_STAGE(PG8_SA(0, 1), cA + hstep, voffA);
        if (wr == 1) PG8_BAR;
        PG8_WAIT_V(2); PG8_BAR;
        PG8_STAGE(PG8_SB(1, 0), cB + kstep, voffB); PG8_STAGE(PG8_SA(1, 0), cA + kstep, voffA); PG8_STAGE(PG8_SB(1, 1), cB + hstep + kstep, voffB);
        PG8_WAIT_V(6); PG8_BAR;
    } else {
        PG8_STAGE(PG8_SB(0, 0), cB, voffB); PG8_STAGE(PG8_SA(0, 0), cA, voffA); PG8_STAGE(PG8_SB(0, 1), cB + hstep, voffB); PG8_STAGE(PG8_SA(0, 1), cA + hstep, voffA);
        if (wr == 1) PG8_BAR;
        PG8_WAIT_V(4); PG8_BAR;
        PG8_STAGE(PG8_SB(1, 0), cB + kstep, voffB); PG8_STAGE(PG8_SA(1, 0), cA + kstep, voffA); PG8_STAGE(PG8_SB(1, 1), cB + hstep + kstep, voffB);
        PG8_WAIT_V(6); PG8_BAR;
    }
    for (;;) {
        const bool has_next = S.next(ui + 1, nxt);
        const char* nA = has_next ? (const char*)g.A + (size_t)nxt.pm * tstep : cA; const char* nB = has_next ? (const char*)g.Bt + (size_t)nxt.pn * tstep : cB;
        for (int t = 0; t < nt; t += 2) {
            const bool last = (t == nt - 2);
            const char* a1 = cA + (size_t)(t + 1) * kstep;
            const char* a2 = last ? nA : cA + (size_t)(t + 2) * kstep; const char* b2 = last ? nB : cB + (size_t)(t + 2) * kstep;
            const char* a3 = a2 + kstep; const char* b3 = b2 + kstep;
            if (last && has_next) S.a_ready(nxt);
            if constexpr (SP2) {
            PG8_LDB(B0, 0, 0); PG8_LDB(B1, 0, 1); PG8_SCHED; PG8_LDA(At, 0, 0); PG8_STAGE(PG8_SA(1, 1), a1 + hstep, voffA);
            PG8_WAIT_V(8); PG8_WAIT_L(0); PG8_BAR; PG8_MMA(0, 0, At, B0); PG8_MMA(0, 1, At, B1); PG8_BAR; PG8_SCHED;
            PG8_LDA(At, 0, 1); PG8_STAGE(PG8_SB(0, 0), b2, voffB); PG8_STAGE(PG8_SB(0, 1), b2 + hstep, voffB); PG8_STAGE(PG8_SA(0, 0), a2, voffA);
            PG8_WAIT_V(8); PG8_WAIT_L(0); PG8_BAR; PG8_MMA(1, 0, At, B0); PG8_MMA(1, 1, At, B1); PG8_BAR; PG8_SCHED;
            PG8_LDB(B0, 1, 0); PG8_LDB(B1, 1, 1); PG8_SCHED; PG8_LDA(At, 1, 0); PG8_STAGE(PG8_SA(0, 1), a2 + hstep, voffA);
            PG8_WAIT_V(8); PG8_WAIT_L(0); PG8_BAR; PG8_MMA(0, 0, At, B0); PG8_MMA(0, 1, At, B1); PG8_BAR; PG8_SCHED;
            PG8_LDA(At, 1, 1); PG8_STAGE(PG8_SB(1, 0), b3, voffB); PG8_STAGE(PG8_SB(1, 1), b3 + hstep, voffB); PG8_STAGE(PG8_SA(1, 0), a3, voffA);
            PG8_WAIT_V(8); PG8_WAIT_L(0); PG8_BAR; PG8_MMA(1, 0, At, B0); PG8_MMA(1, 1, At, B1); PG8_BAR; PG8_SCHED;
            } else {
            PG8_LDB(B0, 0, 0); PG8_SCHED; PG8_LDA(At, 0, 0); PG8_STAGE(PG8_SA(1, 1), a1 + hstep, voffA);
            PG8_WAIT_L(8); PG8_BAR; PG8_WAIT_L(0); PG8_MMA(0, 0, At, B0); PG8_BAR; PG8_SCHED;
            PG8_LDB(B1, 0, 1); PG8_STAGE(PG8_SB(0, 0), b2, voffB);
            PG8_BAR; PG8_WAIT_L(0); PG8_MMA(0, 1, At, B1); PG8_BAR;
            PG8_LDA(At, 0, 1); PG8_STAGE(PG8_SA(0, 0), a2, voffA);
            PG8_BAR; PG8_WAIT_L(0); PG8_MMA(1, 0, At, B0); PG8_BAR; PG8_SCHED;
            PG8_STAGE(PG8_SB(0, 1), b2 + hstep, voffB);
            PG8_WAIT_V(6); PG8_BAR; PG8_MMA(1, 1, At, B1); PG8_BAR;
            PG8_LDB(B0, 1, 0); PG8_SCHED; PG8_LDA(At, 1, 0); PG8_STAGE(PG8_SA(0, 1), a2 + hstep, voffA);
            PG8_WAIT_L(8); PG8_BAR; PG8_WAIT_L(0); PG8_MMA(0, 0, At, B0); PG8_BAR; PG8_SCHED;
            PG8_LDB(B1, 1, 1); PG8_STAGE(PG8_SB(1, 0), b3, voffB);
            PG8_BAR; PG8_WAIT_L(0); PG8_MMA(0, 1, At, B1); PG8_BAR;
            PG8_LDA(At, 1, 1); PG8_STAGE(PG8_SA(1, 0), a3, voffA);
            PG8_BAR; PG8_WAIT_L(0); PG8_MMA(1, 0, At, B0); PG8_BAR; PG8_SCHED;
            PG8_STAGE(PG8_SB(1, 1), b3 + hstep, voffB);
            PG8_WAIT_V(6); PG8_BAR; PG8_MMA(1, 1, At, B1); PG8_BAR;
            }
        }
        if constexpr (ALIGN_EPI) { if (wr == 0) PG8_BAR; }
        if constexpr (!Epi::AFTER_DRAIN) { E(acc, cur, wr, wc, fr, fq); S.done(cur); }
        if (!has_next) break;
#pragma unroll
        for (int a = 0; a < 2; ++a)
#pragma unroll
            for (int b = 0; b < 2; ++b)
#pragma unroll
                for (int m = 0; m < 4; ++m)
#pragma unroll
                    for (int n = 0; n < 2; ++n) acc[a][b][m][n] = (f32x4){0.f, 0.f, 0.f, 0.f};
        cur = nxt; cA = nA; cB = nB; ++ui;
        if constexpr (ALIGN_EPI) { if (wr == 1) PG8_BAR; }
    }
    PG8_WAIT_V(0);
    if constexpr (!ALIGN_EPI) { if (wr == 0) PG8_BAR; }
    PG8_BAR;
    if constexpr (Epi::AFTER_DRAIN) { E.fused(acc, cur, wr, wc, fr, fq, lds, wid, lane); S.done(cur); }
#undef PG8_SA
#undef PG8_SB
#undef PG8_STAGE
#undef PG8_LDA
#undef PG8_LDB
#undef PG8_MMA
#undef PG8_WAIT_V
#undef PG8_WAIT_L
#undef PG8_BAR
#undef PG8_SCHED
}
}

namespace {
#define LAS __attribute__((address_space(3)))
typedef unsigned short bf16_t;
typedef unsigned v4u __attribute__((ext_vector_type(4)));
typedef float f32x4 __attribute__((ext_vector_type(4)));
#define LDS_WAIT() asm volatile("s_waitcnt lgkmcnt(0)" ::: "memory")

__device__ __forceinline__ unsigned f2bf(float f) { unsigned u = __float_as_uint(f); return (u + 0x7fffu + ((u >> 16) & 1u)) >> 16; }
__device__ __forceinline__ unsigned pk2(float lo, float hi) { return f2bf(lo) | (f2bf(hi) << 16); }
__device__ __forceinline__ float bf2f(bf16_t b) { return __uint_as_float(((unsigned)b) << 16); }
__device__ __forceinline__ float sigmoidf_(float x) { return __frcp_rn(1.0f + __expf(-x)); }
__device__ __forceinline__ float siluf_(float x) { return x * __frcp_rn(1.0f + __expf(-x)); }
__device__ __forceinline__ float softplusf_(float x) { const float e = __expf(x); return x > 15.f ? x : (e < 1e-3f ? e * (1.0f - 0.5f * e) : __logf(1.0f + e)); }
__device__ __forceinline__ int lane_id_v() { int l; asm volatile("v_mbcnt_lo_u32_b32 %0, -1, 0\n\tv_mbcnt_hi_u32_b32 %0, -1, %0" : "=v"(l)); return l; }
__device__ __forceinline__ float shx(float v, int mask) { return __builtin_bit_cast(float, __builtin_amdgcn_ds_bpermute((lane_id_v() ^ mask) << 2, __builtin_bit_cast(int, v))); }
__device__ __forceinline__ float shidx(float v, int src) { return __builtin_bit_cast(float, __builtin_amdgcn_ds_bpermute(src << 2, __builtin_bit_cast(int, v))); }
__device__ __forceinline__ float wave_sum(float v) {
#pragma unroll
    for (int o = 32; o >= 1; o >>= 1) v += shx(v, o);
    return v; }
__device__ __forceinline__ float wave_max(float v) {
#pragma unroll
    for (int o = 32; o >= 1; o >>= 1) v = fmaxf(v, shx(v, o));
    return v; }

constexpr size_t MiB = 1u << 20;
constexpr size_t WS_CTL = 0, CTL_ZERO_BYTES = 65536;
constexpr size_t WS_MOD = 1 * MiB;
constexpr size_t WS_WTIN = 2 * MiB;
constexpr size_t WS_WTOUT = 10 * MiB;
constexpr size_t WS_X = 12 * MiB;
constexpr size_t WS_UF = 80 * MiB;
constexpr size_t WS_P = 114 * MiB;
constexpr size_t WS_GDNX = 226 * MiB;
constexpr size_t WS_VT = 230 * MiB;
constexpr size_t WS_RGS = 247 * MiB;
constexpr size_t WS_END = 250 * MiB;
constexpr size_t WS_RGWT = 1 * MiB + 576 * 1024;
constexpr size_t WS_RGTAB = 1 * MiB + 768 * 1024;
constexpr size_t WS_ROPE = 1 * MiB + 512 * 1024;
constexpr int LDS_BAR_OFF = 147456;
constexpr int LDS_BYTES = 147456 + 256;
constexpr size_t WS_BAR = 16384;

struct Params { const void* ptr[22]; };

__device__ __forceinline__ void phase_mods(const float* c, const float* cctx, const float* w_mod, const float* b_mod, float* mod, LAS float* sc, int wid, int lane) {
    for (int item = blockIdx.x; item < DEPTH * 48; item += gridDim.x) {
        const int l = item / 48, n = (item % 48) * 64 + lane;
        float a0 = 0, a1 = 0, a2 = 0, a3 = 0, a4 = 0;
        const float* w = w_mod + (size_t)l * 1024 * 3072 + n;
        for (int k = wid * 128; k < wid * 128 + 128; ++k) {
            const float wv = w[(size_t)k * 3072];
            a0 += siluf_(c[k]) * wv; a1 += siluf_(c[1024 + k]) * wv; a2 += siluf_(c[2048 + k]) * wv; a3 += siluf_(c[3072 + k]) * wv; a4 += siluf_(cctx[k]) * wv;
        }
        sc[(wid * 5 + 0) * 64 + lane] = a0; sc[(wid * 5 + 1) * 64 + lane] = a1; sc[(wid * 5 + 2) * 64 + lane] = a2; sc[(wid * 5 + 3) * 64 + lane] = a3; sc[(wid * 5 + 4) * 64 + lane] = a4;
        __syncthreads();
        if (wid < 5) { float s = 0.f;
#pragma unroll
            for (int w8 = 0; w8 < 8; ++w8) s += sc[(w8 * 5 + wid) * 64 + lane];
            mod[(size_t)(l * 5 + wid) * 3072 + n] = s + b_mod[l * 3072 + n]; }
        __syncthreads();
    }
}
__device__ __forceinline__ void transpose_item(const float* W, int K, int N, int nblk, bf16_t* WT, LAS float* scr, int item, int lane) {
    const int kb = item / nblk, nb = item % nblk, k0 = 64 * kb, n0 = 32 * nb;
    const int nn = n0 + (lane & 31);
#pragma unroll 8
    for (int i = 0; i < 32; ++i) { const int kk = 2 * i + (lane >> 5); scr[kk * 33 + (lane & 31)] = nn < N ? W[(size_t)(k0 + kk) * N + nn] : 0.f; }
    LDS_WAIT();
    const int c = lane & 7;
#pragma unroll
    for (int j = 0; j < 4; ++j) { const int n = (lane >> 3) + 8 * j; const LAS float* s = scr + (8 * c) * 33 + n;
        v4u o; o.x = pk2(s[0 * 33], s[1 * 33]); o.y = pk2(s[2 * 33], s[3 * 33]); o.z = pk2(s[4 * 33], s[5 * 33]); o.w = pk2(s[6 * 33], s[7 * 33]);
        *(v4u*)(WT + (size_t)(n0 + n) * K + k0 + 8 * c) = o; }
    LDS_WAIT();
}
__device__ __forceinline__ void convert_weights(const float* w_in_l, const float* w_out_l, bf16_t* WTIN, bf16_t* WTOUT, LAS float* scr, int gw, int NGW, int lane) {
    constexpr int I_IN = 16 * 105, I_OUT = 16 * 32;
    for (int it = gw; it < I_IN + I_OUT; it += NGW) {
        if (it < I_IN) transpose_item(w_in_l, 1024, DIN, 105, WTIN, scr, it, lane);
        else transpose_item(w_out_l, 1024, 1024, 32, WTOUT, scr, it - I_IN, lane);
    }
}
__device__ __forceinline__ void convert_rg(const float* wa, const float* ba, const float* wx, const float* bx, const float* lam, bf16_t* RGWT, float* rgtab, int gtid, int ngt) {
    for (int idx = gtid; idx < 24 * 4096 + 768; idx += ngt) {
        if (idx < 24 * 4096) { const int dd = idx & 63, e = (idx >> 6) & 63, m = idx >> 12, kind = m & 1, dn = m >> 1;
            RGWT[idx] = (bf16_t)f2bf((kind ? wx : wa)[((size_t)dn * 64 + dd) * 64 + e]); }
        else { const int k = idx - 24 * 4096; rgtab[k] = ba[k]; rgtab[768 + k] = bx[k]; rgtab[1536 + k] = -8.0f * log1pf(expf(-lam[k])); }
    }
}
__device__ __forceinline__ void prep_rows0(const float* x, const float* ctx, const float* modl, bf16_t* U, int gw, int NGW, int lane) {
    for (int t = gw; t < T; t += NGW) {
        const int b = t / SEQT, sp = t - b * SEQT, j = sp < CTX ? 4 : b;
        const float* xs = sp < CTX ? ctx + ((size_t)b * CTX + sp) * D : x + ((size_t)b * SEQ + (sp - CTX)) * D;
        const float* sh = modl + j * 3072; const float* sc = sh + 1024;
#pragma unroll
        for (int q = 0; q < 4; ++q) { const int k = (q * 64 + lane) * 4; const f32x4 v = *(const f32x4*)(xs + k), s1 = *(const f32x4*)(sc + k), s0 = *(const f32x4*)(sh + k);
            const f32x4 u = v * (s1 + 1.0f) + s0; uint2 o; o.x = pk2(u[0], u[1]); o.y = pk2(u[2], u[3]); *(uint2*)(U + (size_t)t * D + k) = o; }
    }
}
__device__ __forceinline__ void ln_rows(const float* X, float* Xw, const float* g, const float* bta, float* final_out, const float* modn, bf16_t* U, int gw, int NGW, int lane) {
    for (int t = gw; t < T; t += NGW) {
        const int b = t / SEQT, sp = t - b * SEQT, j = sp < CTX ? 4 : b;
        if (final_out && sp < CTX) continue;
        const float* xr = X + (size_t)t * D; float* xw = Xw + (size_t)t * D;
        f32x4 v[4]; float s = 0.f;
#pragma unroll
        for (int q = 0; q < 4; ++q) { v[q] = *(const f32x4*)(xr + (q * 64 + lane) * 4); s += (v[q][0] + v[q][1]) + (v[q][2] + v[q][3]); }
        const float mean = wave_sum(s) * (1.0f / D); float s2 = 0.f;
#pragma unroll
        for (int q = 0; q < 4; ++q) { v[q] = v[q] - mean; s2 += (v[q][0] * v[q][0] + v[q][1] * v[q][1]) + (v[q][2] * v[q][2] + v[q][3] * v[q][3]); }
        const float rstd = __frsqrt_rn(wave_sum(s2) * (1.0f / D) + 1e-5f);
#pragma unroll
        for (int q = 0; q < 4; ++q) { const int k = (q * 64 + lane) * 4; const f32x4 y = v[q] * rstd * *(const f32x4*)(g + k) + *(const f32x4*)(bta + k);
            if (final_out) *(f32x4*)(final_out + ((size_t)b * SEQ + (sp - CTX)) * D + k) = y;
            else { *(f32x4*)(xw + k) = y; const f32x4 u = y * (*(const f32x4*)(modn + j * 3072 + 1024 + k) + 1.0f) + *(const f32x4*)(modn + j * 3072 + k);
                uint2 o; o.x = pk2(u[0], u[1]); o.y = pk2(u[2], u[3]); *(uint2*)(U + (size_t)t * D + k) = o; } }
    }
}

__device__ __forceinline__ float conv_at(const bf16_t* P, const float* cw, int t, int c) {
    const int sp = t % SEQT;
    const int lo = sp < CTX ? 0 : CTX, hi = sp < CTX ? CTX : SEQT;
    float acc = 0.f;
#pragma unroll
    for (int j = 0; j < 4; ++j) { const int s2 = sp + j - 2; if (s2 >= lo && s2 < hi) acc += cw[j * CONV_CH + c] * bf2f(P[(size_t)(t + j - 2) * LDP + c]); }
    return acc;
}
__device__ __forceinline__ int step_to_sp(int step, int d) { return d == 0 ? step : (step < CTX ? CTX - 1 - step : SEQT - 1 - (step - CTX)); }

__device__ __forceinline__ void combine_rows(const bf16_t* P, const float* nw, bf16_t* F, int gw, int NGW, int lane) {
    for (int t = gw; t < T; t += NGW) {
#pragma unroll
        for (int hh = 0; hh < 4; ++hh) { const int c = hh * 64 + lane;
            const float o = bf2f(P[(size_t)t * LDP + C_QG + c]) + bf2f(P[(size_t)t * LDP + C_KG + c]);
            const float ms = wave_sum(o * o) * (1.0f / 64.0f);
            F[(size_t)t * 1024 + 768 + c] = (bf16_t)f2bf(o * __frsqrt_rn(ms + 1e-6f) * nw[lane] * siluf_(bf2f(P[(size_t)t * LDP + C_ZG + c]))); }
    }
}


constexpr int LS = 72;
constexpr int G_KN = 0, G_KNT = 9216, G_QN = 18432, G_QK = 27648, G_XT = 36864, G_LB = 55296, G_TI = 64512, G_SM = 72704, G_HALF = 73728;
constexpr int GDN_ITEMS = NB * 4 * 2 * 68;
constexpr size_t GDN_ITEM_BYTES = 32768;
typedef short bf16x8_t __attribute__((ext_vector_type(8)));
typedef unsigned v2u __attribute__((ext_vector_type(2)));
typedef float f32x4_t __attribute__((ext_vector_type(4)));

typedef __bf16 bf16v2_t __attribute__((ext_vector_type(2)));
typedef float f32v2_t __attribute__((ext_vector_type(2)));
__device__ __forceinline__ unsigned cvtpk(float lo, float hi) { const f32v2_t v = {lo, hi}; return __builtin_bit_cast(unsigned, __builtin_convertvector(v, bf16v2_t)); }
__device__ __forceinline__ float fsilu(float x) { return x * __frcp_rn(1.0f + __expf(-x)); }
__device__ __forceinline__ bf16x8_t lds_frag(const LAS unsigned char* base, int row, int col) { return *(const LAS bf16x8_t*)(base + (row * LS + col) * 2); }
__device__ __forceinline__ unsigned char* gdn_item_ptr(unsigned char* dout, unsigned char* wsx, int it) { return it < 2048 ? dout + (size_t)it * GDN_ITEM_BYTES : wsx + (size_t)(it - 2048) * GDN_ITEM_BYTES; }
__device__ __forceinline__ int gdn_sp(int c, int i, int d) {
    if (c < 4) { const int s = c * 64 + i; return d == 0 ? s : CTX - 1 - s; }
    const int s = (c - 4) * 64 + i; return d == 0 ? CTX + s : SEQT - 1 - s;
}

__device__ __forceinline__ void gdn_pass1(const bf16_t* P, const float* cw, const float* alog, const float* dtb, const float* rcos, const float* rsin,
                                          unsigned char* dout, unsigned char* wsx, LAS unsigned char* lds, int tid, int bidx, int nblk) {
    const int n_iter = (GDN_ITEMS + 2 * nblk - 1) / (2 * nblk);
#pragma unroll 1
    for (int iter = 0; iter < n_iter; ++iter) {
        int tidf = tid; asm volatile("" : "+v"(tidf));
        const int half = __builtin_amdgcn_readfirstlane(tidf >> 8), t256 = tidf & 255, w = __builtin_amdgcn_readfirstlane(t256 >> 6), lane = tidf & 63, g = lane >> 4, l15 = lane & 15;
        LAS unsigned char* hb = lds + half * G_HALF;
        LAS float* sm = (LAS float*)(hb + G_SM);
        const int it = (iter * nblk + bidx) * 2 + half;
        const bool valid = it < GDN_ITEMS;
        const int c = it % 68, bhd = it / 68, d = bhd & 1, hh = (bhd >> 1) & 3, b = bhd >> 3;
        if (valid) {
            if (t256 < 64) {
                const int t2 = b * SEQT + gdn_sp(c, lane, d);
                const float beta = sigmoidf_(bf2f(P[(size_t)t2 * LDP + C_BR + d * 4 + hh]));
                const float gg = -__expf(alog[d * 4 + hh]) * softplusf_(bf2f(P[(size_t)t2 * LDP + C_AR + d * 4 + hh]) + dtb[d * 4 + hh]);
                float G = gg;
#pragma unroll
                for (int o = 1; o < 64; o <<= 1) { const float v = shidx(G, lane >= o ? lane - o : lane); if (lane >= o) G += v; }
                const float gl = shidx(G, 63);
                sm[lane] = beta; sm[64 + lane] = G; sm[128 + lane] = __expf(G); sm[192 + lane] = __expf(gl - G);
            }
        }
        const int i = t256 >> 2, qd = t256 & 3;
        float qv[16], kv[16], vv[16];
        if (valid) {
            const int sp = gdn_sp(c, i, d), t = b * SEQT + sp;
            const int lo = sp < CTX ? 0 : CTX, hi = sp < CTX ? CTX : SEQT;
#pragma unroll
            for (int e = 0; e < 16; ++e) { qv[e] = 0.f; kv[e] = 0.f; vv[e] = 0.f; }
#pragma unroll
            for (int j = 0; j < 4; ++j) {
                const int s2 = sp + j - 2;
                if (s2 >= lo && s2 < hi) {
                    const bf16_t* pr = P + (size_t)(t + j - 2) * LDP + hh * 64 + 16 * qd;
                    const float* wr_ = cw + j * CONV_CH + hh * 64 + 16 * qd;
#pragma unroll
                    for (int m3 = 0; m3 < 3; ++m3) {
                        const int cb = m3 == 0 ? C_QG : (m3 == 1 ? C_KG : C_VG);
                        const v4u a0 = *(const v4u*)(pr + cb), a1 = *(const v4u*)(pr + cb + 8);
                        const unsigned aw[8] = {a0.x, a0.y, a0.z, a0.w, a1.x, a1.y, a1.z, a1.w};
                        const f32x4_t w0 = *(const f32x4_t*)(wr_ + cb), w1 = *(const f32x4_t*)(wr_ + cb + 4), w2 = *(const f32x4_t*)(wr_ + cb + 8), w3 = *(const f32x4_t*)(wr_ + cb + 12);
                        const float wv[16] = {w0[0], w0[1], w0[2], w0[3], w1[0], w1[1], w1[2], w1[3], w2[0], w2[1], w2[2], w2[3], w3[0], w3[1], w3[2], w3[3]};
#pragma unroll
                        for (int e2 = 0; e2 < 8; ++e2) {
                            const float x0 = __uint_as_float(aw[e2] << 16), x1 = __uint_as_float(aw[e2] & 0xffff0000u);
                            if (m3 == 0) { qv[2 * e2] += wv[2 * e2] * x0; qv[2 * e2 + 1] += wv[2 * e2 + 1] * x1; }
                            else if (m3 == 1) { kv[2 * e2] += wv[2 * e2] * x0; kv[2 * e2 + 1] += wv[2 * e2 + 1] * x1; }
                            else { vv[2 * e2] += wv[2 * e2] * x0; vv[2 * e2 + 1] += wv[2 * e2 + 1] * x1; }
                        }
                    }
                }
            }
            float sq = 0.f, sk = 0.f;
#pragma unroll
            for (int e = 0; e < 16; ++e) { qv[e] = fsilu(qv[e]); kv[e] = fsilu(kv[e]); vv[e] = fsilu(vv[e]); sq += qv[e] * qv[e]; sk += kv[e] * kv[e]; }
            sq += shx(sq, 1); sq += shx(sq, 2); sk += shx(sk, 1); sk += shx(sk, 2);
            const float rq = __frsqrt_rn(sq + 1e-6f), rk = __frsqrt_rn(sk + 1e-6f);
            const bool lat = sp >= CTX;
            const int s = sp - CTX, pos = qd < 2 ? (s >> 6) : (s & 63);
#pragma unroll
            for (int e = 0; e < 16; ++e) {
                float q1 = qv[e] * rq, k1 = kv[e] * rk;
                const float qp = shx(q1, 1), kp = shx(k1, 1);
                if (lat) { const float cs = rcos[pos * 16 + e], sn = rsin[pos * 16 + e];
                    if (qd & 1) { q1 = q1 * cs + qp * sn; k1 = k1 * cs + kp * sn; } else { q1 = q1 * cs - qp * sn; k1 = k1 * cs - kp * sn; } }
                qv[e] = q1 * 0.125f; kv[e] = k1;
            }
        }
        __syncthreads();
        if (valid) {
            const float beta = sm[i], eG = sm[128 + i], eGl = sm[192 + i];
            v4u o0, o1;
            o0.x = cvtpk(kv[0], kv[1]); o0.y = cvtpk(kv[2], kv[3]); o0.z = cvtpk(kv[4], kv[5]); o0.w = cvtpk(kv[6], kv[7]);
            o1.x = cvtpk(kv[8], kv[9]); o1.y = cvtpk(kv[10], kv[11]); o1.z = cvtpk(kv[12], kv[13]); o1.w = cvtpk(kv[14], kv[15]);
            *(LAS v4u*)(hb + G_KN + (i * LS + 16 * qd) * 2) = o0; *(LAS v4u*)(hb + G_KN + (i * LS + 16 * qd + 8) * 2) = o1;
            o0.x = cvtpk(qv[0], qv[1]); o0.y = cvtpk(qv[2], qv[3]); o0.z = cvtpk(qv[4], qv[5]); o0.w = cvtpk(qv[6], qv[7]);
            o1.x = cvtpk(qv[8], qv[9]); o1.y = cvtpk(qv[10], qv[11]); o1.z = cvtpk(qv[12], qv[13]); o1.w = cvtpk(qv[14], qv[15]);
            *(LAS v4u*)(hb + G_QN + (i * LS + 16 * qd) * 2) = o0; *(LAS v4u*)(hb + G_QN + (i * LS + 16 * qd + 8) * 2) = o1;
            const float bw = beta * eG;
#pragma unroll
            for (int e = 0; e < 16; ++e) {
                const int f = 16 * qd + e;
                const unsigned p0 = cvtpk(kv[e] * eGl, beta * vv[e]), p1 = cvtpk(bw * kv[e], 0.f);
                *(LAS bf16_t*)(hb + G_KNT + (f * LS + i) * 2) = (bf16_t)(p0 & 0xffffu);
                *(LAS bf16_t*)(hb + G_XT + (f * LS + i) * 2) = (bf16_t)(p0 >> 16);
                *(LAS bf16_t*)(hb + G_XT + ((64 + f) * LS + i) * 2) = (bf16_t)(p1 & 0xffffu);
            }
        }
        __syncthreads();
        if (valid) {
            const bf16x8_t ak0 = lds_frag(hb + G_KN, 16 * w + l15, 8 * g), ak1 = lds_frag(hb + G_KN, 16 * w + l15, 32 + 8 * g);
            const bf16x8_t aq0 = lds_frag(hb + G_QN, 16 * w + l15, 8 * g), aq1 = lds_frag(hb + G_QN, 16 * w + l15, 32 + 8 * g);
            const f32x4_t Gi = *(const LAS f32x4_t*)(sm + 64 + 16 * w + 4 * g), Bi = *(const LAS f32x4_t*)(sm + 16 * w + 4 * g);
#pragma unroll
            for (int nt = 0; nt < 4; ++nt) {
                const bf16x8_t b0 = lds_frag(hb + G_KN, 16 * nt + l15, 8 * g), b1 = lds_frag(hb + G_KN, 16 * nt + l15, 32 + 8 * g);
                f32x4_t kk = {0.f, 0.f, 0.f, 0.f}, qk = {0.f, 0.f, 0.f, 0.f};
                kk = __builtin_amdgcn_mfma_f32_16x16x32_bf16(ak0, b0, kk, 0, 0, 0); kk = __builtin_amdgcn_mfma_f32_16x16x32_bf16(ak1, b1, kk, 0, 0, 0);
                qk = __builtin_amdgcn_mfma_f32_16x16x32_bf16(aq0, b0, qk, 0, 0, 0); qk = __builtin_amdgcn_mfma_f32_16x16x32_bf16(aq1, b1, qk, 0, 0, 0);
                const int jj = 16 * nt + l15; const float Gj = sm[64 + jj];
#pragma unroll
                for (int r = 0; r < 4; ++r) {
                    const int ii = 16 * w + 4 * g + r;
                    const float e = __expf(fminf(Gi[r] - Gj, 0.f));
                    const unsigned pk = cvtpk(jj < ii ? -(Bi[r] * kk[r] * e) : 0.f, jj <= ii ? qk[r] * e : 0.f);
                    *(LAS bf16_t*)(hb + G_LB + (ii * LS + jj) * 2) = (bf16_t)(pk & 0xffffu);
                    *(LAS bf16_t*)(hb + G_QK + (ii * LS + jj) * 2) = (bf16_t)(pk >> 16);
                }
            }
        }
        __syncthreads();
        if (valid) {
            LAS unsigned char* ti = hb + G_TI + w * 2048;
            {   float tv[16];
#pragma unroll
                for (int i2 = 0; i2 < 16; ++i2) {
                    float acc = (i2 == l15) ? 1.0f : 0.0f;
                    if (i2 > 0) { const LAS unsigned char* lr = hb + G_LB + ((16 * g + i2) * LS + 16 * g) * 2;
                        const v4u r0 = *(const LAS v4u*)lr, r1 = *(const LAS v4u*)(lr + 16); const unsigned rw[8] = {r0.x, r0.y, r0.z, r0.w, r1.x, r1.y, r1.z, r1.w};
#pragma unroll
                        for (int j2 = 0; j2 < i2; ++j2) acc += ((j2 & 1) ? __uint_as_float(rw[j2 >> 1] & 0xffff0000u) : __uint_as_float(rw[j2 >> 1] << 16)) * tv[j2]; }
                    tv[i2] = acc;
                    *(LAS bf16_t*)(ti + ((g * 16 + i2) * 16 + l15) * 2) = (bf16_t)(cvtpk(acc, 0.f) & 0xffffu);
                }
            }
            LDS_WAIT();
#pragma unroll
            for (int I = 0; I < 4; ++I) {
                const v2u traw = *(const LAS v2u*)(ti + ((I * 16 + l15) * 16 + 4 * g) * 2);
                const v4u tpk = {traw.x, traw.y, 0u, 0u}; const bf16x8_t a_ti = __builtin_bit_cast(bf16x8_t, tpk);
#pragma unroll
                for (int cti = 0; cti < 2; ++cti) {
                    const int cr = 32 * w + 16 * cti + l15;
                    LAS unsigned char* xp = hb + G_XT + (cr * LS + 16 * I + 4 * g) * 2;
                    const v2u rr = *(const LAS v2u*)xp;
                    f32x4_t acc = {__uint_as_float(rr.x << 16), __uint_as_float(rr.x & 0xffff0000u), __uint_as_float(rr.y << 16), __uint_as_float(rr.y & 0xffff0000u)};
#pragma unroll
                    for (int s2 = 0; s2 < (16 * I + 31) / 32; ++s2) {
                        bf16x8_t al = lds_frag(hb + G_LB, 16 * I + l15, 32 * s2 + 8 * g);
                        if (32 * s2 + 8 * g >= 16 * I) al = (bf16x8_t){0, 0, 0, 0, 0, 0, 0, 0};
                        acc = __builtin_amdgcn_mfma_f32_16x16x32_bf16(al, lds_frag(hb + G_XT, cr, 32 * s2 + 8 * g), acc, 0, 0, 0);
                    }
                    const v4u rpk = {cvtpk(acc[0], acc[1]), cvtpk(acc[2], acc[3]), 0u, 0u};
                    f32x4_t xa = {0.f, 0.f, 0.f, 0.f};
                    xa = __builtin_amdgcn_mfma_f32_16x16x32_bf16(a_ti, __builtin_bit_cast(bf16x8_t, rpk), xa, 0, 0, 0);
                    v2u o; o.x = cvtpk(xa[0], xa[1]); o.y = cvtpk(xa[2], xa[3]); *(LAS v2u*)xp = o;
                }
                LDS_WAIT();
            }
        }
        __syncthreads();
        if (valid) {
            unsigned char* blk = gdn_item_ptr(dout, wsx, it);
            bf16_t* gM = (bf16_t*)blk; bf16_t* gP = gM + 4096; bf16_t* gN = gM + 8192; bf16_t* gQ = gM + 12288;
            const bf16x8_t akd0 = lds_frag(hb + G_KNT, 16 * w + l15, 8 * g), akd1 = lds_frag(hb + G_KNT, 16 * w + l15, 32 + 8 * g);
            const bf16x8_t aqk0 = lds_frag(hb + G_QK, 16 * w + l15, 8 * g), aqk1 = lds_frag(hb + G_QK, 16 * w + l15, 32 + 8 * g);
            const bf16x8_t aw0 = lds_frag(hb + G_XT, 64 + 16 * w + l15, 8 * g), aw1 = lds_frag(hb + G_XT, 64 + 16 * w + l15, 32 + 8 * g);
            const float egl = sm[128 + 63];
            const int pcol = 16 * w + 4 * g;
#pragma unroll
            for (int nt = 0; nt < 4; ++nt) {
                const bf16x8_t bu0 = lds_frag(hb + G_XT, 16 * nt + l15, 8 * g), bu1 = lds_frag(hb + G_XT, 16 * nt + l15, 32 + 8 * g);
                f32x4_t nn = {0.f, 0.f, 0.f, 0.f}, qm = {0.f, 0.f, 0.f, 0.f};
                nn = __builtin_amdgcn_mfma_f32_16x16x32_bf16(akd0, bu0, nn, 0, 0, 0); nn = __builtin_amdgcn_mfma_f32_16x16x32_bf16(akd1, bu1, nn, 0, 0, 0);
                qm = __builtin_amdgcn_mfma_f32_16x16x32_bf16(aqk0, bu0, qm, 0, 0, 0); qm = __builtin_amdgcn_mfma_f32_16x16x32_bf16(aqk1, bu1, qm, 0, 0, 0);
                const int cc = 16 * nt + l15;
                v2u o; o.x = cvtpk(nn[0], nn[1]); o.y = cvtpk(nn[2], nn[3]); *(v2u*)(gN + cc * 64 + 16 * w + 4 * g) = o;
                o.x = cvtpk(qm[0], qm[1]); o.y = cvtpk(qm[2], qm[3]); *(v2u*)(gQ + cc * 64 + 16 * w + 4 * g) = o;
                const bf16x8_t bk0 = lds_frag(hb + G_KNT, 16 * nt + l15, 8 * g), bk1 = lds_frag(hb + G_KNT, 16 * nt + l15, 32 + 8 * g);
                const bf16x8_t bq0 = lds_frag(hb + G_QK, 16 * nt + l15, 8 * g), bq1 = lds_frag(hb + G_QK, 16 * nt + l15, 32 + 8 * g);
                f32x4_t mm = {0.f, 0.f, 0.f, 0.f}, pm = {0.f, 0.f, 0.f, 0.f};
                mm = __builtin_amdgcn_mfma_f32_16x16x32_bf16(aw0, bk0, mm, 0, 0, 0); mm = __builtin_amdgcn_mfma_f32_16x16x32_bf16(aw1, bk1, mm, 0, 0, 0);
                pm = __builtin_amdgcn_mfma_f32_16x16x32_bf16(aw0, bq0, pm, 0, 0, 0); pm = __builtin_amdgcn_mfma_f32_16x16x32_bf16(aw1, bq1, pm, 0, 0, 0);
                const int frow = 16 * nt + l15;
                float mv[4], pv[4];
                const v2u qraw = *(const LAS v2u*)(hb + G_QN + (frow * LS + 16 * w + 4 * g) * 2);
                const float qf[4] = {__uint_as_float(qraw.x << 16), __uint_as_float(qraw.x & 0xffff0000u), __uint_as_float(qraw.y << 16), __uint_as_float(qraw.y & 0xffff0000u)};
                const float eGi = sm[128 + frow];
#pragma unroll
                for (int r = 0; r < 4; ++r) { mv[r] = ((16 * w + 4 * g + r) == frow ? egl : 0.f) - mm[r]; pv[r] = qf[r] * eGi - pm[r]; }
                o.x = cvtpk(mv[0], mv[1]); o.y = cvtpk(mv[2], mv[3]); *(v2u*)(gM + frow * 64 + pcol) = o;
                o.x = cvtpk(pv[0], pv[1]); o.y = cvtpk(pv[2], pv[3]); *(v2u*)(gP + frow * 64 + pcol) = o;
            }
        }
        __syncthreads();
    }
}

__device__ __forceinline__ void gdn_chain(unsigned char* dout, unsigned char* wsx, bf16_t* Pw, int bhd, LAS unsigned char* sbuf, int wid, int lane) {
    const int d = bhd & 1, hh = (bhd >> 1) & 3, b = bhd >> 3, g = lane >> 4, l15 = lane & 15, w = wid & 3;
    const bool helper = wid >= 4;
    LAS unsigned char* obuf = sbuf + 18432;
    bf16_t* Og = Pw + (d == 0 ? C_QG : C_KG) + hh * 64;
    bf16x8_t aM[4][2], aP[4][2]; v2u nN[4][4], nQ[4][4];
#define GDN_LOAD(st_, c_) do { const bf16_t* blk_ = (const bf16_t*)gdn_item_ptr(dout, wsx, bhd * 68 + (c_)); \
        _Pragma("unroll") for (int s = 0; s < 2; ++s) { aM[st_][s] = *(const bf16x8_t*)(blk_ + (16 * w + l15) * 64 + 32 * s + 8 * g); aP[st_][s] = *(const bf16x8_t*)(blk_ + 4096 + (16 * w + l15) * 64 + 32 * s + 8 * g); } \
        _Pragma("unroll") for (int nt = 0; nt < 4; ++nt) { nN[st_][nt] = *(const v2u*)(blk_ + 8192 + (16 * nt + l15) * 64 + 16 * w + 4 * g); nQ[st_][nt] = *(const v2u*)(blk_ + 12288 + (16 * nt + l15) * 64 + 16 * w + 4 * g); } } while (0)
#define GDN_HSTORE(c_) do { _Pragma("unroll") for (int k2 = 0; k2 < 2; ++k2) { const int pc = w * 64 + lane + 256 * k2, row = pc >> 3, seg = pc & 7; \
        const v4u ov = *(const LAS v4u*)(obuf + ((c_) & 1) * 9216 + (row * LS + 8 * seg) * 2); \
        *(v4u*)(Og + (size_t)(b * SEQT + gdn_sp((c_), row, d)) * LDP + 8 * seg) = ov; } } while (0)
    if (!helper) {
#pragma unroll
        for (int nt = 0; nt < 4; ++nt) *(LAS v2u*)(sbuf + ((16 * nt + l15) * LS + 16 * w + 4 * g) * 2) = (v2u){0u, 0u};
        GDN_LOAD(0, 0); GDN_LOAD(1, 1); GDN_LOAD(2, 2); GDN_LOAD(3, 3);
    }
    asm volatile("s_waitcnt lgkmcnt(0)" ::: "memory"); __builtin_amdgcn_s_barrier(); asm volatile("" ::: "memory");
#pragma unroll 1
    for (int c4 = 0; c4 < 17; ++c4) {
#pragma unroll
        for (int u = 0; u < 4; ++u) {
            const int c = 4 * c4 + u;
            if (!helper) {
                const LAS unsigned char* rb = sbuf + (c & 1) * 9216; LAS unsigned char* wb = sbuf + ((c + 1) & 1) * 9216; LAS unsigned char* ob = obuf + (c & 1) * 9216;
                f32x4_t Sn[4], Oc[4];
#pragma unroll
                for (int nt = 0; nt < 4; ++nt) {
                    const bf16x8_t b0 = lds_frag(rb, 16 * nt + l15, 8 * g), b1 = lds_frag(rb, 16 * nt + l15, 32 + 8 * g);
                    Sn[nt] = (f32x4_t){__uint_as_float(nN[u][nt].x << 16), __uint_as_float(nN[u][nt].x & 0xffff0000u), __uint_as_float(nN[u][nt].y << 16), __uint_as_float(nN[u][nt].y & 0xffff0000u)};
                    Oc[nt] = (f32x4_t){__uint_as_float(nQ[u][nt].x << 16), __uint_as_float(nQ[u][nt].x & 0xffff0000u), __uint_as_float(nQ[u][nt].y << 16), __uint_as_float(nQ[u][nt].y & 0xffff0000u)};
                    Sn[nt] = __builtin_amdgcn_mfma_f32_16x16x32_bf16(aM[u][0], b0, Sn[nt], 0, 0, 0); Sn[nt] = __builtin_amdgcn_mfma_f32_16x16x32_bf16(aM[u][1], b1, Sn[nt], 0, 0, 0);
                    Oc[nt] = __builtin_amdgcn_mfma_f32_16x16x32_bf16(aP[u][0], b0, Oc[nt], 0, 0, 0); Oc[nt] = __builtin_amdgcn_mfma_f32_16x16x32_bf16(aP[u][1], b1, Oc[nt], 0, 0, 0);
                }
#pragma unroll
                for (int nt = 0; nt < 4; ++nt) { v2u o; o.x = cvtpk(Sn[nt][0], Sn[nt][1]); o.y = cvtpk(Sn[nt][2], Sn[nt][3]); *(LAS v2u*)(wb + ((16 * nt + l15) * LS + 16 * w + 4 * g) * 2) = o; }
                if (c + 4 < 68) GDN_LOAD(u, c + 4);
#pragma unroll
                for (int nt = 0; nt < 4; ++nt) { const unsigned p01 = cvtpk(Oc[nt][0], Oc[nt][1]), p23 = cvtpk(Oc[nt][2], Oc[nt][3]);
                    LAS unsigned char* op = ob + ((16 * w + 4 * g) * LS + 16 * nt + l15) * 2;
                    *(LAS bf16_t*)op = (bf16_t)(p01 & 0xffffu); *(LAS bf16_t*)(op + LS * 2) = (bf16_t)(p01 >> 16); *(LAS bf16_t*)(op + 2 * LS * 2) = (bf16_t)(p23 & 0xffffu); *(LAS bf16_t*)(op + 3 * LS * 2) = (bf16_t)(p23 >> 16); }
            } else if (c > 0) GDN_HSTORE(c - 1);
            asm volatile("s_waitcnt lgkmcnt(0)" ::: "memory"); __builtin_amdgcn_s_barrier(); asm volatile("" ::: "memory");
        }
    }
    if (helper) GDN_HSTORE(67);
#undef GDN_LOAD
#undef GDN_HSTORE
}

constexpr int R_U = 0, R_A = 9216, R_B0 = R_A + 17408, R_B1 = R_B0 + 17408;
constexpr int RS = 68;
constexpr int RG_ITEMS = NB * 68 * 6;
constexpr int RG_SUM = 2 * NB * 68 * 384;

template <int MODE>
__device__ __forceinline__ void rg_pass(const bf16_t* P, const float* cw, const bf16_t* RGWT, const float* rgtab  ,
                                        float* SUMA, float* SUMH, const float* HIN, bf16_t* F, LAS unsigned char* lds, int tid, int bidx, int nblk) {
    const int n_iter = (RG_ITEMS + 2 * nblk - 1) / (2 * nblk);
#pragma unroll 1
    for (int iter = 0; iter < n_iter; ++iter) {
        int tidf = tid; asm volatile("" : "+v"(tidf));
        const int half = __builtin_amdgcn_readfirstlane(tidf >> 8), t256 = tidf & 255, w = __builtin_amdgcn_readfirstlane(t256 >> 6), lane = tidf & 63, g = lane >> 4, l15 = lane & 15;
        LAS unsigned char* hb = lds + half * G_HALF;
        LAS float* Aa = (LAS float*)(hb + R_A);
        const int it = (iter * nblk + bidx) * 2 + half;
        const bool valid = it < RG_ITEMS;
        const int n = it % 6, tc = (it / 6) % 68, b = it / 408;
        const int i = t256 >> 2, qd = t256 & 3;
        const int t = b * SEQT + tc * 64 + i;
        if (valid) {
            const int sp = tc * 64 + i, lo = sp < CTX ? 0 : CTX, hi = sp < CTX ? CTX : SEQT;
            float u[16];
#pragma unroll
            for (int e = 0; e < 16; ++e) u[e] = 0.f;
#pragma unroll
            for (int j = 0; j < 4; ++j) { const int s2 = sp + j - 2;
                if (s2 >= lo && s2 < hi) { const bf16_t* pr = P + (size_t)(t + j - 2) * LDP + C_XA + n * 64 + 16 * qd; const float* wr_ = cw + j * CONV_CH + C_XA + n * 64 + 16 * qd;
                    const v4u a0 = *(const v4u*)pr, a1 = *(const v4u*)(pr + 8); const unsigned aw[8] = {a0.x, a0.y, a0.z, a0.w, a1.x, a1.y, a1.z, a1.w};
#pragma unroll
                    for (int e2 = 0; e2 < 8; ++e2) { u[2 * e2] += wr_[2 * e2] * __uint_as_float(aw[e2] << 16); u[2 * e2 + 1] += wr_[2 * e2 + 1] * __uint_as_float(aw[e2] & 0xffff0000u); } } }
            v4u o0, o1;
            o0.x = cvtpk(u[0], u[1]); o0.y = cvtpk(u[2], u[3]); o0.z = cvtpk(u[4], u[5]); o0.w = cvtpk(u[6], u[7]);
            o1.x = cvtpk(u[8], u[9]); o1.y = cvtpk(u[10], u[11]); o1.z = cvtpk(u[12], u[13]); o1.w = cvtpk(u[14], u[15]);
            *(LAS v4u*)(hb + R_U + (i * LS + 16 * qd) * 2) = o0; *(LAS v4u*)(hb + R_U + (i * LS + 16 * qd + 8) * 2) = o1;
        }
        __syncthreads();
#pragma unroll
        for (int d = 0; d < 2; ++d) {
            LAS float* Bd = (LAS float*)(hb + (d == 0 ? R_B0 : R_B1));
            if (valid) {
                const bf16x8_t a0 = lds_frag(hb + R_U, 16 * w + l15, 8 * g), a1 = lds_frag(hb + R_U, 16 * w + l15, 32 + 8 * g);
                const bf16_t* wa_t = RGWT + (size_t)((d * 6 + n) * 2) * 4096; const bf16_t* wx_t = wa_t + 4096;
#pragma unroll
                for (int nt = 0; nt < 4; ++nt) {
                    const int e = 16 * nt + l15, ch = n * 64 + e;
                    const bf16x8_t ba0 = *(const bf16x8_t*)(wa_t + e * 64 + 8 * g), ba1 = *(const bf16x8_t*)(wa_t + e * 64 + 32 + 8 * g);
                    const bf16x8_t bx0 = *(const bf16x8_t*)(wx_t + e * 64 + 8 * g), bx1 = *(const bf16x8_t*)(wx_t + e * 64 + 32 + 8 * g);
                    f32x4_t ra = {0.f, 0.f, 0.f, 0.f}, ri = {0.f, 0.f, 0.f, 0.f};
                    ra = __builtin_amdgcn_mfma_f32_16x16x32_bf16(a0, ba0, ra, 0, 0, 0); ra = __builtin_amdgcn_mfma_f32_16x16x32_bf16(a1, ba1, ra, 0, 0, 0);
                    ri = __builtin_amdgcn_mfma_f32_16x16x32_bf16(a0, bx0, ri, 0, 0, 0); ri = __builtin_amdgcn_mfma_f32_16x16x32_bf16(a1, bx1, ri, 0, 0, 0);
                    const float bav = rgtab[d * 384 + ch], bxv = rgtab[768 + d * 384 + ch], ls8 = rgtab[1536 + d * 384 + ch];
#pragma unroll
                    for (int r = 0; r < 4; ++r) {
                        const int tok = 16 * w + 4 * g + r;
                        const float uu = bf2f(*(const LAS bf16_t*)(hb + R_U + (tok * LS + e) * 2));
                        const float rr = __frcp_rn(1.0f + __expf(-(ra[r] + bav))), ig = __frcp_rn(1.0f + __expf(-(ri[r] + bxv)));
                        const float log_a = rr * ls8, y = 2.0f * log_a;
                        const float om = -y * (1.0f + y * (0.5f + y * ((1.0f / 6.0f) + y * ((1.0f / 24.0f) + y * ((1.0f / 120.0f) + y * ((1.0f / 720.0f) + y * (1.0f / 5040.0f)))))));
                        Aa[tok * RS + e] = __expf(log_a); Bd[tok * RS + e] = __fsqrt_rn(om) * (ig * uu);
                    }
                }
            }
            __syncthreads();
            if (valid && w == 0) {
                const int ch = n * 64 + lane; const size_t si = ((size_t)(d * NB + b) * 68 + tc) * 384 + ch;
                float h = MODE == 3 ? HIN[si] : 0.f, ap = 1.f;
#pragma unroll 8
                for (int step = 0; step < 64; ++step) { const int tok = d ? 63 - step : step; const float a = Aa[tok * RS + lane];
                    h = a * h + Bd[tok * RS + lane]; if (MODE == 3) Bd[tok * RS + lane] = h; else ap *= a; }
                if (MODE == 1) { SUMA[si] = ap; SUMH[si] = h; }
            }
            __syncthreads();
        }
        if (MODE == 3 && valid) {
            const LAS float* B0 = (const LAS float*)(hb + R_B0); const LAS float* B1 = (const LAS float*)(hb + R_B1);
            const bf16_t* zp = P + (size_t)t * LDP + C_ZA + n * 64 + 16 * qd;
            const v4u z0 = *(const v4u*)zp, z1 = *(const v4u*)(zp + 8); const unsigned zw[8] = {z0.x, z0.y, z0.z, z0.w, z1.x, z1.y, z1.z, z1.w};
            unsigned ow[8];
#pragma unroll
            for (int e2 = 0; e2 < 8; ++e2) { const int e = 16 * qd + 2 * e2;
                const float h0 = B0[i * RS + e] + B1[i * RS + e], h1 = B0[i * RS + e + 1] + B1[i * RS + e + 1];
                ow[e2] = cvtpk(h0 * siluf_(__uint_as_float(zw[e2] << 16)), h1 * siluf_(__uint_as_float(zw[e2] & 0xffff0000u))); }
            v4u o0 = {ow[0], ow[1], ow[2], ow[3]}, o1 = {ow[4], ow[5], ow[6], ow[7]};
            bf16_t* fp = F + (size_t)t * 1024 + n * 64 + 16 * qd;
            *(v4u*)fp = o0; *(v4u*)(fp + 8) = o1;
        }
        __syncthreads();
    }
}
__device__ __forceinline__ void rg_carry(const float* SUMA, const float* SUMH, float* HIN, int idx) {
    const int ch = idx % 384, b = (idx / 384) % NB, d = idx / (384 * NB);
    const size_t base = ((size_t)(d * NB + b) * 68) * 384 + ch;
    float h = 0.f;
#pragma unroll 4
    for (int s = 0; s < 68; ++s) { const int tc = d == 0 ? s : (s < 4 ? 3 - s : 71 - s);
        const size_t k = base + (size_t)tc * 384; HIN[k] = h; h = SUMA[k] * h + SUMH[k]; }
}

constexpr int NA_LAT_ITEMS = NB * 6 * 64 * 4, NA_CTX_ITEMS = NB * 6 * 16;
__device__ __forceinline__ void na_mfma_item(const bf16_t* P, const bf16_t* VT, const LAS float* rpbl, bf16_t* F, int item, int lane) {
    const int g = lane >> 4, l15 = lane & 15;
    const bool latent = item < NA_LAT_ITEMS;
    int b, hh, r, qb;
    if (latent) { qb = item & 3; r = (item >> 2) & 63; const int bh = item >> 8; hh = bh % 6; b = bh / 6; }
    else { const int it2 = item - NA_LAT_ITEMS; qb = it2 & 15; const int bh = it2 >> 4; hh = bh % 6; b = bh / 6; r = 0; }
    const int tq = latent ? b * SEQT + CTX + r * 64 + 16 * qb + l15 : b * SEQT + 16 * qb + l15;
    const bf16_t* qp = P + (size_t)tq * LDP + C_QN + hh * 64 + 8 * g;
    const bf16x8_t bq0 = *(const bf16x8_t*)qp, bq1 = *(const bf16x8_t*)(qp + 32);
    const int c0 = qb == 0 ? 0 : (qb == 1 ? 8 : (qb == 2 ? 24 : 32));
    const int r0 = min(max(r - 4, 0), 56), jq = 16 * qb + l15, cs = min(max(jq - 8, 0), 48);
    const int ia = 8 * (l15 >> 2) + (l15 & 3);
    float sc[16][8];
#pragma unroll
    for (int G = 0; G < 16; ++G) {
        const bool loc = G < 8;
        if (loc && !latent) {
#pragma unroll
            for (int e = 0; e < 8; ++e) sc[G][e] = -1e30f;
            continue; }
        const int tok0 = loc ? b * SEQT + CTX + (r0 + G) * 64 + c0 : b * SEQT + 32 * (G - 8);
        const bf16_t* ka = P + (size_t)(tok0 + ia) * LDP + C_KN + hh * 64 + 8 * g; const bf16_t* kb = ka + 4 * LDP;
        const bf16x8_t aa0 = *(const bf16x8_t*)ka, aa1 = *(const bf16x8_t*)(ka + 32), ab0 = *(const bf16x8_t*)kb, ab1 = *(const bf16x8_t*)(kb + 32);
        f32x4_t sa = {0.f, 0.f, 0.f, 0.f}, sb = {0.f, 0.f, 0.f, 0.f};
        sa = __builtin_amdgcn_mfma_f32_16x16x32_bf16(aa0, bq0, sa, 0, 0, 0); sa = __builtin_amdgcn_mfma_f32_16x16x32_bf16(aa1, bq1, sa, 0, 0, 0);
        sb = __builtin_amdgcn_mfma_f32_16x16x32_bf16(ab0, bq0, sb, 0, 0, 0); sb = __builtin_amdgcn_mfma_f32_16x16x32_bf16(ab1, bq1, sb, 0, 0, 0);
#pragma unroll
        for (int e = 0; e < 8; ++e) {
            float v = (e < 4 ? sa[e & 3] : sb[e & 3]) * 0.125f;
            if (loc) { const int kc = c0 + 8 * g + e; const bool ok = kc >= cs && kc < cs + 16;
                const float bias = rpbl[hh * 465 + (r0 + G - r + 7) * 31 + (ok ? kc - jq + 15 : 0)];
                v = ok ? v + bias : -1e30f; }
            sc[G][e] = v;
        }
    }
    float m = -1e30f;
#pragma unroll
    for (int G = 0; G < 16; ++G)
#pragma unroll
        for (int e = 0; e < 8; ++e) m = fmaxf(m, sc[G][e]);
    m = fmaxf(m, shx(m, 16)); m = fmaxf(m, shx(m, 32));
    f32x4_t o[4]; float lsum = 0.f;
#pragma unroll
    for (int dt = 0; dt < 4; ++dt) o[dt] = (f32x4_t){0.f, 0.f, 0.f, 0.f};
    const bf16_t* vbase = VT + (size_t)(hh * 64 + l15) * T + 8 * g;
#pragma unroll
    for (int G = 0; G < 16; ++G) {
        const bool loc = G < 8;
        if (loc && !latent) continue;
        const int tok0 = loc ? b * SEQT + CTX + (r0 + G) * 64 + c0 : b * SEQT + 32 * (G - 8);
        float pv[8];
#pragma unroll
        for (int e = 0; e < 8; ++e) { pv[e] = __expf(sc[G][e] - m); lsum += pv[e]; }
        v4u pk; pk.x = cvtpk(pv[0], pv[1]); pk.y = cvtpk(pv[2], pv[3]); pk.z = cvtpk(pv[4], pv[5]); pk.w = cvtpk(pv[6], pv[7]);
        const bf16x8_t bp = __builtin_bit_cast(bf16x8_t, pk);
#pragma unroll
        for (int dt = 0; dt < 4; ++dt) { const bf16x8_t av = *(const bf16x8_t*)(vbase + (size_t)(16 * dt) * T + tok0);
            o[dt] = __builtin_amdgcn_mfma_f32_16x16x32_bf16(av, bp, o[dt], 0, 0, 0); }
    }
    lsum += shx(lsum, 16); lsum += shx(lsum, 32);
    const float inv = __frcp_rn(lsum);
#pragma unroll
    for (int dt = 0; dt < 4; ++dt) {
        const v2u zr = *(const v2u*)(P + (size_t)tq * LDP + C_ZN + hh * 64 + 16 * dt + 4 * g);
        const float z0 = __uint_as_float(zr.x << 16), z1 = __uint_as_float(zr.x & 0xffff0000u), z2 = __uint_as_float(zr.y << 16), z3 = __uint_as_float(zr.y & 0xffff0000u);
        v2u ov; ov.x = cvtpk(o[dt][0] * inv * siluf_(z0), o[dt][1] * inv * siluf_(z1)); ov.y = cvtpk(o[dt][2] * inv * siluf_(z2), o[dt][3] * inv * siluf_(z3));
        *(v2u*)(F + (size_t)tq * 1024 + 384 + hh * 64 + 16 * dt + 4 * g) = ov;
    }
}
__device__ __forceinline__ void vt_transpose(const bf16_t* P, bf16_t* VT, LAS unsigned char* scr, int gw, int NGW, int lane) {
    for (int it = gw; it < NB * 68 * 6; it += NGW) {
        const int hh = it % 6, tcb = it / 6, t0 = (tcb / 68) * SEQT + (tcb % 68) * 64;
        const bf16_t* src = P + (size_t)(t0 + lane) * LDP + C_VN + hh * 64;
#pragma unroll
        for (int q8 = 0; q8 < 8; ++q8) *(LAS v4u*)(scr + (lane * LS + 8 * q8) * 2) = *(const v4u*)(src + 8 * q8);
        LDS_WAIT();
        bf16_t* dst = VT + (size_t)(hh * 64 + lane) * T + t0;
#pragma unroll
        for (int q8 = 0; q8 < 8; ++q8) { unsigned w4[4];
#pragma unroll
            for (int e2 = 0; e2 < 4; ++e2) { const unsigned lo = *(const LAS bf16_t*)(scr + ((8 * q8 + 2 * e2) * LS + lane) * 2), hi = *(const LAS bf16_t*)(scr + ((8 * q8 + 2 * e2 + 1) * LS + lane) * 2); w4[e2] = lo | (hi << 16); }
            v4u o = {w4[0], w4[1], w4[2], w4[3]}; *(v4u*)(dst + 8 * q8) = o; }
        LDS_WAIT();
    }
}
#define XB_TMO      128
#define XB_XCNT(j)  (256  + 64 * (j))
#define XB_XSUB(j)  (1280 + 64 * (j))
#define XB_XGEN(j)  (2304 + 64 * (j))
#define XB_TOP      3328
#define XB_TOPGEN   3392
#define XCD_BAR_WORDS 3456
#define XB_SPIN_CAP (1u << 18)

__device__ __forceinline__ unsigned xb_ld(unsigned* p)              { return __hip_atomic_load(p, __ATOMIC_RELAXED, __HIP_MEMORY_SCOPE_AGENT); }
__device__ __forceinline__ unsigned xb_add(unsigned* p, unsigned v) { return __hip_atomic_fetch_add(p, v, __ATOMIC_RELAXED, __HIP_MEMORY_SCOPE_AGENT); }
__device__ __forceinline__ unsigned xb_xcc_id() { return (unsigned)__builtin_amdgcn_s_getreg((3 << 11) | 20) & 0xFu; }
#define XB_SPIN(cond, bar) do { unsigned _sp = 0; while (cond) { __builtin_amdgcn_s_sleep(1); \
    if ((++_sp & 255u) == 0u) { if (xb_ld(&(bar)[XB_TMO])) break; if (_sp > XB_SPIN_CAP) { atomicAdd(&(bar)[XB_TMO], 1u); break; } } } } while (0)

struct XcdBarrier {
    unsigned* bar; unsigned x;
    volatile LAS unsigned* st;
};

__device__ __forceinline__ XcdBarrier xcd_barrier_post(unsigned* bar, volatile LAS unsigned* st) {
    XcdBarrier b; b.bar = bar; b.x = xb_xcc_id(); b.st = st;
    if (threadIdx.x == 0) (void)xb_add(&bar[XB_XCNT(b.x)], 1u);
    return b;
}
__device__ __forceinline__ void xcd_barrier_complete(unsigned* bar, unsigned x, unsigned& nloc, unsigned& nx) {
    const unsigned G = gridDim.x * gridDim.y * gridDim.z;
    unsigned sum, cnt, mine, sp = 0u;
    for (;;) {
        sum = 0u; cnt = 0u; mine = 0u;
#pragma unroll
        for (unsigned j = 0; j < 16; ++j) { const unsigned c = xb_ld(&bar[XB_XCNT(j)]); sum += c; cnt += (c > 0u) ? 1u : 0u; mine = (j == x) ? c : mine; }
        if (sum == G) break;
        __builtin_amdgcn_s_sleep(1);
        if ((++sp & 255u) == 0u) { if (xb_ld(&bar[XB_TMO])) break; if (sp > XB_SPIN_CAP) { atomicAdd(&bar[XB_TMO], 1u); break; } }
    }
    nloc = mine > 0u ? mine : 1u; nx = cnt > 0u ? cnt : 1u;
}

__device__ __forceinline__ void xcd_barrier(const XcdBarrier& b) {
    asm volatile("s_waitcnt vmcnt(0)" ::: "memory");
    __syncthreads();
    if (threadIdx.x == 0) {
        unsigned* bar = b.bar;
        __builtin_amdgcn_s_waitcnt(0);
        unsigned nloc = b.st[0], nx = b.st[1];
        if (nloc == 0u) { xcd_barrier_complete(bar, b.x, nloc, nx); b.st[0] = nloc; b.st[1] = nx; }
        const unsigned old = xb_add(&bar[XB_XSUB(b.x)], 1u);
        const unsigned gen = old / nloc;
        if (old + 1u == (gen + 1u) * nloc) {
            __builtin_amdgcn_fence(__ATOMIC_RELEASE, "agent");
            asm volatile("s_waitcnt vmcnt(0)" ::: "memory");
            const unsigned og = xb_add(&bar[XB_TOP], 1u);
            const unsigned tg = og / nx;
            if (og + 1u == (tg + 1u) * nx) xb_add(&bar[XB_TOPGEN], 1u);
            else XB_SPIN(xb_ld(&bar[XB_TOPGEN]) == tg, bar);
            __builtin_amdgcn_fence(__ATOMIC_ACQUIRE, "agent");
            xb_add(&bar[XB_XGEN(b.x)], 1u);
            asm volatile("s_waitcnt vmcnt(0)" ::: "memory");
        } else {
            XB_SPIN(xb_ld(&bar[XB_XGEN(b.x)]) == gen, bar);
            __builtin_amdgcn_fence(__ATOMIC_ACQUIRE, "agent");
            asm volatile("s_waitcnt vmcnt(0)" ::: "memory");
        }
    }
    __syncthreads();
}


#ifndef REP_P2A
#define REP_P2A 1
#endif
#ifndef REP_P2B
#define REP_P2B 1
#endif
#ifndef REP_CH
#define REP_CH 1
#endif
#ifndef REP_NA
#define REP_NA 1
#endif
#ifndef REP_GDN1
#define REP_GDN1 1
#endif
#ifndef REP_RG1
#define REP_RG1 1
#endif
#ifndef REP_VT
#define REP_VT 1
#endif
#ifndef REP_COMB
#define REP_COMB 1
#endif
#ifndef REP_RG3
#define REP_RG3 1
#endif
#ifndef REP_G2
#define REP_G2 1
#endif
#ifndef REP_P5
#define REP_P5 1
#endif
#ifndef REP_P3
#define REP_P3 1
#endif
#ifndef REP_G1
#define REP_G1 1
#endif
#ifndef REP_SYNC
#define REP_SYNC 1
#endif
#define GSYNC() do { _Pragma("unroll 1") for (int rs_ = 0, nrs_ = opq(REP_SYNC); rs_ < nrs_; ++rs_) { XcdBarrier xb_; xb_.bar = (unsigned*)(WSB + WS_BAR); xb_.x = xb_xcc_id(); xb_.st = (volatile LAS unsigned*)(lds + LDS_BAR_OFF); xcd_barrier(xb_); } } while (0)
__device__ __forceinline__ int opq(int i) { asm volatile("" : "+s"(i)); return i; }
#define IN(i) ((const float*)p.ptr[opq(i)])
#define WSB ((unsigned char*)p.ptr[opq(21)])
#define OUTP ((float*)p.ptr[opq(20)])
#define ctl ((unsigned*)(WSB + WS_CTL))
#define mod ((float*)(WSB + WS_MOD))
#define WTIN ((bf16_t*)(WSB + WS_WTIN))
#define WTOUT ((bf16_t*)(WSB + WS_WTOUT))
#define X ((float*)(WSB + WS_X))
#define UF ((bf16_t*)(WSB + WS_UF))
#define P ((bf16_t*)(WSB + WS_P))
#define gdn0 ((unsigned char*)OUTP)
#define gdnx (WSB + WS_GDNX)
#define VT ((bf16_t*)(WSB + WS_VT))
#define rcos ((float*)(WSB + WS_ROPE))
#define rsin ((float*)(WSB + WS_ROPE) + 1024)
#define RGWT ((bf16_t*)(WSB + WS_RGWT))
#define rgtab ((float*)(WSB + WS_RGTAB))
#define SUMA ((float*)(WSB + WS_RGS))
#define SUMH ((float*)(WSB + WS_RGS) + (1 << 18))
#define HIN ((float*)(WSB + WS_RGS) + (2 << 18))
__device__ __forceinline__ int fresh_v(int v) { asm volatile("" : "+v"(v)); return v; }
__device__ __forceinline__ int lane_now() { int l; asm volatile("v_mbcnt_lo_u32_b32 %0, -1, 0\n\tv_mbcnt_hi_u32_b32 %0, -1, %0" : "=v"(l)); return l; }
enum { I_X = 0, I_C, I_CTX, I_CCTX, I_WMOD, I_BMOD, I_WIN, I_CONVW, I_RGWA, I_RGBA, I_RGWX, I_RGBX, I_RGLAM, I_RPB, I_ALOG, I_DTB, I_NW, I_WOUT, I_LNG, I_LNB };
__global__ void __launch_bounds__(512, 2) mega_fwd(Params p) {
    extern __shared__ __attribute__((aligned(16))) unsigned char lds_raw[];
    LAS unsigned char* lds = (LAS unsigned char*)lds_raw;
    cg::grid_group grid = cg::this_grid();
    const int bid = (int)blockIdx.x; __builtin_assume(bid >= 0 && bid < 256);
    const int wid = __builtin_amdgcn_readfirstlane((int)threadIdx.x >> 6);
#define lane0 lane_now()
#define tid (wid * 64 + lane_now())
#define BIDL opq(bid)
#define WIDL opq(wid)
    const int gw0 = bid * 8 + wid, NGW = 2048;
    if (threadIdx.x < 2) ((volatile LAS unsigned*)(lds + LDS_BAR_OFF))[threadIdx.x] = 0u;
    __syncthreads();
    (void)xcd_barrier_post((unsigned*)(WSB + WS_BAR), (volatile LAS unsigned*)(lds + LDS_BAR_OFF));
    const int gw = gw0;
    LAS float* wscr = (LAS float*)(lds + wid * 16384);
    { const int lane = lane_now();

    phase_mods(IN(I_C), IN(I_CCTX), IN(I_WMOD), IN(I_BMOD), mod, (LAS float*)lds, wid, lane);
    convert_weights(IN(I_WIN), IN(I_WOUT), WTIN, WTOUT, wscr, gw, NGW, lane);
    convert_rg(IN(I_RGWA), IN(I_RGBA), IN(I_RGWX), IN(I_RGBX), IN(I_RGLAM), RGWT, rgtab, (int)blockIdx.x * 512 + tid, (int)gridDim.x * 512);
    if (blockIdx.x == 0) { for (int e = tid; e < 1024; e += 512) { const float ang = (float)(e >> 4) * expf(-(float)(e & 15) * (9.210340371976184f / 16.0f)); rcos[e] = cosf(ang); rsin[e] = sinf(ang); } }
    grid.sync();
    prep_rows0(IN(I_X), IN(I_CTX), mod, UF, gw, NGW, lane);
    }
    GSYNC();
#pragma unroll 1
    for (int l = 0; l < DEPTH; ++l) {
        const float* modl = mod + (size_t)l * 5 * 3072;
        { pg8::Gemm g{UF, WTIN, T, NPAD, D}; pg8::StaticOrder S; S.init(T, NPAD, 256, BIDL);
          pg8::EpiP E{P};
          _Pragma("unroll 1") for (int rp = 0, nrp = opq(REP_G1); rp < nrp; ++rp)
          pg8::gemm_phase<pg8::EpiP, pg8::StaticOrder, true, true>(lds, g, S, E, WIDL * 64 + lane_now());
        }
        GSYNC();
        _Pragma("unroll 1") for (int rp = 0, nrp = opq(REP_P2A); rp < nrp; ++rp) {
#ifndef ABL_P1
        _Pragma("unroll 1") for (int r2 = 0, n2 = opq(REP_GDN1); r2 < n2; ++r2)
        gdn_pass1(P, IN(I_CONVW) + (size_t)l * 4 * CONV_CH, IN(I_ALOG) + l * 8, IN(I_DTB) + l * 8, rcos, rsin, gdn0, gdnx, lds, (WIDL * 64 + lane_now()), BIDL, opq(256));
#endif
        _Pragma("unroll 1") for (int r2 = 0, n2 = opq(REP_RG1); r2 < n2; ++r2)
        rg_pass<1>(P, IN(I_CONVW) + (size_t)l * 4 * CONV_CH, RGWT, rgtab, SUMA, SUMH, nullptr, nullptr, lds, (WIDL * 64 + lane_now()), BIDL, opq(256));
        _Pragma("unroll 1") for (int r2 = 0, n2 = opq(REP_VT); r2 < n2; ++r2)
        vt_transpose(P, VT, lds + WIDL * 16384, (BIDL * 8 + WIDL), NGW, fresh_v(lane0));
        __syncthreads(); }
        GSYNC();
        _Pragma("unroll 1") for (int rp = 0, nrp = opq(REP_P2B); rp < nrp; ++rp) { const int lane = fresh_v(lane0); const int bx = BIDL;
            const float* rpb = IN(I_RPB) + (size_t)l * 6 * 15 * 31;
            for (int e = (WIDL * 64 + lane_now()); e < 6 * 465; e += 512) ((LAS float*)lds)[e] = rpb[e];
            __syncthreads();
#ifndef ABL_CH
            if (bx < 32) _Pragma("unroll 1") for (int r2 = 0, n2 = opq(REP_CH); r2 < n2; ++r2) gdn_chain(gdn0, gdnx, P, bx, lds + 65536, WIDL, lane);
#endif
            if (bx >= 32 && bx < 38) rg_carry(SUMA, SUMH, HIN, (bx - 32) * 512 + (WIDL * 64 + lane_now()));
            const int n_items = NA_LAT_ITEMS + (l < DEPTH - 1 ? NA_CTX_ITEMS : 0);
            _Pragma("unroll 1") for (int r3 = 0, n3 = opq(REP_NA); r3 < n3; ++r3) {
            unsigned* cnt = ctl + 64 * (l + 1) + 16 * rp + 8 * r3;
            for (;;) {
                int it = 0;
                if (lane == 0) it = (int)__hip_atomic_fetch_add(cnt, 1u, __ATOMIC_RELAXED, __HIP_MEMORY_SCOPE_AGENT);
                it = __builtin_amdgcn_readfirstlane(it);
                if (it >= n_items) break;
                na_mfma_item(P, VT, (const LAS float*)lds, UF, it, lane);
            } }
            __syncthreads();
        }
        GSYNC();
        _Pragma("unroll 1") for (int rp = 0, nrp = opq(REP_P3); rp < nrp; ++rp) {
        _Pragma("unroll 1") for (int r2 = 0, n2 = opq(REP_RG3); r2 < n2; ++r2)
        rg_pass<3>(P, IN(I_CONVW) + (size_t)l * 4 * CONV_CH, RGWT, rgtab, nullptr, nullptr, HIN, UF, lds, (WIDL * 64 + lane_now()), BIDL, opq(256));
        { const int lane = fresh_v(lane0); const int gw = (BIDL * 8 + WIDL); _Pragma("unroll 1") for (int r2 = 0, n2 = opq(REP_COMB); r2 < n2; ++r2) combine_rows(P, IN(I_NW) + l * 64, UF, gw, NGW, lane); } }
        GSYNC();
        { pg8::Gemm g{UF, WTOUT, T, D, D}; pg8::StaticOrder S; S.init(T, D, 256, BIDL);
          if (opq(REP_G2) > 1) { pg8::EpiZ E2{IN(I_X), IN(I_CTX), X, (float*)P, modl, l == 0 ? 1 : 0};
            pg8::gemm_phase<pg8::EpiZ, pg8::StaticOrder, true, true>(lds, g, S, E2, WIDL * 64 + lane_now()); }
          pg8::EpiZ E{IN(I_X), IN(I_CTX), X, X, modl, l == 0 ? 1 : 0};
#ifndef ABL_G2
          pg8::gemm_phase<pg8::EpiZ, pg8::StaticOrder, true, true>(lds, g, S, E, WIDL * 64 + lane_now());
#endif
        }
        GSYNC();
        if (l < DEPTH - 1) { const int lane = fresh_v(lane0); const int gw = (BIDL * 8 + WIDL);
            if (opq(REP_P5) > 1) { ln_rows(X, (float*)P, IN(I_LNG) + l * D, IN(I_LNB) + l * D, nullptr, mod + (size_t)(l + 1) * 5 * 3072, (bf16_t*)((unsigned char*)P + 72 * MiB), gw, NGW, lane);
                convert_weights(IN(I_WIN) + (size_t)(l + 1) * D * DIN, IN(I_WOUT) + (size_t)(l + 1) * D * D, WTIN, WTOUT, (LAS float*)(lds + WIDL * 16384), gw, NGW, lane); }
            ln_rows(X, X, IN(I_LNG) + l * D, IN(I_LNB) + l * D, nullptr, mod + (size_t)(l + 1) * 5 * 3072, UF, gw, NGW, lane);
            convert_weights(IN(I_WIN) + (size_t)(l + 1) * D * DIN, IN(I_WOUT) + (size_t)(l + 1) * D * D, WTIN, WTOUT, (LAS float*)(lds + WIDL * 16384), gw, NGW, lane);
            convert_rg(IN(I_RGWA) + (size_t)(l + 1) * 49152, IN(I_RGBA) + (l + 1) * 768, IN(I_RGWX) + (size_t)(l + 1) * 49152, IN(I_RGBX) + (l + 1) * 768, IN(I_RGLAM) + (l + 1) * 768, RGWT, rgtab, BIDL * 512 + (WIDL * 64 + lane_now()), opq(256) * 512);
            GSYNC();
        } else { const int lane = fresh_v(lane0); const int gw = (BIDL * 8 + WIDL); ln_rows(X, X, IN(I_LNG) + l * D, IN(I_LNB) + l * D, OUTP, nullptr, nullptr, gw, NGW, lane); }
    }
}
#undef ctl
#undef mod
#undef WTIN
#undef WTOUT
#undef X
#undef UF
#undef P
#undef gdn0
#undef gdnx
#undef VT
#undef rcos
#undef rsin
#undef RGWT
#undef rgtab
#undef SUMA
#undef SUMH
#undef HIN
#undef lane0
#undef BIDL
#undef WIDL
#undef tid
}

extern "C" void kernel_launch(void* const* d_in, const int* in_sizes, int n_in, void* d_out, int out_size, void* d_ws, size_t ws_size, hipStream_t stream) {
    static int grid = 0;
    if (grid == 0) {
        if (n_in != 20 || ws_size < WS_END) { fprintf(stderr, "kernel_launch: unexpected n_in %d / ws_size %zu\n", n_in, ws_size); grid = -1; return; }
        int dev = 0, cus = 0, per_cu = 0;
        hipGetDevice(&dev);
        hipDeviceGetAttribute(&cus, hipDeviceAttributeMultiprocessorCount, dev);
        if (hipFuncSetAttribute((const void*)mega_fwd, hipFuncAttributeMaxDynamicSharedMemorySize, LDS_BYTES) != hipSuccess) { fprintf(stderr, "kernel_launch: hipFuncSetAttribute failed\n"); grid = -1; return; }
        if (hipOccupancyMaxActiveBlocksPerMultiprocessor(&per_cu, (const void*)mega_fwd, 512, LDS_BYTES) != hipSuccess || per_cu < 1) { fprintf(stderr, "kernel_launch: occupancy query gave %d\n", per_cu); per_cu = 1; }
        (void)hipGetLastError();
        grid = 256;
        if (cus < 256) { fprintf(stderr, "kernel_launch: needs 256 CUs, device has %d\n", cus); grid = -1; return; }
        fprintf(stderr, "kernel_launch: cus %d per_cu %d grid %d\n", cus, per_cu, grid);
    }
    if (grid < 0) return;
    hipMemsetAsync((char*)d_ws + WS_CTL, 0, CTL_ZERO_BYTES, stream);
    Params prm{};
    for (int i = 0; i < 20; ++i) prm.ptr[i] = d_in[i];
    prm.ptr[20] = d_out; prm.ptr[21] = d_ws;
    void* args[] = {&prm};
    hipError_t e = hipLaunchCooperativeKernel((const void*)mega_fwd, dim3(grid), dim3(512), args, LDS_BYTES, stream);
    if (e != hipSuccess) fprintf(stderr, "cooperative launch failed: %s (grid %d)\n", hipGetErrorString(e), grid);
}
```

```cpp
#include <hip/hip_runtime.h>
#include <hip/hip_cooperative_groups.h>
#include <cstdio>
#include <cstdint>
namespace cg = cooperative_groups;

namespace {
constexpr int D = 1024, NB = 4, SEQ = 4096, DEPTH = 4, CTX = 256;
constexpr int SEQT = CTX + SEQ;
constexpr int T = NB * SEQT;
constexpr int DIN = 3344, LDP = 3360, NPAD = 3584;
constexpr int CONV_CH = 1152;
constexpr int C_XA = 0, C_QG = 384, C_KG = 640, C_VG = 896, C_ZA = 1152, C_QN = 1536, C_KN = 1920, C_VN = 2304,
              C_ZN = 2688, C_ZG = 3072, C_BR = 3328, C_AR = 3336;
constexpr float ALPHA = 1.681792830507429f;
}
namespace pg8 {
#define PG8_LAS __attribute__((address_space(3)))
typedef unsigned short bf16_t;
typedef short bf16x8 __attribute__((ext_vector_type(8)));
typedef float f32x4 __attribute__((ext_vector_type(4)));
typedef unsigned u32x4 __attribute__((ext_vector_type(4)));
constexpr int BM = 256, BK = 64, HALF = 128, HTB = HALF * BK * 2  , STAGE_BYTES = 8 * HTB, NXCD = 8, WGM = 8;

__host__ __device__ __forceinline__ int lds_byte(int r, int c) { const int st = (r >> 4) * 2 + (c >> 5), rr = r & 15, cc = c & 31, ob = rr * 64 + cc * 2; return st * 1024 + (ob ^ (((ob >> 9) & 1) << 5)); }
__host__ __device__ __forceinline__ void stage_rc(int b, int& R, int& C) { const int st = b / 1024, sb = b % 1024, swz = sb ^ (((sb >> 9) & 1) << 5); R = (st >> 1) * 16 + swz / 64; C = (st & 1) * 32 + (swz % 64) / 2; }
__host__ __device__ __forceinline__ int perm32(int rho) { const int n = rho >> 4, i = rho & 15; return 8 * (i >> 2) + 4 * n + (i & 3); }

struct Unit { int pm, pn; };
struct Gemm { const bf16_t* A; const bf16_t* Bt; int M, N, K; };

struct StaticOrder {
    int nM, nN, nwg, G, c;
    __host__ __device__ void init(int M, int N, int G_, int c_) { nM = M / BM; nN = N / BM; nwg = nM * nN; G = G_; c = c_; }
    __host__ __device__ bool next(int i, Unit& u) const {
        const long L = (long)i * G + c; if (L >= nwg) return false;
        int wgid = (int)L; { const int q = nwg / NXCD, r = nwg % NXCD, xcd = wgid % NXCD, off = wgid / NXCD; wgid = (xcd < r ? xcd * (q + 1) : r * (q + 1) + (xcd - r) * q) + off; }
        const int nig = WGM * nN, gid = wgid / nig, fm = gid * WGM, gsz = (nM - fm) < WGM ? (nM - fm) : WGM;
        u.pm = fm + ((wgid % nig) % gsz); u.pn = (wgid % nig) / gsz; return true;
    }
    __device__ __forceinline__ void a_ready(const Unit&) const {}
    __device__ __forceinline__ void done(const Unit&) const {}
};

typedef __bf16 bf16v2 __attribute__((ext_vector_type(2)));
typedef float f32v2 __attribute__((ext_vector_type(2)));
__device__ __forceinline__ unsigned cvt_pk_bf16(float lo, float hi) { const f32v2 v = {lo, hi}; return __builtin_bit_cast(unsigned, __builtin_convertvector(v, bf16v2)); }
struct EpiP {
    static constexpr bool PERM = true, AFTER_DRAIN = false;
    bf16_t* P;
    __device__ __forceinline__ void operator()(const f32x4 (&acc)[2][2][4][2], const Unit& u, int wr, int wc, int fr, int fq) const {
        asm volatile("" : "+v"(fr), "+v"(fq));
        const int row0 = u.pm * BM + wr * 64 + fr, col0 = u.pn * BM + wc * 32 + 8 * fq;
#pragma unroll
        for (int ai = 0; ai < 2; ++ai)
#pragma unroll
            for (int m = 0; m < 4; ++m) { bf16_t* rowp = P + (size_t)(row0 + ai * HALF + m * 16) * LDP + col0;
#pragma unroll
                for (int bj = 0; bj < 2; ++bj) { if (col0 + bj * HALF < LDP) { const f32x4 v0 = acc[ai][bj][m][0], v1 = acc[ai][bj][m][1];
                    u32x4 w; w.x = cvt_pk_bf16(v0[0], v0[1]); w.y = cvt_pk_bf16(v0[2], v0[3]); w.z = cvt_pk_bf16(v1[0], v1[1]); w.w = cvt_pk_bf16(v1[2], v1[3]);
                    *(u32x4*)(rowp + bj * HALF) = w; } } }
    }
};
struct EpiZ {
    static constexpr bool PERM = false, AFTER_DRAIN = false;
    const float* x_in; const float* ctx_in; const float* X; float* Xout; const float* modl; int layer0;
    __device__ __forceinline__ void operator()(const f32x4 (&acc)[2][2][4][2], const Unit& u, int wr, int wc, int fr, int fq) const {
        asm volatile("" : "+v"(fr), "+v"(fq));
        const int row0 = u.pm * BM + wr * 64 + fr, col0 = u.pn * BM + wc * 32 + 4 * fq;
#pragma unroll
        for (int ai = 0; ai < 2; ++ai)
#pragma unroll
            for (int m = 0; m < 4; ++m) { const int r = row0 + ai * HALF + m * 16; const int b = r / SEQT, sp = r - b * SEQT; const int j = sp < CTX ? 4 : b;
                const float* xs = layer0 ? (sp < CTX ? ctx_in + ((size_t)b * CTX + sp) * D : x_in + ((size_t)b * SEQ + (sp - CTX)) * D) : X + (size_t)r * D;
                float* zo = Xout + (size_t)r * D; const float* gp = modl + j * 3072 + 2048;
#pragma unroll
                for (int bj = 0; bj < 2; ++bj)
#pragma unroll
                    for (int n = 0; n < 2; ++n) { const int c = col0 + bj * HALF + n * 16; const f32x4 xv = *(const f32x4*)(xs + c), gv = *(const f32x4*)(gp + c);
                        *(f32x4*)(zo + c) = xv * ALPHA + gv * acc[ai][bj][m][n]; } }
    }
};

template <class Epi, class Sched, bool ALIGN_EPI = false, bool SP2 = false>
__device__ __forceinline__ void gemm_phase(PG8_LAS unsigned char* lds, const Gemm g, const Sched& S, const Epi& E, const int tid  ) {
    const int wid = __builtin_amdgcn_readfirstlane(tid >> 6), lane = tid & 63, wr = wid >> 2, wc = wid & 3, fr = lane & 15, fq = lane >> 4;
    const int K = g.K, nt = K / BK;
    unsigned voffA[2], voffB[2];
#pragma unroll
    for (int i = 0; i < 2; ++i) { int R, C; stage_rc(tid * 16 + i * 8192, R, C); const int Rb = Epi::PERM ? ((R & ~31) + perm32(R & 31)) : R;
        voffA[i] = (unsigned)(R * K + C) * 2u; voffB[i] = (unsigned)(Rb * K + C) * 2u; }
    const size_t kstep = (size_t)(BK * 2);
    const size_t hstep = (size_t)HALF * K * 2;
    const size_t tstep = 2 * hstep;
    const unsigned ldsw = (unsigned)wid * 1024u;
    const int aoff = lds_byte(wr * 64 + fr, fq * 8), boff = lds_byte(wc * 32 + fr, fq * 8);
#define PG8_SA(b, h) (((b) * 2 + (h)) * HTB)
#define PG8_SB(b, h) ((4 + (b) * 2 + (h)) * HTB)
#define PG8_STAGE(bufoff, gbase, voff) do { _Pragma("unroll") for (int _i = 0; _i < 2; ++_i) \
        __builtin_amdgcn_global_load_lds((const unsigned*)((const char*)(gbase) + (voff)[_i]), (PG8_LAS unsigned*)(lds + (bufoff) + ldsw + _i * 8192), 16, 0, 0); } while (0)
#define PG8_LDA(dst, b, h) do { _Pragma("unroll") for (int m = 0; m < 4; ++m) _Pragma("unroll") for (int k = 0; k < 2; ++k) dst[m][k] = *(const PG8_LAS bf16x8*)(lds + PG8_SA(b, h) + aoff + m * 2048 + k * 1024); } while (0)
#define PG8_LDB(dst, b, h) do { _Pragma("unroll") for (int n = 0; n < 2; ++n) _Pragma("unroll") for (int k = 0; k < 2; ++k) dst[n][k] = *(const PG8_LAS bf16x8*)(lds + PG8_SB(b, h) + boff + n * 2048 + k * 1024); } while (0)
#define PG8_MMA(ai, bj, At, Bt) do { __builtin_amdgcn_s_setprio(1); _Pragma("unroll") for (int m = 0; m < 4; ++m) _Pragma("unroll") for (int n = 0; n < 2; ++n) _Pragma("unroll") for (int k = 0; k < 2; ++k) \
        acc[ai][bj][m][n] = __builtin_amdgcn_mfma_f32_16x16x32_bf16(Bt[n][k], At[m][k], acc[ai][bj][m][n], 0, 0, 0); __builtin_amdgcn_s_setprio(0); } while (0)
#define PG8_WAIT_V(n) asm volatile("s_waitcnt vmcnt(" #n ")" ::: "memory")
#define PG8_WAIT_L(n) asm volatile("s_waitcnt lgkmcnt(" #n ")" ::: "memory")
#define PG8_BAR __builtin_amdgcn_s_barrier()
#define PG8_SCHED __builtin_amdgcn_sched_barrier(0)
    Unit cur, nxt; int ui = 0;
    if (!S.next(0, cur)) return;
    f32x4 acc[2][2][4][2];
#pragma unroll
    for (int a = 0; a < 2; ++a)
#pragma unroll
        for (int b = 0; b < 2; ++b)
#pragma unroll
            for (int m = 0; m < 4; ++m)
#pragma unroll
                for (int n = 0; n < 2; ++n) acc[a][b][m][n] = (f32x4){0.f, 0.f, 0.f, 0.f};
    bf16x8 At[4][2], B0[2][2], B1[2][2];
    const char* cA = (const char*)g.A + (size_t)cur.pm * tstep; const char* cB = (const char*)g.Bt + (size_t)cur.pn * tstep;
    S.a_ready(cur);
    if constexpr (SP2) {
        PG8_STAGE(PG8_SB(0, 0), cB, voffB); PG8_STAGE(PG8_SB(0, 1), cB + hstep, voffB); PG8_STAGE(PG8_SA(0, 0), cA, voffA); PG8_STAGE(PG8_SA(0, 1), cA + hstep, voffA);
        if (wr == 1) PG8_BAR;
        PG8_WAIT_V(2); PG8_BAR;
        PG8_STAGE(PG8_SB(1, 0), cB + kstep, voffB); PG8_STAGE(PG8_SA(1, 0), cA + kstep, voffA); PG8_STAGE(PG8_SB(1, 1), cB + hstep + kstep, voffB);
        PG8_WAIT_V(6); PG8_BAR;
    } else {
        PG8_STAGE(PG8_SB(0, 0), cB, voffB); PG8_STAGE(PG8_SA(0, 0), cA, voffA); PG8_STAGE(PG8_SB(0, 1), cB + hstep, voffB); PG8_STAGE(PG8_SA(0, 1), cA + hstep, voffA);
        if (wr == 1) PG8_BAR;
        PG8_WAIT_V(4); PG8_BAR;
        PG8_STAGE(PG8_SB(1, 0), cB + kstep, voffB); PG8_STAGE(PG8_SA(1, 0), cA + kstep, voffA); PG8_STAGE(PG8_SB(1, 1), cB + hstep + kstep, voffB);
        PG8_WAIT_V(6); PG8_BAR;
    }
    for (;;) {
        const bool has_next = S.next(ui + 1, nxt);
        const char* nA = has_next ? (const char*)g.A + (size_t)nxt.pm * tstep : cA; const char* nB = has_next ? (const char*)g.Bt + (size_t)nxt.pn * tstep : cB;
        for (int t = 0; t < nt; t += 2) {
            const bool last = (t == nt - 2);
            const char* a1 = cA + (size_t)(t + 1) * kstep;
            const char* a2 = last ? nA : cA + (size_t)(t + 2) * kstep; const char* b2 = last ? nB : cB + (size_t)(t + 2) * kstep;
            const char* a3 = a2 + kstep; const char* b3 = b2 + kstep;
            if (last && has_next) S.a_ready(nxt);
            if constexpr (SP2) {
            PG8_LDB(B0, 0, 0); PG8_LDB(B1, 0, 1); PG8_SCHED; PG8_LDA(At, 0, 0); PG8_STAGE(PG8_SA(1, 1), a1 + hstep, voffA);
            PG8_WAIT_V(8); PG8_WAIT_L(0); PG8_BAR; PG8_MMA(0, 0, At, B0); PG8_MMA(0, 1, At, B1); PG8_BAR; PG8_SCHED;
            PG8_LDA(At, 0, 1); PG8_STAGE(PG8_SB(0, 0), b2, voffB); PG8_STAGE(PG8_SB(0, 1), b2 + hstep, voffB); PG8_STAGE(PG8_SA(0, 0), a2, voffA);
            PG8_WAIT_V(8); PG8_WAIT_L(0); PG8_BAR; PG8_MMA(1, 0, At, B0); PG8_MMA(1, 1, At, B1); PG8_BAR; PG8_SCHED;
            PG8_LDB(B0, 1, 0); PG8_LDB(B1, 1, 1); PG8_SCHED; PG8_LDA(At, 1, 0); PG8_STAGE(PG8_SA(0, 1), a2 + hstep, voffA);
            PG8_WAIT_V(8); PG8_WAIT_L(0); PG8_BAR; PG8_MMA(0, 0, At, B0); PG8_MMA(0, 1, At, B1); PG8_BAR; PG8_SCHED;
            PG8_LDA(At, 1, 1); PG8_STAGE(PG8_SB(1, 0), b3, voffB); PG8_STAGE(PG8_SB(1, 1), b3 + hstep, voffB); PG8_STAGE(PG8_SA(1, 0), a3, voffA);
            PG8_WAIT_V(8); PG8_WAIT_L(0); PG8_BAR; PG8_MMA(1, 0, At, B0); PG8_MMA(1, 1, At, B1); PG8_BAR; PG8_SCHED;
            } else {
            PG8_LDB(B0, 0, 0); PG8_SCHED; PG8_LDA(At, 0, 0); PG8_STAGE(PG8_SA(1, 1), a1 + hstep, voffA);
            PG8_WAIT_L(8); PG8_BAR; PG8_WAIT_L(0); PG8_MMA(0, 0, At, B0); PG8_BAR; PG8_SCHED;
            PG8_LDB(B1, 0, 1); PG8_STAGE(PG8_SB(0, 0), b2, voffB);
            PG8_BAR; PG8_WAIT_L(0); PG8_MMA(0, 1, At, B1); PG8_BAR;
            PG8_LDA(At, 0, 1); PG8_STAGE(PG8_SA(0, 0), a2, voffA);
            PG8_BAR; PG8_WAIT_L(0); PG8_MMA(1, 0, At, B0); PG8_BAR; PG8_SCHED;
            PG8_STAGE(PG8_SB(0, 1), b2 + hstep, voffB);
            PG8_WAIT_V(6); PG8_BAR; PG8_MMA(1, 1, At, B1); PG8_BAR;
            PG8_LDB(B0, 1, 0); PG8_SCHED; PG8_LDA(At, 1, 0); PG8_STAGE(PG8_SA(0, 1), a2 + hstep, voffA);
            PG8_WAIT_L(8); PG8_BAR; PG8_WAIT_L(0); PG8_MMA(0, 0, At, B0); PG8_BAR; PG8_SCHED;
            PG8_LDB(B1, 1, 1); PG8_STAGE(PG8_SB(1, 0), b3, voffB);
            PG8_BAR; PG8_WAIT_L(0); PG8_MMA(0, 1, At, B1); PG8_BAR;
            PG8_LDA(At, 1, 1); PG8_STAGE(PG8_SA(1, 0), a3, voffA);
            PG8_BAR; PG8_WAIT_L(0); PG8_MMA(1, 0, At, B0); PG8_BAR; PG8_SCHED;
            PG8_STAGE(PG8_SB(1, 1), b3 + hstep, voffB);
            PG8_WAIT_V(6); PG8_BAR; PG8_MMA(1, 1, At, B1); PG8_BAR;
            }
        }
        if constexpr (ALIGN_EPI) { if (wr == 0) PG8_BAR; }
        if constexpr (!Epi::AFTER_DRAIN) { E(acc, cur, wr, wc, fr, fq); S.done(cur); }
        if (!has_next) break;
#pragma unroll
        for (int a = 0; a < 2; ++a)
#pragma unroll
            for (int b = 0; b < 2; ++b)
#pragma unroll
                for (int m = 0; m < 4; ++m)
#pragma unroll
                    for (int n = 0; n < 2; ++n) acc[a][b][m][n] = (f32x4){0.f, 0.f, 0.f, 0.f};
        cur = nxt; cA = nA; cB = nB; ++ui;
        if constexpr (ALIGN_EPI) { if (wr == 1) PG8_BAR; }
    }
    PG8_WAIT_V(0);
    if constexpr (!ALIGN_EPI) { if (wr == 0) PG8_BAR; }
    PG8_BAR;
    if constexpr (Epi::AFTER_DRAIN) { E.fused(acc, cur, wr, wc, fr, fq, lds, wid, lane); S.done(cur); }
#undef PG8_SA
#undef PG8_SB
#undef PG8_STAGE
#undef PG8_LDA
#undef PG8_LDB
#undef PG8_MMA
#undef PG8_WAIT_V
#undef PG8_WAIT_L
#undef PG8_BAR
#undef PG8_SCHED
}
}

namespace {
#define LAS __attribute__((address_space(3)))
typedef unsigned short bf16_t;
typedef unsigned v4u __attribute__((ext_vector_type(4)));
typedef float f32x4 __attribute__((ext_vector_type(4)));
#define LDS_WAIT() asm volatile("s_waitcnt lgkmcnt(0)" ::: "memory")

__device__ __forceinline__ unsigned f2bf(float f) { unsigned u = __float_as_uint(f); return (u + 0x7fffu + ((u >> 16) & 1u)) >> 16; }
__device__ __forceinline__ unsigned pk2(float lo, float hi) { return f2bf(lo) | (f2bf(hi) << 16); }
__device__ __forceinline__ float bf2f(bf16_t b) { return __uint_as_float(((unsigned)b) << 16); }
__device__ __forceinline__ float fexp(float x) { return __builtin_amdgcn_exp2f(x * 1.4426950408889634f); }
__device__ __forceinline__ float frcp(float x) { return __builtin_amdgcn_rcpf(x); }
__device__ __forceinline__ float frsq(float x) { return __builtin_amdgcn_rsqf(x); }
__device__ __forceinline__ float fsqrt_(float x) { return __builtin_amdgcn_sqrtf(x); }
__device__ __forceinline__ float flog(float x) { return __builtin_amdgcn_logf(x) * 0.6931471805599453f; }
__device__ __forceinline__ float sigmoidf_(float x) { return frcp(1.0f + fexp(-x)); }
__device__ __forceinline__ float siluf_(float x) { return x * frcp(1.0f + fexp(-x)); }
__device__ __forceinline__ float softplusf_(float x) { const float e = fexp(x); return x > 15.f ? x : (e < 1e-3f ? e * (1.0f - 0.5f * e) : flog(1.0f + e)); }
__device__ __forceinline__ int lane_id_v() { int l; asm volatile("v_mbcnt_lo_u32_b32 %0, -1, 0\n\tv_mbcnt_hi_u32_b32 %0, -1, %0" : "=v"(l)); return l; }
__device__ __forceinline__ float shx(float v, int mask) { return __builtin_bit_cast(float, __builtin_amdgcn_ds_bpermute((lane_id_v() ^ mask) << 2, __builtin_bit_cast(int, v))); }
__device__ __forceinline__ float shidx(float v, int src) { return __builtin_bit_cast(float, __builtin_amdgcn_ds_bpermute(src << 2, __builtin_bit_cast(int, v))); }
__device__ __forceinline__ float wave_sum(float v) {
#pragma unroll
    for (int o = 32; o >= 1; o >>= 1) v += shx(v, o);
    return v; }
__device__ __forceinline__ float wave_max(float v) {
#pragma unroll
    for (int o = 32; o >= 1; o >>= 1) v = fmaxf(v, shx(v, o));
    return v; }

constexpr size_t MiB = 1u << 20;
constexpr size_t WS_CTL = 0, CTL_ZERO_BYTES = 65536;
constexpr size_t WS_MOD = 1 * MiB;
constexpr size_t WS_WTIN = 2 * MiB;
constexpr size_t WS_WTOUT = 10 * MiB;
constexpr size_t WS_X = 12 * MiB;
constexpr size_t WS_UF = 80 * MiB;
constexpr size_t WS_P = 114 * MiB;
constexpr size_t WS_GDNX = 226 * MiB;
constexpr size_t WS_VT = 230 * MiB;
constexpr size_t WS_RGS = 247 * MiB;
constexpr size_t WS_END = 250 * MiB;
constexpr size_t WS_RGWT = 1 * MiB + 576 * 1024;
constexpr size_t WS_RGTAB = 1 * MiB + 768 * 1024;
constexpr size_t WS_ROPE = 1 * MiB + 512 * 1024;
constexpr int LDS_BAR_OFF = 155648;
constexpr int LDS_BYTES = 155648 + 256;
constexpr size_t WS_BAR = 16384;

struct Params { const void* ptr[22]; };

__device__ __forceinline__ void phase_mods(const float* c, const float* cctx, const float* w_mod, const float* b_mod, float* mod, LAS float* sc, int wid, int lane) {
    for (int item = blockIdx.x; item < DEPTH * 48; item += gridDim.x) {
        const int l = item / 48, n = (item % 48) * 64 + lane;
        float a0 = 0, a1 = 0, a2 = 0, a3 = 0, a4 = 0;
        const float* w = w_mod + (size_t)l * 1024 * 3072 + n;
        for (int k = wid * 128; k < wid * 128 + 128; ++k) {
            const float wv = w[(size_t)k * 3072];
            a0 += siluf_(c[k]) * wv; a1 += siluf_(c[1024 + k]) * wv; a2 += siluf_(c[2048 + k]) * wv; a3 += siluf_(c[3072 + k]) * wv; a4 += siluf_(cctx[k]) * wv;
        }
        sc[(wid * 5 + 0) * 64 + lane] = a0; sc[(wid * 5 + 1) * 64 + lane] = a1; sc[(wid * 5 + 2) * 64 + lane] = a2; sc[(wid * 5 + 3) * 64 + lane] = a3; sc[(wid * 5 + 4) * 64 + lane] = a4;
        __syncthreads();
        if (wid < 5) { float s = 0.f;
#pragma unroll
            for (int w8 = 0; w8 < 8; ++w8) s += sc[(w8 * 5 + wid) * 64 + lane];
            mod[(size_t)(l * 5 + wid) * 3072 + n] = s + b_mod[l * 3072 + n]; }
        __syncthreads();
    }
}
__device__ __forceinline__ void transpose_item(const float* W, int K, int N, int nblk, bf16_t* WT, LAS float* scr, int item, int lane) {
    const int kb = item / nblk, nb = item % nblk, k0 = 64 * kb, n0 = 32 * nb;
    const int nn = n0 + (lane & 31);
#pragma unroll 8
    for (int i = 0; i < 32; ++i) { const int kk = 2 * i + (lane >> 5); scr[kk * 33 + (lane & 31)] = nn < N ? W[(size_t)(k0 + kk) * N + nn] : 0.f; }
    LDS_WAIT();
    const int c = lane & 7;
#pragma unroll
    for (int j = 0; j < 4; ++j) { const int n = (lane >> 3) + 8 * j; const LAS float* s = scr + (8 * c) * 33 + n;
        v4u o; o.x = pk2(s[0 * 33], s[1 * 33]); o.y = pk2(s[2 * 33], s[3 * 33]); o.z = pk2(s[4 * 33], s[5 * 33]); o.w = pk2(s[6 * 33], s[7 * 33]);
        *(v4u*)(WT + (size_t)(n0 + n) * K + k0 + 8 * c) = o; }
    LDS_WAIT();
}
__device__ __forceinline__ void convert_weights(const float* w_in_l, const float* w_out_l, bf16_t* WTIN, bf16_t* WTOUT, LAS float* scr, int gw, int NGW, int lane) {
    constexpr int I_IN = 16 * 105, I_OUT = 16 * 32;
    for (int it = gw; it < I_IN + I_OUT; it += NGW) {
        if (it < I_IN) transpose_item(w_in_l, 1024, DIN, 105, WTIN, scr, it, lane);
        else transpose_item(w_out_l, 1024, 1024, 32, WTOUT, scr, it - I_IN, lane);
    }
}
__device__ __forceinline__ void convert_rg(const float* wa, const float* ba, const float* wx, const float* bx, const float* lam, bf16_t* RGWT, float* rgtab, int gtid, int ngt) {
    for (int idx = gtid; idx < 24 * 4096 + 768; idx += ngt) {
        if (idx < 24 * 4096) { const int dd = idx & 63, e = (idx >> 6) & 63, m = idx >> 12, kind = m & 1, dn = m >> 1;
            RGWT[idx] = (bf16_t)f2bf((kind ? wx : wa)[((size_t)dn * 64 + dd) * 64 + e]); }
        else { const int k = idx - 24 * 4096; rgtab[k] = ba[k]; rgtab[768 + k] = bx[k]; rgtab[1536 + k] = -8.0f * log1pf(expf(-lam[k])); }
    }
}
__device__ __forceinline__ void prep_rows0(const float* x, const float* ctx, const float* modl, bf16_t* U, int gw, int NGW, int lane) {
    for (int t = gw; t < T; t += NGW) {
        const int b = t / SEQT, sp = t - b * SEQT, j = sp < CTX ? 4 : b;
        const float* xs = sp < CTX ? ctx + ((size_t)b * CTX + sp) * D : x + ((size_t)b * SEQ + (sp - CTX)) * D;
        const float* sh = modl + j * 3072; const float* sc = sh + 1024;
#pragma unroll
        for (int q = 0; q < 4; ++q) { const int k = (q * 64 + lane) * 4; const f32x4 v = *(const f32x4*)(xs + k), s1 = *(const f32x4*)(sc + k), s0 = *(const f32x4*)(sh + k);
            const f32x4 u = v * (s1 + 1.0f) + s0; uint2 o; o.x = pk2(u[0], u[1]); o.y = pk2(u[2], u[3]); *(uint2*)(U + (size_t)t * D + k) = o; }
    }
}
__device__ __forceinline__ void ln_rows(const float* X, float* Xw, const float* g, const float* bta, float* final_out, const float* modn, bf16_t* U, int gw, int NGW, int lane) {
    for (int t = gw; t < T; t += NGW) {
        const int b = t / SEQT, sp = t - b * SEQT, j = sp < CTX ? 4 : b;
        if (final_out && sp < CTX) continue;
        const float* xr = X + (size_t)t * D; float* xw = Xw + (size_t)t * D;
        f32x4 v[4]; float s = 0.f;
#pragma unroll
        for (int q = 0; q < 4; ++q) { v[q] = *(const f32x4*)(xr + (q * 64 + lane) * 4); s += (v[q][0] + v[q][1]) + (v[q][2] + v[q][3]); }
        const float mean = wave_sum(s) * (1.0f / D); float s2 = 0.f;
#pragma unroll
        for (int q = 0; q < 4; ++q) { v[q] = v[q] - mean; s2 += (v[q][0] * v[q][0] + v[q][1] * v[q][1]) + (v[q][2] * v[q][2] + v[q][3] * v[q][3]); }
        const float rstd = frsq(wave_sum(s2) * (1.0f / D) + 1e-5f);
#pragma unroll
        for (int q = 0; q < 4; ++q) { const int k = (q * 64 + lane) * 4; const f32x4 y = v[q] * rstd * *(const f32x4*)(g + k) + *(const f32x4*)(bta + k);
            if (final_out) *(f32x4*)(final_out + ((size_t)b * SEQ + (sp - CTX)) * D + k) = y;
            else { *(f32x4*)(xw + k) = y; const f32x4 u = y * (*(const f32x4*)(modn + j * 3072 + 1024 + k) + 1.0f) + *(const f32x4*)(modn + j * 3072 + k);
                uint2 o; o.x = pk2(u[0], u[1]); o.y = pk2(u[2], u[3]); *(uint2*)(U + (size_t)t * D + k) = o; } }
    }
}

__device__ __forceinline__ float conv_at(const bf16_t* P, const float* cw, int t, int c) {
    const int sp = t % SEQT;
    const int lo = sp < CTX ? 0 : CTX, hi = sp < CTX ? CTX : SEQT;
    float acc = 0.f;
#pragma unroll
    for (int j = 0; j < 4; ++j) { const int s2 = sp + j - 2; if (s2 >= lo && s2 < hi) acc += cw[j * CONV_CH + c] * bf2f(P[(size_t)(t + j - 2) * LDP + c]); }
    return acc;
}
__device__ __forceinline__ int step_to_sp(int step, int d) { return d == 0 ? step : (step < CTX ? CTX - 1 - step : SEQT - 1 - (step - CTX)); }

__device__ __forceinline__ void combine_rows(const bf16_t* P, const float* nw, bf16_t* F, int gw, int NGW, int lane) {
    for (int t = gw; t < T; t += NGW) {
#pragma unroll
        for (int hh = 0; hh < 4; ++hh) { const int c = hh * 64 + lane;
            const float o = bf2f(P[(size_t)t * LDP + C_QG + c]) + bf2f(P[(size_t)t * LDP + C_KG + c]);
            const float ms = wave_sum(o * o) * (1.0f / 64.0f);
            F[(size_t)t * 1024 + 768 + c] = (bf16_t)f2bf(o * frsq(ms + 1e-6f) * nw[lane] * siluf_(bf2f(P[(size_t)t * LDP + C_ZG + c]))); }
    }
}


constexpr int LS = 72;
constexpr int G_KN = 0, G_KNT = 9216, G_QN = 18432, G_QK = 27648, G_XT = 36864, G_LB = 55296, G_TI = 64512, G_SM = 72704, G_CW = 73728, G_HALF = 77824;
#ifndef GP_S1
#define GP_S1 1
#endif
#ifndef GP_S1B
#define GP_S1B 1
#endif
#ifndef GP_S2
#define GP_S2 1
#endif
#ifndef GP_S4
#define GP_S4 1
#endif
#ifdef TPROBE
#define TP_BEGIN(k_) unsigned long long tp_t##k_ = 0; if (tidf == 0 && bidx == 0) tp_t##k_ = __builtin_amdgcn_s_memtime()
#define TP_END(k_, slot_) do { if (tidf == 0 && bidx == 0) { asm volatile("s_waitcnt lgkmcnt(0)" ::: "memory"); *(LAS unsigned long long*)(lds + 155648 + 64 + 8 * (slot_)) += __builtin_amdgcn_s_memtime() - tp_t##k_; } } while (0)
#else
#define TP_BEGIN(k_) do {} while (0)
#define TP_END(k_, slot_) do {} while (0)
#endif
__device__ __forceinline__ int opq3(int i) { asm volatile("" : "+s"(i)); return i; }
constexpr int GDN_ITEMS = NB * 4 * 2 * 68;
constexpr size_t GDN_ITEM_BYTES = 32768;
typedef short bf16x8_t __attribute__((ext_vector_type(8)));
typedef unsigned v2u __attribute__((ext_vector_type(2)));
typedef float f32x4_t __attribute__((ext_vector_type(4)));

typedef __bf16 bf16v2_t __attribute__((ext_vector_type(2)));
typedef float f32v2_t __attribute__((ext_vector_type(2)));
__device__ __forceinline__ unsigned cvtpk(float lo, float hi) { const f32v2_t v = {lo, hi}; return __builtin_bit_cast(unsigned, __builtin_convertvector(v, bf16v2_t)); }
__device__ __forceinline__ float fsilu(float x) { return x * frcp(1.0f + fexp(-x)); }
__device__ __forceinline__ bf16x8_t lds_frag(const LAS unsigned char* base, int row, int col) { return *(const LAS bf16x8_t*)(base + (row * LS + col) * 2); }
__device__ __forceinline__ unsigned char* gdn_item_ptr(unsigned char* dout, unsigned char* wsx, int it) { return it < 2048 ? dout + (size_t)it * GDN_ITEM_BYTES : wsx + (size_t)(it - 2048) * GDN_ITEM_BYTES; }
__device__ __forceinline__ int gdn_sp(int c, int i, int d) {
    if (c < 4) { const int s = c * 64 + i; return d == 0 ? s : CTX - 1 - s; }
    const int s = (c - 4) * 64 + i; return d == 0 ? CTX + s : SEQT - 1 - s;
}

__device__ __forceinline__ void gdn_pass1(const bf16_t* P, const float* cw, const float* alog, const float* dtb, const float* rcos, const float* rsin,
                                          unsigned char* dout, unsigned char* wsx, LAS unsigned char* lds, int wid8  , int bidx, int nblk) {
    const int n_iter = (544 + 127) / 128;
    {   const int tv0 = wid8 * 64 + lane_id_v();
        const int half0 = tv0 >> 8, t0 = tv0 & 255, hq = (bidx * 2 + half0) & 3;
        LAS float* cwl = (LAS float*)(lds + half0 * G_HALF + G_CW);
        for (int e = t0; e < 768; e += 256) { const int m3 = e >> 8, j = (e >> 6) & 3, ch = e & 63; cwl[e] = cw[j * CONV_CH + (m3 == 0 ? C_QG : (m3 == 1 ? C_KG : C_VG)) + hq * 64 + ch]; }
    }
#define GDN_BAR() do { asm volatile("s_waitcnt lgkmcnt(0)" ::: "memory"); __builtin_amdgcn_s_barrier(); asm volatile("" ::: "memory"); } while (0)
    GDN_BAR();
#pragma unroll 1
    for (int iter = 0; iter < n_iter; ++iter) {
        const int tidf = wid8 * 64 + lane_id_v();
        const int half = __builtin_amdgcn_readfirstlane(tidf >> 8), t256 = tidf & 255, w = __builtin_amdgcn_readfirstlane(t256 >> 6), lane = tidf & 63, g = lane >> 4, l15 = lane & 15;
        LAS unsigned char* hb = lds + half * G_HALF;
        LAS float* sm = (LAS float*)(hb + G_SM);
        const int hq2 = bidx * 2 + half, hh = hq2 & 3, kidx = iter * 128 + (hq2 >> 2);
        const bool valid = kidx < 544;
        const int c = kidx % 68, bd = kidx / 68, d = bd & 1, b = bd >> 1;
        const int it = ((b * 4 + hh) * 2 + d) * 68 + c;
        const int i = t256 >> 2, qd = t256 & 3;
        float qv[16], kv[16], vv[16];
        TP_BEGIN(0); TP_BEGIN(1);
        _Pragma("unroll 1") for (int rq = 0, nq = opq3(GP_S1); rq < nq; ++rq)
        if (valid) {
            const int sp = gdn_sp(c, i, d), t = b * SEQT + sp;
            const int lo = sp < CTX ? 0 : CTX, hi = sp < CTX ? CTX : SEQT;
            v4u raw[4][3][2];
#pragma unroll
            for (int j = 0; j < 4; ++j) { const int s2 = sp + j - 2; const bool ok = s2 >= lo && s2 < hi;
                const bf16_t* pr = P + (size_t)(b * SEQT + (ok ? s2 : sp)) * LDP + hh * 64 + 16 * qd;
#pragma unroll
                for (int m3 = 0; m3 < 3; ++m3) { const int cb = m3 == 0 ? C_QG : (m3 == 1 ? C_KG : C_VG);
                    raw[j][m3][0] = ok ? *(const v4u*)(pr + cb) : (v4u){0u, 0u, 0u, 0u}; raw[j][m3][1] = ok ? *(const v4u*)(pr + cb + 8) : (v4u){0u, 0u, 0u, 0u}; } }
            if (t256 < 64) {
                const int t2 = b * SEQT + gdn_sp(c, lane, d);
                const float beta = sigmoidf_(bf2f(P[(size_t)t2 * LDP + C_BR + d * 4 + hh]));
                const float gg = -fexp(alog[d * 4 + hh]) * softplusf_(bf2f(P[(size_t)t2 * LDP + C_AR + d * 4 + hh]) + dtb[d * 4 + hh]);
                float G = gg;
#pragma unroll
                for (int o = 1; o < 64; o <<= 1) { const float v = shidx(G, lane >= o ? lane - o : lane); if (lane >= o) G += v; }
                const float gl = shidx(G, 63);
                sm[lane] = beta; sm[64 + lane] = G; sm[128 + lane] = fexp(G); sm[192 + lane] = fexp(gl - G);
            }
            const LAS float* cwl = (const LAS float*)(hb + G_CW);
            asm volatile("s_waitcnt vmcnt(0)" ::: "memory");
#pragma unroll
            for (int e = 0; e < 16; ++e) { qv[e] = 0.f; kv[e] = 0.f; vv[e] = 0.f; }
#pragma unroll
            for (int j = 0; j < 4; ++j) {
#pragma unroll
                for (int m3 = 0; m3 < 3; ++m3) {
                    const LAS float* wl = cwl + (m3 * 4 + j) * 64 + 16 * qd;
                    const f32x4_t w0 = *(const LAS f32x4_t*)wl, w1 = *(const LAS f32x4_t*)(wl + 4), w2 = *(const LAS f32x4_t*)(wl + 8), w3 = *(const LAS f32x4_t*)(wl + 12);
                    const float wv[16] = {w0[0], w0[1], w0[2], w0[3], w1[0], w1[1], w1[2], w1[3], w2[0], w2[1], w2[2], w2[3], w3[0], w3[1], w3[2], w3[3]};
                    const unsigned aw[8] = {raw[j][m3][0].x, raw[j][m3][0].y, raw[j][m3][0].z, raw[j][m3][0].w, raw[j][m3][1].x, raw[j][m3][1].y, raw[j][m3][1].z, raw[j][m3][1].w};
#pragma unroll
                    for (int e2 = 0; e2 < 8; ++e2) {
                        const float x0 = __uint_as_float(aw[e2] << 16), x1 = __uint_as_float(aw[e2] & 0xffff0000u);
                        if (m3 == 0) { qv[2 * e2] += wv[2 * e2] * x0; qv[2 * e2 + 1] += wv[2 * e2 + 1] * x1; }
                        else if (m3 == 1) { kv[2 * e2] += wv[2 * e2] * x0; kv[2 * e2 + 1] += wv[2 * e2 + 1] * x1; }
                        else { vv[2 * e2] += wv[2 * e2] * x0; vv[2 * e2 + 1] += wv[2 * e2 + 1] * x1; }
                    }
#define PIN16(a_) asm volatile("" : "+v"(a_[0]), "+v"(a_[1]), "+v"(a_[2]), "+v"(a_[3]), "+v"(a_[4]), "+v"(a_[5]), "+v"(a_[6]), "+v"(a_[7]), "+v"(a_[8]), "+v"(a_[9]), "+v"(a_[10]), "+v"(a_[11]), "+v"(a_[12]), "+v"(a_[13]), "+v"(a_[14]), "+v"(a_[15]) :: "memory")
                    if (m3 == 0) PIN16(qv); else if (m3 == 1) PIN16(kv); else PIN16(vv);
#undef PIN16
                }
            }
            float sq = 0.f, sk = 0.f;
#pragma unroll
            for (int e = 0; e < 16; ++e) { qv[e] = fsilu(qv[e]); kv[e] = fsilu(kv[e]); vv[e] = fsilu(vv[e]); sq += qv[e] * qv[e]; sk += kv[e] * kv[e]; }
            sq += shx(sq, 1); sq += shx(sq, 2); sk += shx(sk, 1); sk += shx(sk, 2);
            const float rq = frsq(sq + 1e-6f), rk = frsq(sk + 1e-6f);
            const bool lat = sp >= CTX;
            const int s = sp - CTX, pos = qd < 2 ? (s >> 6) : (s & 63);
#pragma unroll
            for (int e = 0; e < 16; ++e) {
                float q1 = qv[e] * rq, k1 = kv[e] * rk;
                const float qp = shx(q1, 1), kp = shx(k1, 1);
                if (lat) { const float cs = rcos[pos * 16 + e], sn = rsin[pos * 16 + e];
                    if (qd & 1) { q1 = q1 * cs + qp * sn; k1 = k1 * cs + kp * sn; } else { q1 = q1 * cs - qp * sn; k1 = k1 * cs - kp * sn; } }
                qv[e] = q1 * 0.125f; kv[e] = k1;
            }
        }
        GDN_BAR(); TP_END(1, 1); TP_BEGIN(2);
        _Pragma("unroll 1") for (int rq = 0, nq = opq3(GP_S1B); rq < nq; ++rq)
        if (valid) {
            const float beta = sm[i], eG = sm[128 + i], eGl = sm[192 + i];
            v4u o0, o1;
            o0.x = cvtpk(kv[0], kv[1]); o0.y = cvtpk(kv[2], kv[3]); o0.z = cvtpk(kv[4], kv[5]); o0.w = cvtpk(kv[6], kv[7]);
            o1.x = cvtpk(kv[8], kv[9]); o1.y = cvtpk(kv[10], kv[11]); o1.z = cvtpk(kv[12], kv[13]); o1.w = cvtpk(kv[14], kv[15]);
            *(LAS v4u*)(hb + G_KN + (i * LS + 16 * qd) * 2) = o0; *(LAS v4u*)(hb + G_KN + (i * LS + 16 * qd + 8) * 2) = o1;
            o0.x = cvtpk(qv[0], qv[1]); o0.y = cvtpk(qv[2], qv[3]); o0.z = cvtpk(qv[4], qv[5]); o0.w = cvtpk(qv[6], qv[7]);
            o1.x = cvtpk(qv[8], qv[9]); o1.y = cvtpk(qv[10], qv[11]); o1.z = cvtpk(qv[12], qv[13]); o1.w = cvtpk(qv[14], qv[15]);
            *(LAS v4u*)(hb + G_QN + (i * LS + 16 * qd) * 2) = o0; *(LAS v4u*)(hb + G_QN + (i * LS + 16 * qd + 8) * 2) = o1;
            const float bw = beta * eG;
#pragma unroll
            for (int e = 0; e < 16; ++e) {
                const int f = 16 * qd + e;
                const unsigned p0 = cvtpk(kv[e] * eGl, beta * vv[e]), p1 = cvtpk(bw * kv[e], 0.f);
                *(LAS bf16_t*)(hb + G_KNT + (f * LS + i) * 2) = (bf16_t)(p0 & 0xffffu);
                *(LAS bf16_t*)(hb + G_XT + (f * LS + i) * 2) = (bf16_t)(p0 >> 16);
                *(LAS bf16_t*)(hb + G_XT + ((64 + f) * LS + i) * 2) = (bf16_t)(p1 & 0xffffu);
            }
        }
        GDN_BAR(); TP_END(2, 2); TP_BEGIN(3);
        _Pragma("unroll 1") for (int rq = 0, nq = opq3(GP_S2); rq < nq; ++rq)
        if (valid) {
            const bf16x8_t ak0 = lds_frag(hb + G_KN, 16 * w + l15, 8 * g), ak1 = lds_frag(hb + G_KN, 16 * w + l15, 32 + 8 * g);
            const bf16x8_t aq0 = lds_frag(hb + G_QN, 16 * w + l15, 8 * g), aq1 = lds_frag(hb + G_QN, 16 * w + l15, 32 + 8 * g);
            const f32x4_t Gi = *(const LAS f32x4_t*)(sm + 64 + 16 * w + 4 * g), Bi = *(const LAS f32x4_t*)(sm + 16 * w + 4 * g);
#pragma unroll
            for (int nt = 0; nt < 4; ++nt) {
                const bf16x8_t b0 = lds_frag(hb + G_KN, 16 * nt + l15, 8 * g), b1 = lds_frag(hb + G_KN, 16 * nt + l15, 32 + 8 * g);
                f32x4_t kk = {0.f, 0.f, 0.f, 0.f}, qk = {0.f, 0.f, 0.f, 0.f};
                kk = __builtin_amdgcn_mfma_f32_16x16x32_bf16(ak0, b0, kk, 0, 0, 0); kk = __builtin_amdgcn_mfma_f32_16x16x32_bf16(ak1, b1, kk, 0, 0, 0);
                qk = __builtin_amdgcn_mfma_f32_16x16x32_bf16(aq0, b0, qk, 0, 0, 0); qk = __builtin_amdgcn_mfma_f32_16x16x32_bf16(aq1, b1, qk, 0, 0, 0);
                const int jj = 16 * nt + l15; const float Gj = sm[64 + jj];
#pragma unroll
                for (int r = 0; r < 4; ++r) {
                    const int ii = 16 * w + 4 * g + r;
                    const float e = fexp(fminf(Gi[r] - Gj, 0.f));
                    const unsigned pk = cvtpk(jj < ii ? -(Bi[r] * kk[r] * e) : 0.f, jj <= ii ? qk[r] * e : 0.f);
                    *(LAS bf16_t*)(hb + G_LB + (ii * LS + jj) * 2) = (bf16_t)(pk & 0xffffu);
                    *(LAS bf16_t*)(hb + G_QK + (ii * LS + jj) * 2) = (bf16_t)(pk >> 16);
                }
            }
        }
        GDN_BAR(); TP_END(3, 3); TP_BEGIN(4);
        if (valid) {
            LAS unsigned char* ti = hb + G_TI + w * 2048;
            {   float tv[16];
#pragma unroll
                for (int i2 = 0; i2 < 16; ++i2) {
                    float acc = (i2 == l15) ? 1.0f : 0.0f;
                    if (i2 > 0) { const LAS unsigned char* lr = hb + G_LB + ((16 * g + i2) * LS + 16 * g) * 2;
                        const v4u r0 = *(const LAS v4u*)lr, r1 = *(const LAS v4u*)(lr + 16); const unsigned rw[8] = {r0.x, r0.y, r0.z, r0.w, r1.x, r1.y, r1.z, r1.w};
#pragma unroll
                        for (int j2 = 0; j2 < i2; ++j2) acc += ((j2 & 1) ? __uint_as_float(rw[j2 >> 1] & 0xffff0000u) : __uint_as_float(rw[j2 >> 1] << 16)) * tv[j2]; }
                    tv[i2] = acc;
                }
#pragma unroll
                for (int i2 = 0; i2 < 16; i2 += 2) { const unsigned pk = cvtpk(tv[i2], tv[i2 + 1]);
                    *(LAS bf16_t*)(ti + ((g * 16 + i2) * 16 + l15) * 2) = (bf16_t)(pk & 0xffffu); *(LAS bf16_t*)(ti + ((g * 16 + i2 + 1) * 16 + l15) * 2) = (bf16_t)(pk >> 16); }
            }
            LDS_WAIT();
#pragma unroll
            for (int I = 0; I < 4; ++I) {
                const v2u traw = *(const LAS v2u*)(ti + ((I * 16 + l15) * 16 + 4 * g) * 2);
                const v4u tpk = {traw.x, traw.y, 0u, 0u}; const bf16x8_t a_ti = __builtin_bit_cast(bf16x8_t, tpk);
#pragma unroll
                for (int cti = 0; cti < 2; ++cti) {
                    const int cr = 32 * w + 16 * cti + l15;
                    LAS unsigned char* xp = hb + G_XT + (cr * LS + 16 * I + 4 * g) * 2;
                    const v2u rr = *(const LAS v2u*)xp;
                    f32x4_t acc = {__uint_as_float(rr.x << 16), __uint_as_float(rr.x & 0xffff0000u), __uint_as_float(rr.y << 16), __uint_as_float(rr.y & 0xffff0000u)};
#pragma unroll
                    for (int s2 = 0; s2 < (16 * I + 31) / 32; ++s2) {
                        bf16x8_t al = lds_frag(hb + G_LB, 16 * I + l15, 32 * s2 + 8 * g);
                        if (32 * s2 + 8 * g >= 16 * I) al = (bf16x8_t){0, 0, 0, 0, 0, 0, 0, 0};
                        acc = __builtin_amdgcn_mfma_f32_16x16x32_bf16(al, lds_frag(hb + G_XT, cr, 32 * s2 + 8 * g), acc, 0, 0, 0);
                    }
                    const v4u rpk = {cvtpk(acc[0], acc[1]), cvtpk(acc[2], acc[3]), 0u, 0u};
                    f32x4_t xa = {0.f, 0.f, 0.f, 0.f};
                    xa = __builtin_amdgcn_mfma_f32_16x16x32_bf16(a_ti, __builtin_bit_cast(bf16x8_t, rpk), xa, 0, 0, 0);
                    v2u o; o.x = cvtpk(xa[0], xa[1]); o.y = cvtpk(xa[2], xa[3]); *(LAS v2u*)xp = o;
                }
                LDS_WAIT();
            }
        }
        GDN_BAR(); TP_END(4, 4); TP_BEGIN(5);
        _Pragma("unroll 1") for (int rq = 0, nq = opq3(GP_S4); rq < nq; ++rq)
        if (valid) {
            unsigned char* blk = gdn_item_ptr(dout, wsx, it);
            bf16_t* gM = (bf16_t*)blk; bf16_t* gP = gM + 4096; bf16_t* gN = gM + 8192; bf16_t* gQ = gM + 12288;
            const bf16x8_t akd0 = lds_frag(hb + G_KNT, 16 * w + l15, 8 * g), akd1 = lds_frag(hb + G_KNT, 16 * w + l15, 32 + 8 * g);
            const bf16x8_t aqk0 = lds_frag(hb + G_QK, 16 * w + l15, 8 * g), aqk1 = lds_frag(hb + G_QK, 16 * w + l15, 32 + 8 * g);
            const bf16x8_t aw0 = lds_frag(hb + G_XT, 64 + 16 * w + l15, 8 * g), aw1 = lds_frag(hb + G_XT, 64 + 16 * w + l15, 32 + 8 * g);
            const float egl = sm[128 + 63];
            const int pcol = 16 * w + 4 * g;
#pragma unroll
            for (int nt = 0; nt < 4; ++nt) {
                const bf16x8_t bu0 = lds_frag(hb + G_XT, 16 * nt + l15, 8 * g), bu1 = lds_frag(hb + G_XT, 16 * nt + l15, 32 + 8 * g);
                f32x4_t nn = {0.f, 0.f, 0.f, 0.f}, qm = {0.f, 0.f, 0.f, 0.f};
                nn = __builtin_amdgcn_mfma_f32_16x16x32_bf16(akd0, bu0, nn, 0, 0, 0); nn = __builtin_amdgcn_mfma_f32_16x16x32_bf16(akd1, bu1, nn, 0, 0, 0);
                qm = __builtin_amdgcn_mfma_f32_16x16x32_bf16(aqk0, bu0, qm, 0, 0, 0); qm = __builtin_amdgcn_mfma_f32_16x16x32_bf16(aqk1, bu1, qm, 0, 0, 0);
                const int cc = 16 * nt + l15;
                v2u o; o.x = cvtpk(nn[0], nn[1]); o.y = cvtpk(nn[2], nn[3]); *(v2u*)(gN + cc * 64 + 16 * w + 4 * g) = o;
                o.x = cvtpk(qm[0], qm[1]); o.y = cvtpk(qm[2], qm[3]); *(v2u*)(gQ + cc * 64 + 16 * w + 4 * g) = o;
                const bf16x8_t bk0 = lds_frag(hb + G_KNT, 16 * nt + l15, 8 * g), bk1 = lds_frag(hb + G_KNT, 16 * nt + l15, 32 + 8 * g);
                const bf16x8_t bq0 = lds_frag(hb + G_QK, 16 * nt + l15, 8 * g), bq1 = lds_frag(hb + G_QK, 16 * nt + l15, 32 + 8 * g);
                f32x4_t mm = {0.f, 0.f, 0.f, 0.f}, pm = {0.f, 0.f, 0.f, 0.f};
                mm = __builtin_amdgcn_mfma_f32_16x16x32_bf16(aw0, bk0, mm, 0, 0, 0); mm = __builtin_amdgcn_mfma_f32_16x16x32_bf16(aw1, bk1, mm, 0, 0, 0);
                pm = __builtin_amdgcn_mfma_f32_16x16x32_bf16(aw0, bq0, pm, 0, 0, 0); pm = __builtin_amdgcn_mfma_f32_16x16x32_bf16(aw1, bq1, pm, 0, 0, 0);
                const int frow = 16 * nt + l15;
                float mv[4], pv[4];
                const v2u qraw = *(const LAS v2u*)(hb + G_QN + (frow * LS + 16 * w + 4 * g) * 2);
                const float qf[4] = {__uint_as_float(qraw.x << 16), __uint_as_float(qraw.x & 0xffff0000u), __uint_as_float(qraw.y << 16), __uint_as_float(qraw.y & 0xffff0000u)};
                const float eGi = sm[128 + frow];
#pragma unroll
                for (int r = 0; r < 4; ++r) { mv[r] = ((16 * w + 4 * g + r) == frow ? egl : 0.f) - mm[r]; pv[r] = qf[r] * eGi - pm[r]; }
                o.x = cvtpk(mv[0], mv[1]); o.y = cvtpk(mv[2], mv[3]); *(v2u*)(gM + frow * 64 + pcol) = o;
                o.x = cvtpk(pv[0], pv[1]); o.y = cvtpk(pv[2], pv[3]); *(v2u*)(gP + frow * 64 + pcol) = o;
            }
        }
        GDN_BAR(); TP_END(5, 5); TP_END(0, 0);
    }
#undef GDN_BAR
}

__device__ __forceinline__ void gdn_chain(unsigned char* dout, unsigned char* wsx, bf16_t* Pw, int bhd, LAS unsigned char* sbuf, int wid, int lane) {
    const int d = bhd & 1, hh = (bhd >> 1) & 3, b = bhd >> 3, g = lane >> 4, l15 = lane & 15, w = wid & 3;
    const bool helper = wid >= 4;
    LAS unsigned char* obuf = sbuf + 18432;
    bf16_t* Og = Pw + (d == 0 ? C_QG : C_KG) + hh * 64;
    bf16x8_t aM[4][2], aP[4][2]; v2u nN[4][4], nQ[4][4];
#define GDN_LOAD(st_, c_) do { const bf16_t* blk_ = (const bf16_t*)gdn_item_ptr(dout, wsx, bhd * 68 + (c_)); \
        _Pragma("unroll") for (int s = 0; s < 2; ++s) { aM[st_][s] = *(const bf16x8_t*)(blk_ + (16 * w + l15) * 64 + 32 * s + 8 * g); aP[st_][s] = *(const bf16x8_t*)(blk_ + 4096 + (16 * w + l15) * 64 + 32 * s + 8 * g); } \
        _Pragma("unroll") for (int nt = 0; nt < 4; ++nt) { nN[st_][nt] = *(const v2u*)(blk_ + 8192 + (16 * nt + l15) * 64 + 16 * w + 4 * g); nQ[st_][nt] = *(const v2u*)(blk_ + 12288 + (16 * nt + l15) * 64 + 16 * w + 4 * g); } } while (0)
#define GDN_HSTORE(c_) do { _Pragma("unroll") for (int k2 = 0; k2 < 2; ++k2) { const int pc = w * 64 + lane + 256 * k2, row = pc >> 3, seg = pc & 7; \
        const v4u ov = *(const LAS v4u*)(obuf + ((c_) & 1) * 9216 + (row * LS + 8 * seg) * 2); \
        *(v4u*)(Og + (size_t)(b * SEQT + gdn_sp((c_), row, d)) * LDP + 8 * seg) = ov; } } while (0)
#define GDN_BAR() do { asm volatile("s_waitcnt lgkmcnt(0)" ::: "memory"); __builtin_amdgcn_s_barrier(); asm volatile("" ::: "memory"); } while (0)
    if (helper) {
        GDN_BAR();
#pragma unroll 1
        for (int c = 0; c < 68; ++c) { if (c > 0) GDN_HSTORE(c - 1); GDN_BAR(); }
        GDN_HSTORE(67);
    } else {
#pragma unroll
        for (int nt = 0; nt < 4; ++nt) *(LAS v2u*)(sbuf + ((16 * nt + l15) * LS + 16 * w + 4 * g) * 2) = (v2u){0u, 0u};
        GDN_LOAD(0, 0); GDN_LOAD(1, 1); GDN_LOAD(2, 2); GDN_LOAD(3, 3);
        GDN_BAR();
#pragma unroll 1
        for (int c4 = 0; c4 < 17; ++c4) {
#pragma unroll
            for (int u = 0; u < 4; ++u) {
                const int c = 4 * c4 + u;
                const LAS unsigned char* rb = sbuf + (c & 1) * 9216; LAS unsigned char* wb = sbuf + ((c + 1) & 1) * 9216; LAS unsigned char* ob = obuf + (c & 1) * 9216;
                f32x4_t Sn[4], Oc[4];
#pragma unroll
                for (int nt = 0; nt < 4; ++nt) {
                    const bf16x8_t b0 = lds_frag(rb, 16 * nt + l15, 8 * g), b1 = lds_frag(rb, 16 * nt + l15, 32 + 8 * g);
                    Sn[nt] = (f32x4_t){__uint_as_float(nN[u][nt].x << 16), __uint_as_float(nN[u][nt].x & 0xffff0000u), __uint_as_float(nN[u][nt].y << 16), __uint_as_float(nN[u][nt].y & 0xffff0000u)};
                    Oc[nt] = (f32x4_t){__uint_as_float(nQ[u][nt].x << 16), __uint_as_float(nQ[u][nt].x & 0xffff0000u), __uint_as_float(nQ[u][nt].y << 16), __uint_as_float(nQ[u][nt].y & 0xffff0000u)};
                    Sn[nt] = __builtin_amdgcn_mfma_f32_16x16x32_bf16(aM[u][0], b0, Sn[nt], 0, 0, 0); Sn[nt] = __builtin_amdgcn_mfma_f32_16x16x32_bf16(aM[u][1], b1, Sn[nt], 0, 0, 0);
                    Oc[nt] = __builtin_amdgcn_mfma_f32_16x16x32_bf16(aP[u][0], b0, Oc[nt], 0, 0, 0); Oc[nt] = __builtin_amdgcn_mfma_f32_16x16x32_bf16(aP[u][1], b1, Oc[nt], 0, 0, 0);
                }
#pragma unroll
                for (int nt = 0; nt < 4; ++nt) { v2u o; o.x = cvtpk(Sn[nt][0], Sn[nt][1]); o.y = cvtpk(Sn[nt][2], Sn[nt][3]); *(LAS v2u*)(wb + ((16 * nt + l15) * LS + 16 * w + 4 * g) * 2) = o; }
                if (c + 4 < 68) GDN_LOAD(u, c + 4);
#pragma unroll
                for (int nt = 0; nt < 4; ++nt) { const unsigned p01 = cvtpk(Oc[nt][0], Oc[nt][1]), p23 = cvtpk(Oc[nt][2], Oc[nt][3]);
                    LAS unsigned char* op = ob + ((16 * w + 4 * g) * LS + 16 * nt + l15) * 2;
                    *(LAS bf16_t*)op = (bf16_t)(p01 & 0xffffu); *(LAS bf16_t*)(op + LS * 2) = (bf16_t)(p01 >> 16); *(LAS bf16_t*)(op + 2 * LS * 2) = (bf16_t)(p23 & 0xffffu); *(LAS bf16_t*)(op + 3 * LS * 2) = (bf16_t)(p23 >> 16); }
                GDN_BAR();
            }
        }
    }
#undef GDN_BAR
#undef GDN_LOAD
#undef GDN_HSTORE
}

constexpr int R_U = 0, R_A0 = 9216, R_B0 = R_A0 + 16384, R_A1 = R_B0 + 16384, R_B1 = R_A1 + 16384, R_HALF = 77824;
#ifndef RGP_GATES
#define RGP_GATES 1
#endif
#ifndef RGP_SCAN
#define RGP_SCAN 1
#endif
#ifndef RGP_CONV
#define RGP_CONV 1
#endif
constexpr int RG_ITEMS = NB * 68 * 6;
#define RG_BAR() do { asm volatile("s_waitcnt lgkmcnt(0)" ::: "memory"); __builtin_amdgcn_s_barrier(); asm volatile("" ::: "memory"); } while (0)

__device__ __forceinline__ int opq2(int i) { asm volatile("" : "+s"(i)); return i; }
template <int MODE>
__device__ __forceinline__ void rg_pass(const bf16_t* P, const float* cw, const bf16_t* RGWT, const float* rgtab  ,
                                        float* SUMA, float* SUMH, const float* HIN, bf16_t* F, LAS unsigned char* lds, int wid8  , int bidx, int nblk) {
    const int n_iter = (RG_ITEMS + 2 * nblk - 1) / (2 * nblk);
    v4u pre[4][2];
#define RG_PREFETCH(it_, tv_) do { const int n_ = (it_) % 6, tc_ = ((it_) / 6) % 68, b_ = (it_) / 408; const int i_ = ((tv_) & 255) >> 2, qd_ = (tv_) & 3, sp_ = tc_ * 64 + i_; \
        const int lo_ = sp_ < CTX ? 0 : CTX, hi_ = sp_ < CTX ? CTX : SEQT; \
        _Pragma("unroll") for (int j = 0; j < 4; ++j) { const int s2_ = sp_ + j - 2; const bool ok_ = (it_) < RG_ITEMS && s2_ >= lo_ && s2_ < hi_; \
            const bf16_t* pr_ = P + (size_t)(b_ * SEQT + (ok_ ? s2_ : sp_)) * LDP + C_XA + n_ * 64 + 16 * qd_; \
            pre[j][0] = ok_ ? *(const v4u*)pr_ : (v4u){0u, 0u, 0u, 0u}; pre[j][1] = ok_ ? *(const v4u*)(pr_ + 8) : (v4u){0u, 0u, 0u, 0u}; } } while (0)
    { const int tv0 = wid8 * 64 + lane_id_v(); RG_PREFETCH((0 * nblk + bidx) * 2 + (tv0 >> 8), tv0); }
#pragma unroll 1
    for (int iter = 0; iter < n_iter; ++iter) {
        const int tidf = wid8 * 64 + lane_id_v();
        const int half = __builtin_amdgcn_readfirstlane(tidf >> 8), t256 = tidf & 255, w = __builtin_amdgcn_readfirstlane(t256 >> 6), lane = tidf & 63, g = lane >> 4, l15 = lane & 15;
        LAS unsigned char* hb = lds + half * R_HALF;
        const int it = (iter * nblk + bidx) * 2 + half;
        const bool valid = it < RG_ITEMS;
        const int n = it % 6, tc = (it / 6) % 68, b = it / 408;
        const int i = t256 >> 2, qd = t256 & 3;
        const int t = b * SEQT + tc * 64 + i;
        TP_BEGIN(8); TP_BEGIN(9);
        _Pragma("unroll 1") for (int rq = 0, nq = opq2(RGP_CONV); rq < nq; ++rq)
        {
            float u[16];
#pragma unroll
            for (int e = 0; e < 16; ++e) u[e] = 0.f;
#pragma unroll
            for (int j = 0; j < 4; ++j) { const float* wr_ = cw + j * CONV_CH + C_XA + n * 64 + 16 * qd;
                const f32x4_t w0 = *(const f32x4_t*)wr_, w1 = *(const f32x4_t*)(wr_ + 4), w2 = *(const f32x4_t*)(wr_ + 8), w3 = *(const f32x4_t*)(wr_ + 12);
                const float wv[16] = {w0[0], w0[1], w0[2], w0[3], w1[0], w1[1], w1[2], w1[3], w2[0], w2[1], w2[2], w2[3], w3[0], w3[1], w3[2], w3[3]};
                const unsigned aw[8] = {pre[j][0].x, pre[j][0].y, pre[j][0].z, pre[j][0].w, pre[j][1].x, pre[j][1].y, pre[j][1].z, pre[j][1].w};
#pragma unroll
                for (int e2 = 0; e2 < 8; ++e2) { u[2 * e2] += wv[2 * e2] * __uint_as_float(aw[e2] << 16); u[2 * e2 + 1] += wv[2 * e2 + 1] * __uint_as_float(aw[e2] & 0xffff0000u); } }
            v4u o0, o1;
            o0.x = cvtpk(u[0], u[1]); o0.y = cvtpk(u[2], u[3]); o0.z = cvtpk(u[4], u[5]); o0.w = cvtpk(u[6], u[7]);
            o1.x = cvtpk(u[8], u[9]); o1.y = cvtpk(u[10], u[11]); o1.z = cvtpk(u[12], u[13]); o1.w = cvtpk(u[14], u[15]);
            *(LAS v4u*)(hb + R_U + (i * LS + 16 * qd) * 2) = o0; *(LAS v4u*)(hb + R_U + (i * LS + 16 * qd + 8) * 2) = o1;
        }
        RG_PREFETCH(((iter + 1) * nblk + bidx) * 2 + half, tidf);
        RG_BAR(); if (MODE == 3) { TP_END(9, 9); } TP_BEGIN(10);
        _Pragma("unroll 1") for (int rq = 0, nq = opq2(RGP_GATES); rq < nq; ++rq)
        if (valid) {
            bf16x8_t wf[4][4]; float tb[4][3]; f32x4_t ra[4], ri[4];
#define RG_LOADW(d_) do { const bf16_t* wa_t = RGWT + (size_t)(((d_) * 6 + n) * 2) * 4096; const bf16_t* wx_t = wa_t + 4096; \
        _Pragma("unroll") for (int nt = 0; nt < 4; ++nt) { const int e = 16 * nt + l15, ch = n * 64 + e; \
            wf[nt][0] = *(const bf16x8_t*)(wa_t + e * 64 + 8 * g); wf[nt][1] = *(const bf16x8_t*)(wa_t + e * 64 + 32 + 8 * g); \
            wf[nt][2] = *(const bf16x8_t*)(wx_t + e * 64 + 8 * g); wf[nt][3] = *(const bf16x8_t*)(wx_t + e * 64 + 32 + 8 * g); \
            tb[nt][0] = rgtab[(d_) * 384 + ch]; tb[nt][1] = rgtab[768 + (d_) * 384 + ch]; tb[nt][2] = rgtab[1536 + (d_) * 384 + ch]; } } while (0)
#define RG_MMA() do { _Pragma("unroll") for (int nt = 0; nt < 4; ++nt) { ra[nt] = (f32x4_t){0.f, 0.f, 0.f, 0.f}; ri[nt] = ra[nt]; \
            ra[nt] = __builtin_amdgcn_mfma_f32_16x16x32_bf16(a0, wf[nt][0], ra[nt], 0, 0, 0); ra[nt] = __builtin_amdgcn_mfma_f32_16x16x32_bf16(a1, wf[nt][1], ra[nt], 0, 0, 0); \
            ri[nt] = __builtin_amdgcn_mfma_f32_16x16x32_bf16(a0, wf[nt][2], ri[nt], 0, 0, 0); ri[nt] = __builtin_amdgcn_mfma_f32_16x16x32_bf16(a1, wf[nt][3], ri[nt], 0, 0, 0); \
            ra[nt] += tb[nt][0]; ri[nt] += tb[nt][1]; } } while (0)
            RG_LOADW(0);
            const bf16x8_t a0 = lds_frag(hb + R_U, 16 * w + l15, 8 * g), a1 = lds_frag(hb + R_U, 16 * w + l15, 32 + 8 * g);
#pragma unroll
            for (int d = 0; d < 2; ++d) {
                LAS float* Ad = (LAS float*)(hb + (d == 0 ? R_A0 : R_A1)); LAS float* Bd = (LAS float*)(hb + (d == 0 ? R_B0 : R_B1));
                RG_MMA();
                float ls8v[4];
#pragma unroll
                for (int nt = 0; nt < 4; ++nt) ls8v[nt] = tb[nt][2];
                asm volatile("" ::: "memory");
                if (d == 0) RG_LOADW(1);
#pragma unroll
                for (int nt = 0; nt < 4; ++nt) {
                    const int e = 16 * nt + l15;
#pragma unroll
                    for (int r = 0; r < 4; ++r) {
                        const int tok = 16 * w + 4 * g + r;
                        const float rr = frcp(1.0f + fexp(-ra[nt][r])), ig = frcp(1.0f + fexp(-ri[nt][r]));
                        const float log_a = rr * ls8v[nt], y = 2.0f * log_a;
                        const float om = -y * (1.0f + y * (0.5f + y * ((1.0f / 6.0f) + y * ((1.0f / 24.0f) + y * ((1.0f / 120.0f) + y * ((1.0f / 720.0f) + y * (1.0f / 5040.0f)))))));
                        Ad[tok * 64 + e] = fexp(log_a); Bd[tok * 64 + e] = fsqrt_(om) * (ig * bf2f(*(const LAS bf16_t*)(hb + R_U + (tok * LS + e) * 2)));
                    }
                }
            }
#undef RG_LOADW
#undef RG_MMA
        }
        v4u z0 = {0u, 0u, 0u, 0u}, z1 = z0;
        if (MODE == 3 && valid) { const bf16_t* zp = P + (size_t)t * LDP + C_ZA + n * 64 + 16 * qd; z0 = *(const v4u*)zp; z1 = *(const v4u*)(zp + 8); }
        RG_BAR(); if (MODE == 3) { TP_END(10, 10); } TP_BEGIN(11);
        _Pragma("unroll 1") for (int rq = 0, nq = (MODE == 1 ? opq2(RGP_SCAN) : 1); rq < nq; ++rq)
        if (valid && w < 2) {
            const int d = w;
            const LAS float* Ad = (const LAS float*)(hb + (d == 0 ? R_A0 : R_A1)); LAS float* Bd = (LAS float*)(hb + (d == 0 ? R_B0 : R_B1));
            const int ch = n * 64 + lane; const size_t si = ((size_t)(d * NB + b) * 68 + tc) * 384 + ch;
            float h = MODE == 3 ? HIN[si] : 0.f, ap = 1.f;
#pragma unroll 8
            for (int step = 0; step < 64; ++step) { const int tok = d ? 63 - step : step; const float a = Ad[tok * 64 + lane];
                h = a * h + Bd[tok * 64 + lane]; if (MODE == 3) Bd[tok * 64 + lane] = h; else ap *= a; }
            if (MODE == 1) { SUMA[si] = ap; SUMH[si] = h; }
        }
        if (MODE == 3) {
            RG_BAR(); TP_END(11, 11);
            if (valid) {
                const LAS float* B0 = (const LAS float*)(hb + R_B0); const LAS float* B1 = (const LAS float*)(hb + R_B1);
                const unsigned zw[8] = {z0.x, z0.y, z0.z, z0.w, z1.x, z1.y, z1.z, z1.w};
                unsigned ow[8];
#pragma unroll
                for (int e2 = 0; e2 < 8; ++e2) { const int e = 16 * qd + 2 * e2;
                    const float h0 = B0[i * 64 + e] + B1[i * 64 + e], h1 = B0[i * 64 + e + 1] + B1[i * 64 + e + 1];
                    ow[e2] = cvtpk(h0 * siluf_(__uint_as_float(zw[e2] << 16)), h1 * siluf_(__uint_as_float(zw[e2] & 0xffff0000u))); }
                v4u o0 = {ow[0], ow[1], ow[2], ow[3]}, o1 = {ow[4], ow[5], ow[6], ow[7]};
                bf16_t* fp = F + (size_t)t * 1024 + n * 64 + 16 * qd;
                *(v4u*)fp = o0; *(v4u*)(fp + 8) = o1;
            }
        }
        TP_BEGIN(12);
        RG_BAR(); if (MODE == 3) { TP_END(12, 12); TP_END(8, 8); }
    }
#undef RG_PREFETCH
}
#undef RG_BAR
__device__ __forceinline__ void rg_carry(const float* SUMA, const float* SUMH, float* HIN, int idx) {
    const int ch = idx % 384, b = (idx / 384) % NB, d = idx / (384 * NB);
    const size_t base = ((size_t)(d * NB + b) * 68) * 384 + ch;
    float h = 0.f;
#pragma unroll 4
    for (int s = 0; s < 68; ++s) { const int tc = d == 0 ? s : (s < 4 ? 3 - s : 71 - s);
        const size_t k = base + (size_t)tc * 384; HIN[k] = h; h = SUMA[k] * h + SUMH[k]; }
}

constexpr int NA_LAT_ITEMS = NB * 6 * 64 * 4, NA_CTX_ITEMS = NB * 6 * 16;
__device__ __forceinline__ void na_mfma_item(const bf16_t* P, const bf16_t* VT, const LAS float* rpbl, bf16_t* F, int item, int lane) {
    const int g = lane >> 4, l15 = lane & 15;
    const bool latent = item < NA_LAT_ITEMS;
    int b, hh, r, qb;
    if (latent) { qb = item & 3; r = (item >> 2) & 63; const int bh = item >> 8; hh = bh % 6; b = bh / 6; }
    else { const int it2 = item - NA_LAT_ITEMS; qb = it2 & 15; const int bh = it2 >> 4; hh = bh % 6; b = bh / 6; r = 0; }
    const int tq = latent ? b * SEQT + CTX + r * 64 + 16 * qb + l15 : b * SEQT + 16 * qb + l15;
    const bf16_t* qp = P + (size_t)tq * LDP + C_QN + hh * 64 + 8 * g;
    const bf16x8_t bq0 = *(const bf16x8_t*)qp, bq1 = *(const bf16x8_t*)(qp + 32);
    const int c0 = qb == 0 ? 0 : (qb == 1 ? 8 : (qb == 2 ? 24 : 32));
    const int r0 = min(max(r - 4, 0), 56), jq = 16 * qb + l15, cs = min(max(jq - 8, 0), 48);
    const int ia = 8 * (l15 >> 2) + (l15 & 3);
    float sc[16][8];
#define NA_TOK0(G_) ((G_) < 8 ? b * SEQT + CTX + (r0 + (G_)) * 64 + c0 : b * SEQT + 32 * ((G_) - 8))
#define NA_QK_BATCH(G0_, NG_) do { bf16x8_t kf[NG_][4]; \
        _Pragma("unroll") for (int q = 0; q < (NG_); ++q) { const bf16_t* ka = P + (size_t)(NA_TOK0((G0_) + q) + ia) * LDP + C_KN + hh * 64 + 8 * g; const bf16_t* kb = ka + 4 * LDP; \
            kf[q][0] = *(const bf16x8_t*)ka; kf[q][1] = *(const bf16x8_t*)(ka + 32); kf[q][2] = *(const bf16x8_t*)kb; kf[q][3] = *(const bf16x8_t*)(kb + 32); } \
        _Pragma("unroll") for (int q = 0; q < (NG_); ++q) { const int G = (G0_) + q; \
            f32x4_t sa = {0.f, 0.f, 0.f, 0.f}, sb = {0.f, 0.f, 0.f, 0.f}; \
            sa = __builtin_amdgcn_mfma_f32_16x16x32_bf16(kf[q][0], bq0, sa, 0, 0, 0); sa = __builtin_amdgcn_mfma_f32_16x16x32_bf16(kf[q][1], bq1, sa, 0, 0, 0); \
            sb = __builtin_amdgcn_mfma_f32_16x16x32_bf16(kf[q][2], bq0, sb, 0, 0, 0); sb = __builtin_amdgcn_mfma_f32_16x16x32_bf16(kf[q][3], bq1, sb, 0, 0, 0); \
            _Pragma("unroll") for (int e = 0; e < 8; ++e) { float v = (e < 4 ? sa[e & 3] : sb[e & 3]) * 0.125f; \
                if (G < 8) { const int kc = c0 + 8 * g + e; const bool ok = kc >= cs && kc < cs + 16; \
                    const float bias = rpbl[hh * 465 + (r0 + G - r + 7) * 31 + (ok ? kc - jq + 15 : 0)]; v = ok ? v + bias : -1e30f; } \
                sc[G][e] = v; } } } while (0)
    if (latent) NA_QK_BATCH(0, 8);
    else {
#pragma unroll
        for (int G = 0; G < 8; ++G)
#pragma unroll
            for (int e = 0; e < 8; ++e) sc[G][e] = -1e30f;
    }
    NA_QK_BATCH(8, 4);
    NA_QK_BATCH(12, 4);
    float m = -1e30f;
#pragma unroll
    for (int G = 0; G < 16; ++G)
#pragma unroll
        for (int e = 0; e < 8; ++e) m = fmaxf(m, sc[G][e]);
    m = fmaxf(m, shx(m, 16)); m = fmaxf(m, shx(m, 32));
    bf16x8_t pf[16]; float lsum = 0.f;
#pragma unroll
    for (int G = 0; G < 16; ++G) { float pv[8];
#pragma unroll
        for (int e = 0; e < 8; ++e) { pv[e] = fexp(sc[G][e] - m); lsum += pv[e]; }
        v4u pk; pk.x = cvtpk(pv[0], pv[1]); pk.y = cvtpk(pv[2], pv[3]); pk.z = cvtpk(pv[4], pv[5]); pk.w = cvtpk(pv[6], pv[7]);
        pf[G] = __builtin_bit_cast(bf16x8_t, pk); }
    f32x4_t o[4];
#pragma unroll
    for (int dt = 0; dt < 4; ++dt) o[dt] = (f32x4_t){0.f, 0.f, 0.f, 0.f};
    const bf16_t* vbase = VT + (size_t)(hh * 64 + l15) * T + 8 * g;
#define NA_PV_BATCH(G0_, NG_) do { bf16x8_t vf[NG_][4]; \
        _Pragma("unroll") for (int q = 0; q < (NG_); ++q) { const int tok0 = NA_TOK0((G0_) + q); \
            _Pragma("unroll") for (int dt = 0; dt < 4; ++dt) vf[q][dt] = *(const bf16x8_t*)(vbase + (size_t)(16 * dt) * T + tok0); } \
        _Pragma("unroll") for (int q = 0; q < (NG_); ++q) { _Pragma("unroll") for (int dt = 0; dt < 4; ++dt) o[dt] = __builtin_amdgcn_mfma_f32_16x16x32_bf16(vf[q][dt], pf[(G0_) + q], o[dt], 0, 0, 0); } } while (0)
    if (latent) NA_PV_BATCH(0, 8);
    NA_PV_BATCH(8, 8);
#undef NA_TOK0
#undef NA_QK_BATCH
#undef NA_PV_BATCH
    lsum += shx(lsum, 16); lsum += shx(lsum, 32);
    const float inv = frcp(lsum);
#pragma unroll
    for (int dt = 0; dt < 4; ++dt) {
        const v2u zr = *(const v2u*)(P + (size_t)tq * LDP + C_ZN + hh * 64 + 16 * dt + 4 * g);
        const float z0 = __uint_as_float(zr.x << 16), z1 = __uint_as_float(zr.x & 0xffff0000u), z2 = __uint_as_float(zr.y << 16), z3 = __uint_as_float(zr.y & 0xffff0000u);
        v2u ov; ov.x = cvtpk(o[dt][0] * inv * siluf_(z0), o[dt][1] * inv * siluf_(z1)); ov.y = cvtpk(o[dt][2] * inv * siluf_(z2), o[dt][3] * inv * siluf_(z3));
        *(v2u*)(F + (size_t)tq * 1024 + 384 + hh * 64 + 16 * dt + 4 * g) = ov;
    }
}
constexpr int NAW_K = 12288, NAW_KROW = 144, NAW_VROW = 1680, NAW_ITEMW = 12032;
constexpr int NAW_LAT = NB * 6 * 32, NAW_CTX = NB * 6 * 2;
__device__ __forceinline__ void na_wg_item(const bf16_t* P, const bf16_t* VT, LAS unsigned char* lds, bf16_t* F, int item, int wid, int lane) {
    const LAS float* rpbl = (const LAS float*)lds;
    const int g = lane >> 4, l15 = lane & 15, tid = wid * 64 + lane;
    const bool latent = item < NAW_LAT;
    int b, hh, rp;
    if (latent) { rp = item & 31; const int bh = item >> 5; hh = bh % 6; b = bh / 6; } else { const int it2 = item - NAW_LAT; rp = it2 & 1; const int bh = it2 >> 1; hh = bh % 6; b = bh / 6; }
    const int r = latent ? 2 * rp + (wid >> 2) : 0, qb = latent ? (wid & 3) : 8 * rp + wid;
    const int R0 = min(max(2 * rp - 4, 0), 56);
    const int tq = latent ? b * SEQT + CTX + r * 64 + 16 * qb + l15 : b * SEQT + 16 * qb + l15;
    const bf16_t* qp = P + (size_t)tq * LDP + C_QN + hh * 64 + 8 * g;
    const bf16x8_t bq0 = *(const bf16x8_t*)qp, bq1 = *(const bf16x8_t*)(qp + 32);
    LAS unsigned char* kreg = lds + NAW_K;
    {   v4u kr[13];
#pragma unroll
        for (int k = 0; k < 13; ++k) { const int p = tid + 512 * k, key = p >> 3, seg = p & 7;
            const int tok = key < 576 ? b * SEQT + CTX + min(R0 + (key >> 6), 63) * 64 + (key & 63) : b * SEQT + (key - 576);
            kr[k] = (latent || key >= 576) ? *(const v4u*)(P + (size_t)tok * LDP + C_KN + hh * 64 + 8 * seg) : (v4u){0u, 0u, 0u, 0u}; }
#pragma unroll
        for (int k = 0; k < 13; ++k) { const int p = tid + 512 * k, key = p >> 3, seg = p & 7; *(LAS v4u*)(kreg + key * NAW_KROW + seg * 16) = kr[k]; }
    }
    __syncthreads();
    const int c0 = (qb & 3) == 0 ? 0 : ((qb & 3) == 1 ? 8 : ((qb & 3) == 2 ? 24 : 32));
    const int r0 = min(max(r - 4, 0), 56), jq = 16 * (qb & 3) + l15, cs = min(max(jq - 8, 0), 48);
    const int ia = 8 * (l15 >> 2) + (l15 & 3);
    float sc[16][8];
#define NAW_KEY0(G_) ((G_) < 8 ? (r0 - R0 + (G_)) * 64 + c0 : 576 + 32 * ((G_) - 8))
#pragma unroll
    for (int G = 0; G < 16; ++G) {
        if (G < 8 && !latent) {
#pragma unroll
            for (int e = 0; e < 8; ++e) sc[G][e] = -1e30f;
            continue; }
        const LAS unsigned char* ka = kreg + (NAW_KEY0(G) + ia) * NAW_KROW + 16 * g; const LAS unsigned char* kb = ka + 4 * NAW_KROW;
        const bf16x8_t aa0 = *(const LAS bf16x8_t*)ka, aa1 = *(const LAS bf16x8_t*)(ka + 64), ab0 = *(const LAS bf16x8_t*)kb, ab1 = *(const LAS bf16x8_t*)(kb + 64);
        f32x4_t sa = {0.f, 0.f, 0.f, 0.f}, sb = {0.f, 0.f, 0.f, 0.f};
        sa = __builtin_amdgcn_mfma_f32_16x16x32_bf16(aa0, bq0, sa, 0, 0, 0); sa = __builtin_amdgcn_mfma_f32_16x16x32_bf16(aa1, bq1, sa, 0, 0, 0);
        sb = __builtin_amdgcn_mfma_f32_16x16x32_bf16(ab0, bq0, sb, 0, 0, 0); sb = __builtin_amdgcn_mfma_f32_16x16x32_bf16(ab1, bq1, sb, 0, 0, 0);
#pragma unroll
        for (int e = 0; e < 8; ++e) {
            float v = (e < 4 ? sa[e & 3] : sb[e & 3]) * 0.125f;
            if (G < 8) { const int kc = c0 + 8 * g + e; const bool ok = kc >= cs && kc < cs + 16;
                const float bias = rpbl[hh * 465 + (r0 + G - r + 7) * 31 + (ok ? kc - jq + 15 : 0)]; v = ok ? v + bias : -1e30f; }
            sc[G][e] = v;
        }
    }
    v4u vr[13];
#define NAW_VLOAD(k0_, k1_) do { _Pragma("unroll") for (int k = (k0_); k < (k1_); ++k) { const int p = tid + 512 * k, dim = p / 104, q = p - dim * 104; \
        const bf16_t* src = VT + (size_t)(hh * 64 + dim) * T + (q < 72 ? b * SEQT + CTX + min(R0 + (q >> 3), 63) * 64 + (q & 7) * 8 : b * SEQT + (q - 72) * 8); \
        vr[k] = (latent || q >= 72) ? *(const v4u*)src : (v4u){0u, 0u, 0u, 0u}; } } while (0)
    NAW_VLOAD(0, 5);
    float m = -1e30f;
#pragma unroll
    for (int G = 0; G < 16; ++G)
#pragma unroll
        for (int e = 0; e < 8; ++e) m = fmaxf(m, sc[G][e]);
    m = fmaxf(m, shx(m, 16)); m = fmaxf(m, shx(m, 32));
    bf16x8_t pf[16]; float lsum = 0.f;
#pragma unroll
    for (int G = 0; G < 16; ++G) { float pv[8];
#pragma unroll
        for (int e = 0; e < 8; ++e) { pv[e] = fexp(sc[G][e] - m); lsum += pv[e]; }
        v4u pk; pk.x = cvtpk(pv[0], pv[1]); pk.y = cvtpk(pv[2], pv[3]); pk.z = cvtpk(pv[4], pv[5]); pk.w = cvtpk(pv[6], pv[7]);
        pf[G] = __builtin_bit_cast(bf16x8_t, pk); }
    NAW_VLOAD(5, 13);
#undef NAW_VLOAD
    __syncthreads();
#pragma unroll
    for (int k = 0; k < 13; ++k) { const int p = tid + 512 * k, dim = p / 104, q = p - dim * 104; const int key = q < 72 ? (q >> 3) * 64 + (q & 7) * 8 : 576 + (q - 72) * 8;
        *(LAS v4u*)(kreg + dim * NAW_VROW + key * 2) = vr[k]; }
    __syncthreads();
    f32x4_t o[4];
#pragma unroll
    for (int dt = 0; dt < 4; ++dt) o[dt] = (f32x4_t){0.f, 0.f, 0.f, 0.f};
#pragma unroll
    for (int G = 0; G < 16; ++G) {
        if (G < 8 && !latent) continue;
        const LAS unsigned char* vb = kreg + l15 * NAW_VROW + (NAW_KEY0(G) + 8 * g) * 2;
#pragma unroll
        for (int dt = 0; dt < 4; ++dt) o[dt] = __builtin_amdgcn_mfma_f32_16x16x32_bf16(*(const LAS bf16x8_t*)(vb + 16 * dt * NAW_VROW), pf[G], o[dt], 0, 0, 0);
    }
#undef NAW_KEY0
    lsum += shx(lsum, 16); lsum += shx(lsum, 32);
    const float inv = frcp(lsum);
    int tq2 = tq; asm volatile("" : "+v"(tq2));
#pragma unroll
    for (int dt = 0; dt < 4; ++dt) {
        const v2u zr = *(const v2u*)(P + (size_t)tq2 * LDP + C_ZN + hh * 64 + 16 * dt + 4 * g);
        const float z0 = __uint_as_float(zr.x << 16), z1 = __uint_as_float(zr.x & 0xffff0000u), z2 = __uint_as_float(zr.y << 16), z3 = __uint_as_float(zr.y & 0xffff0000u);
        v2u ov; ov.x = cvtpk(o[dt][0] * inv * siluf_(z0), o[dt][1] * inv * siluf_(z1)); ov.y = cvtpk(o[dt][2] * inv * siluf_(z2), o[dt][3] * inv * siluf_(z3));
        *(v2u*)(F + (size_t)tq2 * 1024 + 384 + hh * 64 + 16 * dt + 4 * g) = ov;
    }
    __syncthreads();
}
__device__ __forceinline__ void vt_transpose(const bf16_t* P, bf16_t* VT, LAS unsigned char* scr, int gw, int NGW, int lane) {
    for (int it = gw; it < NB * 68 * 6; it += NGW) {
        const int hh = it % 6, tcb = it / 6, t0 = (tcb / 68) * SEQT + (tcb % 68) * 64;
        const bf16_t* src = P + (size_t)(t0 + lane) * LDP + C_VN + hh * 64;
#pragma unroll
        for (int q8 = 0; q8 < 8; ++q8) *(LAS v4u*)(scr + (lane * LS + 8 * q8) * 2) = *(const v4u*)(src + 8 * q8);
        LDS_WAIT();
        bf16_t* dst = VT + (size_t)(hh * 64 + lane) * T + t0;
#pragma unroll
        for (int q8 = 0; q8 < 8; ++q8) { unsigned w4[4];
#pragma unroll
            for (int e2 = 0; e2 < 4; ++e2) { const unsigned lo = *(const LAS bf16_t*)(scr + ((8 * q8 + 2 * e2) * LS + lane) * 2), hi = *(const LAS bf16_t*)(scr + ((8 * q8 + 2 * e2 + 1) * LS + lane) * 2); w4[e2] = lo | (hi << 16); }
            v4u o = {w4[0], w4[1], w4[2], w4[3]}; *(v4u*)(dst + 8 * q8) = o; }
        LDS_WAIT();
    }
}
#define XB_TMO      128
#define XB_XCNT(j)  (256  + 64 * (j))
#define XB_XSUB(j)  (1280 + 64 * (j))
#define XB_XGEN(j)  (2304 + 64 * (j))
#define XB_TOP      3328
#define XB_TOPGEN   3392
#define XCD_BAR_WORDS 3456
#define XB_SPIN_CAP (1u << 18)

__device__ __forceinline__ unsigned xb_ld(unsigned* p)              { return __hip_atomic_load(p, __ATOMIC_RELAXED, __HIP_MEMORY_SCOPE_AGENT); }
__device__ __forceinline__ unsigned xb_add(unsigned* p, unsigned v) { return __hip_atomic_fetch_add(p, v, __ATOMIC_RELAXED, __HIP_MEMORY_SCOPE_AGENT); }
__device__ __forceinline__ unsigned xb_xcc_id() { return (unsigned)__builtin_amdgcn_s_getreg((3 << 11) | 20) & 0xFu; }
#define XB_SPIN(cond, bar) do { unsigned _sp = 0; while (cond) { __builtin_amdgcn_s_sleep(1); \
    if ((++_sp & 255u) == 0u) { if (xb_ld(&(bar)[XB_TMO])) break; if (_sp > XB_SPIN_CAP) { atomicAdd(&(bar)[XB_TMO], 1u); break; } } } } while (0)

struct XcdBarrier {
    unsigned* bar; unsigned x;
    volatile LAS unsigned* st;
};

__device__ __forceinline__ XcdBarrier xcd_barrier_post(unsigned* bar, volatile LAS unsigned* st) {
    XcdBarrier b; b.bar = bar; b.x = xb_xcc_id(); b.st = st;
    if (threadIdx.x == 0) (void)xb_add(&bar[XB_XCNT(b.x)], 1u);
    return b;
}
__device__ __forceinline__ void xcd_barrier_complete(unsigned* bar, unsigned x, unsigned& nloc, unsigned& nx) {
    const unsigned G = gridDim.x * gridDim.y * gridDim.z;
    unsigned sum, cnt, mine, sp = 0u;
    for (;;) {
        sum = 0u; cnt = 0u; mine = 0u;
#pragma unroll
        for (unsigned j = 0; j < 16; ++j) { const unsigned c = xb_ld(&bar[XB_XCNT(j)]); sum += c; cnt += (c > 0u) ? 1u : 0u; mine = (j == x) ? c : mine; }
        if (sum == G) break;
        __builtin_amdgcn_s_sleep(1);
        if ((++sp & 255u) == 0u) { if (xb_ld(&bar[XB_TMO])) break; if (sp > XB_SPIN_CAP) { atomicAdd(&bar[XB_TMO], 1u); break; } }
    }
    nloc = mine > 0u ? mine : 1u; nx = cnt > 0u ? cnt : 1u;
}

__device__ __forceinline__ void xcd_barrier(const XcdBarrier& b) {
    asm volatile("s_waitcnt vmcnt(0)" ::: "memory");
    __syncthreads();
    if (threadIdx.x == 0) {
        unsigned* bar = b.bar;
        __builtin_amdgcn_s_waitcnt(0);
        unsigned nloc = b.st[0], nx = b.st[1];
        if (nloc == 0u) { xcd_barrier_complete(bar, b.x, nloc, nx); b.st[0] = nloc; b.st[1] = nx; }
        const unsigned old = xb_add(&bar[XB_XSUB(b.x)], 1u);
        const unsigned gen = old / nloc;
        if (old + 1u == (gen + 1u) * nloc) {
            __builtin_amdgcn_fence(__ATOMIC_RELEASE, "agent");
            asm volatile("s_waitcnt vmcnt(0)" ::: "memory");
            const unsigned og = xb_add(&bar[XB_TOP], 1u);
            const unsigned tg = og / nx;
            if (og + 1u == (tg + 1u) * nx) xb_add(&bar[XB_TOPGEN], 1u);
            else XB_SPIN(xb_ld(&bar[XB_TOPGEN]) == tg, bar);
            __builtin_amdgcn_fence(__ATOMIC_ACQUIRE, "agent");
            xb_add(&bar[XB_XGEN(b.x)], 1u);
            asm volatile("s_waitcnt vmcnt(0)" ::: "memory");
        } else {
            XB_SPIN(xb_ld(&bar[XB_XGEN(b.x)]) == gen, bar);
            __builtin_amdgcn_fence(__ATOMIC_ACQUIRE, "agent");
            asm volatile("s_waitcnt vmcnt(0)" ::: "memory");
        }
    }
    __syncthreads();
}


#ifndef REP_P2A
#define REP_P2A 1
#endif
#ifndef REP_P2B
#define REP_P2B 1
#endif
#ifndef REP_CH
#define REP_CH 1
#endif
#ifndef REP_NA
#define REP_NA 1
#endif
#ifndef REP_GDN1
#define REP_GDN1 1
#endif
#ifndef REP_RG1
#define REP_RG1 1
#endif
#ifndef REP_VT
#define REP_VT 1
#endif
#ifndef REP_COMB
#define REP_COMB 1
#endif
#ifndef REP_RG3
#define REP_RG3 1
#endif
#ifndef REP_G2
#define REP_G2 1
#endif
#ifndef REP_P5
#define REP_P5 1
#endif
#ifndef REP_P3
#define REP_P3 1
#endif
#ifndef REP_G1
#define REP_G1 1
#endif
#ifndef REP_SYNC
#define REP_SYNC 1
#endif
#ifdef PHPROBE
#define PH_MARK(id_) do { if (bid == 0 && threadIdx.x == 0) { const unsigned long long now_ = __builtin_amdgcn_s_memrealtime(); LAS unsigned long long* ph_ = (LAS unsigned long long*)(lds + LDS_BAR_OFF + 64); ph_[16 + (id_)] += now_ - ph_[15]; ph_[15] = now_; } } while (0)
#else
#define PH_MARK(id_) do {} while (0)
#endif
#define GSYNC() do { _Pragma("unroll 1") for (int rs_ = 0, nrs_ = opq(REP_SYNC); rs_ < nrs_; ++rs_) { XcdBarrier xb_; xb_.bar = (unsigned*)(WSB + WS_BAR); xb_.x = xb_xcc_id(); xb_.st = (volatile LAS unsigned*)(lds + LDS_BAR_OFF); xcd_barrier(xb_); } } while (0)
__device__ __forceinline__ int opq(int i) { asm volatile("" : "+s"(i)); return i; }
#define IN(i) ((const float*)p.ptr[opq(i)])
#define WSB ((unsigned char*)p.ptr[opq(21)])
#define OUTP ((float*)p.ptr[opq(20)])
#define ctl ((unsigned*)(WSB + WS_CTL))
#define mod ((float*)(WSB + WS_MOD))
#define WTIN ((bf16_t*)(WSB + WS_WTIN))
#define WTOUT ((bf16_t*)(WSB + WS_WTOUT))
#define X ((float*)(WSB + WS_X))
#define UF ((bf16_t*)(WSB + WS_UF))
#define P ((bf16_t*)(WSB + WS_P))
#define gdn0 ((unsigned char*)OUTP)
#define gdnx (WSB + WS_GDNX)
#define VT ((bf16_t*)(WSB + WS_VT))
#define rcos ((float*)(WSB + WS_ROPE))
#define rsin ((float*)(WSB + WS_ROPE) + 1024)
#define RGWT ((bf16_t*)(WSB + WS_RGWT))
#define rgtab ((float*)(WSB + WS_RGTAB))
#define SUMA ((float*)(WSB + WS_RGS))
#define SUMH ((float*)(WSB + WS_RGS) + (1 << 18))
#define HIN ((float*)(WSB + WS_RGS) + (2 << 18))
__device__ __forceinline__ int fresh_v(int v) { asm volatile("" : "+v"(v)); return v; }
__device__ __forceinline__ int lane_now() { int l; asm volatile("v_mbcnt_lo_u32_b32 %0, -1, 0\n\tv_mbcnt_hi_u32_b32 %0, -1, %0" : "=v"(l)); return l; }
enum { I_X = 0, I_C, I_CTX, I_CCTX, I_WMOD, I_BMOD, I_WIN, I_CONVW, I_RGWA, I_RGBA, I_RGWX, I_RGBX, I_RGLAM, I_RPB, I_ALOG, I_DTB, I_NW, I_WOUT, I_LNG, I_LNB };
__global__ void __launch_bounds__(512, 2) mega_fwd(Params p) {
    extern __shared__ __attribute__((aligned(16))) unsigned char lds_raw[];
    LAS unsigned char* lds = (LAS unsigned char*)lds_raw;
    cg::grid_group grid = cg::this_grid();
    const int bid = (int)blockIdx.x; __builtin_assume(bid >= 0 && bid < 256);
    const int wid = __builtin_amdgcn_readfirstlane((int)threadIdx.x >> 6);
#define lane0 lane_now()
#define tid (wid * 64 + lane_now())
#define BIDL opq(bid)
#define WIDL opq(wid)
    const int gw0 = bid * 8 + wid, NGW = 2048;
    if (threadIdx.x < 2) ((volatile LAS unsigned*)(lds + LDS_BAR_OFF))[threadIdx.x] = 0u;
#if defined(TPROBE) || defined(PHPROBE)
    if (threadIdx.x < 64) ((volatile LAS unsigned*)(lds + LDS_BAR_OFF + 64))[threadIdx.x] = 0u;
#endif
    __syncthreads();
    (void)xcd_barrier_post((unsigned*)(WSB + WS_BAR), (volatile LAS unsigned*)(lds + LDS_BAR_OFF));
#ifdef PHPROBE
    if (bid == 0 && threadIdx.x == 0) ((LAS unsigned long long*)(lds + LDS_BAR_OFF + 64))[15] = __builtin_amdgcn_s_memrealtime();
#endif
    const int gw = gw0;
    LAS float* wscr = (LAS float*)(lds + wid * 16384);
    { const int lane = lane_now();

    phase_mods(IN(I_C), IN(I_CCTX), IN(I_WMOD), IN(I_BMOD), mod, (LAS float*)lds, wid, lane);
    convert_weights(IN(I_WIN), IN(I_WOUT), WTIN, WTOUT, wscr, gw, NGW, lane);
    convert_rg(IN(I_RGWA), IN(I_RGBA), IN(I_RGWX), IN(I_RGBX), IN(I_RGLAM), RGWT, rgtab, (int)blockIdx.x * 512 + tid, (int)gridDim.x * 512);
    if (blockIdx.x == 0) { for (int e = tid; e < 1024; e += 512) { const float ang = (float)(e >> 4) * expf(-(float)(e & 15) * (9.210340371976184f / 16.0f)); rcos[e] = cosf(ang); rsin[e] = sinf(ang); } }
    grid.sync(); PH_MARK(0);
    prep_rows0(IN(I_X), IN(I_CTX), mod, UF, gw, NGW, lane);
    }
    GSYNC(); PH_MARK(1);
#pragma unroll 1
    for (int l = 0; l < DEPTH; ++l) {
        const float* modl = mod + (size_t)l * 5 * 3072;
        { pg8::Gemm g{UF, WTIN, T, NPAD, D}; pg8::StaticOrder S; S.init(T, NPAD, 256, BIDL);
          pg8::EpiP E{P};
          _Pragma("unroll 1") for (int rp = 0, nrp = opq(REP_G1); rp < nrp; ++rp)
          pg8::gemm_phase<pg8::EpiP, pg8::StaticOrder, true, true>(lds, g, S, E, WIDL * 64 + lane_now());
        }
        GSYNC(); PH_MARK(2);
        _Pragma("unroll 1") for (int rp = 0, nrp = opq(REP_P2A); rp < nrp; ++rp) {
#ifndef ABL_P1
        _Pragma("unroll 1") for (int r2 = 0, n2 = opq(REP_GDN1); r2 < n2; ++r2)
        gdn_pass1(P, IN(I_CONVW) + (size_t)l * 4 * CONV_CH, IN(I_ALOG) + l * 8, IN(I_DTB) + l * 8, rcos, rsin, gdn0, gdnx, lds, WIDL, BIDL, opq(256));
#endif
        _Pragma("unroll 1") for (int r2 = 0, n2 = opq(REP_RG1); r2 < n2; ++r2)
        rg_pass<1>(P, IN(I_CONVW) + (size_t)l * 4 * CONV_CH, RGWT, rgtab, SUMA, SUMH, nullptr, nullptr, lds, WIDL, BIDL, opq(256));
        _Pragma("unroll 1") for (int r2 = 0, n2 = opq(REP_VT); r2 < n2; ++r2)
        vt_transpose(P, VT, lds + WIDL * 16384, (BIDL * 8 + WIDL), NGW, fresh_v(lane0));
        __syncthreads(); }
        GSYNC(); PH_MARK(3);
        _Pragma("unroll 1") for (int rp = 0, nrp = opq(REP_P2B); rp < nrp; ++rp) { const int lane = fresh_v(lane0); const int bx = BIDL;
            const float* rpb = IN(I_RPB) + (size_t)l * 6 * 15 * 31;
            for (int e = (WIDL * 64 + lane_now()); e < 6 * 465; e += 512) ((LAS float*)lds)[e] = rpb[e];
            __syncthreads();
#ifndef ABL_CH
            if (bx < 32) _Pragma("unroll 1") for (int r2 = 0, n2 = opq(REP_CH); r2 < n2; ++r2) gdn_chain(gdn0, gdnx, P, bx, lds + 65536, WIDL, lane);
#endif
            if (bx >= 32 && bx < 38) rg_carry(SUMA, SUMH, HIN, (bx - 32) * 512 + (WIDL * 64 + lane_now()));
            __syncthreads();
            const int n_items = NAW_LAT + (l < DEPTH - 1 ? NAW_CTX : 0);
            _Pragma("unroll 1") for (int r3 = 0, n3 = opq(REP_NA); r3 < n3; ++r3) {
            unsigned* cnt = ctl + 64 * (l + 1) + 16 * rp + 8 * r3;
            for (;;) {
                if ((WIDL * 64 + lane_now()) == 0) *(LAS int*)(lds + NAW_ITEMW) = (int)__hip_atomic_fetch_add(cnt, 1u, __ATOMIC_RELAXED, __HIP_MEMORY_SCOPE_AGENT);
                __syncthreads();
                const int it = __builtin_amdgcn_readfirstlane(*(const LAS int*)(lds + NAW_ITEMW));
                if (it >= n_items) break;
                na_wg_item(P, VT, lds, UF, it, WIDL, lane_now());
            } }
            __syncthreads();
        }
        GSYNC(); PH_MARK(4);
        _Pragma("unroll 1") for (int rp = 0, nrp = opq(REP_P3); rp < nrp; ++rp) {
        _Pragma("unroll 1") for (int r2 = 0, n2 = opq(REP_RG3); r2 < n2; ++r2)
        rg_pass<3>(P, IN(I_CONVW) + (size_t)l * 4 * CONV_CH, RGWT, rgtab, nullptr, nullptr, HIN, UF, lds, WIDL, BIDL, opq(256));
        { const int lane = fresh_v(lane0); const int gw = (BIDL * 8 + WIDL); _Pragma("unroll 1") for (int r2 = 0, n2 = opq(REP_COMB); r2 < n2; ++r2) combine_rows(P, IN(I_NW) + l * 64, UF, gw, NGW, lane); } }
        GSYNC(); PH_MARK(5);
        { pg8::Gemm g{UF, WTOUT, T, D, D}; pg8::StaticOrder S; S.init(T, D, 256, BIDL);
          if (opq(REP_G2) > 1) { pg8::EpiZ E2{IN(I_X), IN(I_CTX), X, (float*)P, modl, l == 0 ? 1 : 0};
            pg8::gemm_phase<pg8::EpiZ, pg8::StaticOrder, true, true>(lds, g, S, E2, WIDL * 64 + lane_now()); }
          pg8::EpiZ E{IN(I_X), IN(I_CTX), X, X, modl, l == 0 ? 1 : 0};
#ifndef ABL_G2
          pg8::gemm_phase<pg8::EpiZ, pg8::StaticOrder, true, true>(lds, g, S, E, WIDL * 64 + lane_now());
#endif
        }
        GSYNC(); PH_MARK(6);
        if (l < DEPTH - 1) { const int lane = fresh_v(lane0); const int gw = (BIDL * 8 + WIDL);
            if (opq(REP_P5) > 1) { ln_rows(X, (float*)P, IN(I_LNG) + l * D, IN(I_LNB) + l * D, nullptr, mod + (size_t)(l + 1) * 5 * 3072, (bf16_t*)((unsigned char*)P + 72 * MiB), gw, NGW, lane);
                convert_weights(IN(I_WIN) + (size_t)(l + 1) * D * DIN, IN(I_WOUT) + (size_t)(l + 1) * D * D, WTIN, WTOUT, (LAS float*)(lds + WIDL * 16384), gw, NGW, lane); }
            ln_rows(X, X, IN(I_LNG) + l * D, IN(I_LNB) + l * D, nullptr, mod + (size_t)(l + 1) * 5 * 3072, UF, gw, NGW, lane);
            convert_weights(IN(I_WIN) + (size_t)(l + 1) * D * DIN, IN(I_WOUT) + (size_t)(l + 1) * D * D, WTIN, WTOUT, (LAS float*)(lds + WIDL * 16384), gw, NGW, lane);
            convert_rg(IN(I_RGWA) + (size_t)(l + 1) * 49152, IN(I_RGBA) + (l + 1) * 768, IN(I_RGWX) + (size_t)(l + 1) * 49152, IN(I_RGBX) + (l + 1) * 768, IN(I_RGLAM) + (l + 1) * 768, RGWT, rgtab, BIDL * 512 + (WIDL * 64 + lane_now()), opq(256) * 512);
            GSYNC(); PH_MARK(7);
        } else { const int lane = fresh_v(lane0); const int gw = (BIDL * 8 + WIDL); ln_rows(X, X, IN(I_LNG) + l * D, IN(I_LNB) + l * D, OUTP, nullptr, nullptr, gw, NGW, lane); }
    }
#ifdef PHPROBE
    GSYNC(); PH_MARK(7);
    if (bid == 0 && threadIdx.x == 0) { const LAS unsigned long long* ph = (const LAS unsigned long long*)(lds + LDS_BAR_OFF + 64); OUTP[0] = 0.01f * (float)ph[16 + PHPROBE]; }
#endif
#ifdef TPROBE
#ifndef TPBASE
#define TPBASE 0
#endif
    GSYNC();
    if (bid == 0 && threadIdx.x == 0) { const LAS unsigned long long* tp = (const LAS unsigned long long*)(lds + LDS_BAR_OFF + 64);
        OUTP[0] = 1000.0f * (float)tp[TPROBE] / (float)tp[TPBASE]; }
#endif
}
#undef ctl
#undef mod
#undef WTIN
#undef WTOUT
#undef X
#undef UF
#undef P
#undef gdn0
#undef gdnx
#undef VT
#undef rcos
#undef rsin
#undef RGWT
#undef rgtab
#undef SUMA
#undef SUMH
#undef HIN
#undef lane0
#undef BIDL
#undef WIDL
#undef tid
}

extern "C" void kernel_launch(void* const* d_in, const int* in_sizes, int n_in, void* d_out, int out_size, void* d_ws, size_t ws_size, hipStream_t stream) {
    static int grid = 0;
    if (grid == 0) {
        if (n_in != 20 || ws_size < WS_END) { fprintf(stderr, "kernel_launch: unexpected n_in %d / ws_size %zu\n", n_in, ws_size); grid = -1; return; }
        int dev = 0, cus = 0, per_cu = 0;
        hipGetDevice(&dev);
        hipDeviceGetAttribute(&cus, hipDeviceAttributeMultiprocessorCount, dev);
        if (hipFuncSetAttribute((const void*)mega_fwd, hipFuncAttributeMaxDynamicSharedMemorySize, LDS_BYTES) != hipSuccess) { fprintf(stderr, "kernel_launch: hipFuncSetAttribute failed\n"); grid = -1; return; }
        if (hipOccupancyMaxActiveBlocksPerMultiprocessor(&per_cu, (const void*)mega_fwd, 512, LDS_BYTES) != hipSuccess || per_cu < 1) { fprintf(stderr, "kernel_launch: occupancy query gave %d\n", per_cu); per_cu = 1; }
        (void)hipGetLastError();
        grid = 256;
        if (cus < 256) { fprintf(stderr, "kernel_launch: needs 256 CUs, device has %d\n", cus); grid = -1; return; }
        fprintf(stderr, "kernel_launch: cus %d per_cu %d grid %d\n", cus, per_cu, grid);
    }
    if (grid < 0) return;
    hipMemsetAsync((char*)d_ws + WS_CTL, 0, CTL_ZERO_BYTES, stream);
    Params prm{};
    for (int i = 0; i < 20; ++i) prm.ptr[i] = d_in[i];
    prm.ptr[20] = d_out; prm.ptr[21] = d_ws;
    void* args[] = {&prm};
    hipError_t e = hipLaunchCooperativeKernel((const void*)mega_fwd, dim3(grid), dim3(512), args, LDS_BYTES, stream);
    if (e != hipSuccess) fprintf(stderr, "cooperative launch failed: %s (grid %d)\n", hipGetErrorString(e), grid);
}
```

```cpp
#include <hip/hip_runtime.h>
#include <hip/hip_cooperative_groups.h>
#include <cstdio>
#include <cstdint>
namespace cg = cooperative_groups;

namespace {
constexpr int D = 1024, NB = 4, SEQ = 4096, DEPTH = 4, CTX = 256;
constexpr int SEQT = CTX + SEQ;
constexpr int T = NB * SEQT;
constexpr int DIN = 3344, LDP = 3360, NPAD = 3584;
constexpr int CONV_CH = 1152;
constexpr int C_XA = 0, C_QG = 384, C_KG = 640, C_VG = 896, C_ZA = 1152, C_QN = 1536, C_KN = 1920, C_VN = 2304,
              C_ZN = 2688, C_ZG = 3072, C_BR = 3328, C_AR = 3336;
constexpr float ALPHA = 1.681792830507429f;
}
namespace pg8 {
#define PG8_LAS __attribute__((address_space(3)))
typedef unsigned short bf16_t;
typedef short bf16x8 __attribute__((ext_vector_type(8)));
typedef float f32x4 __attribute__((ext_vector_type(4)));
typedef unsigned u32x4 __attribute__((ext_vector_type(4)));
constexpr int BM = 256, BK = 64, HALF = 128, HTB = HALF * BK * 2  , STAGE_BYTES = 8 * HTB, NXCD = 8, WGM = 8;

__host__ __device__ __forceinline__ int lds_byte(int r, int c) { const int st = (r >> 4) * 2 + (c >> 5), rr = r & 15, cc = c & 31, ob = rr * 64 + cc * 2; return st * 1024 + (ob ^ (((ob >> 9) & 1) << 5)); }
__host__ __device__ __forceinline__ void stage_rc(int b, int& R, int& C) { const int st = b / 1024, sb = b % 1024, swz = sb ^ (((sb >> 9) & 1) << 5); R = (st >> 1) * 16 + swz / 64; C = (st & 1) * 32 + (swz % 64) / 2; }
__host__ __device__ __forceinline__ int perm32(int rho) { const int n = rho >> 4, i = rho & 15; return 8 * (i >> 2) + 4 * n + (i & 3); }

struct Unit { int pm, pn; };
struct Gemm { const bf16_t* A; const bf16_t* Bt; int M, N, K; };

struct StaticOrder {
    int nM, nN, nwg, G, c;
    __host__ __device__ void init(int M, int N, int G_, int c_) { nM = M / BM; nN = N / BM; nwg = nM * nN; G = G_; c = c_; }
    __host__ __device__ bool next(int i, Unit& u) const {
        const long L = (long)i * G + c; if (L >= nwg) return false;
        int wgid = (int)L; { const int q = nwg / NXCD, r = nwg % NXCD, xcd = wgid % NXCD, off = wgid / NXCD; wgid = (xcd < r ? xcd * (q + 1) : r * (q + 1) + (xcd - r) * q) + off; }
        const int nig = WGM * nN, gid = wgid / nig, fm = gid * WGM, gsz = (nM - fm) < WGM ? (nM - fm) : WGM;
        u.pm = fm + ((wgid % nig) % gsz); u.pn = (wgid % nig) / gsz; return true;
    }
    __device__ __forceinline__ void a_ready(const Unit&) const {}
    __device__ __forceinline__ void done(const Unit&) const {}
};
struct LatOrder { int c;
    __host__ __device__ bool next(int i, Unit& u) const { if (i > 0) return false; const int k = c >> 3, pl = (c & 7) * 8 + (k >> 2);
        u.pm = (pl >> 4) * 17 + 1 + (pl & 15); u.pn = k & 3; return true; }
    __device__ __forceinline__ void a_ready(const Unit&) const {}
    __device__ __forceinline__ void done(const Unit&) const {} };
struct CtxOrder { int c;
    __host__ __device__ bool next(int i, Unit& u) const { if (i > 0 || c >= 16) return false; u.pm = 17 * (c >> 2); u.pn = c & 3; return true; }
    __device__ __forceinline__ void a_ready(const Unit&) const {}
    __device__ __forceinline__ void done(const Unit&) const {} };

typedef __bf16 bf16v2 __attribute__((ext_vector_type(2)));
typedef float f32v2 __attribute__((ext_vector_type(2)));
__device__ __forceinline__ unsigned cvt_pk_bf16(float lo, float hi) { const f32v2 v = {lo, hi}; return __builtin_bit_cast(unsigned, __builtin_convertvector(v, bf16v2)); }
struct EpiP {
    static constexpr bool PERM = true, AFTER_DRAIN = false;
    bf16_t* P;
    __device__ __forceinline__ void operator()(const f32x4 (&acc)[2][2][4][2], const Unit& u, int wr, int wc, int fr, int fq) const {
        asm volatile("" : "+v"(fr), "+v"(fq));
        const int row0 = u.pm * BM + wr * 64 + fr, col0 = u.pn * BM + wc * 32 + 8 * fq;
#pragma unroll
        for (int ai = 0; ai < 2; ++ai)
#pragma unroll
            for (int m = 0; m < 4; ++m) { bf16_t* rowp = P + (size_t)(row0 + ai * HALF + m * 16) * LDP + col0;
#pragma unroll
                for (int bj = 0; bj < 2; ++bj) { if (col0 + bj * HALF < LDP) { const f32x4 v0 = acc[ai][bj][m][0], v1 = acc[ai][bj][m][1];
                    u32x4 w; w.x = cvt_pk_bf16(v0[0], v0[1]); w.y = cvt_pk_bf16(v0[2], v0[3]); w.z = cvt_pk_bf16(v1[0], v1[1]); w.w = cvt_pk_bf16(v1[2], v1[3]);
                    *(u32x4*)(rowp + bj * HALF) = w; } } }
    }
};
struct EpiZ {
    static constexpr bool PERM = false, AFTER_DRAIN = false;
    const float* x_in; const float* ctx_in; const float* X; float* Xout; const float* modl; int layer0;
    __device__ __forceinline__ void operator()(const f32x4 (&acc)[2][2][4][2], const Unit& u, int wr, int wc, int fr, int fq) const {
        asm volatile("" : "+v"(fr), "+v"(fq));
        const int row0 = u.pm * BM + wr * 64 + fr, col0 = u.pn * BM + wc * 32 + 4 * fq;
#pragma unroll
        for (int ai = 0; ai < 2; ++ai)
#pragma unroll
            for (int m = 0; m < 4; ++m) { const int r = row0 + ai * HALF + m * 16; const int b = r / SEQT, sp = r - b * SEQT; const int j = sp < CTX ? 4 : b;
                const float* xs = layer0 ? (sp < CTX ? ctx_in + ((size_t)b * CTX + sp) * D : x_in + ((size_t)b * SEQ + (sp - CTX)) * D) : X + (size_t)r * D;
                float* zo = Xout + (size_t)r * D; const float* gp = modl + j * 3072 + 2048;
#pragma unroll
                for (int bj = 0; bj < 2; ++bj)
#pragma unroll
                    for (int n = 0; n < 2; ++n) { const int c = col0 + bj * HALF + n * 16; const f32x4 xv = *(const f32x4*)(xs + c), gv = *(const f32x4*)(gp + c);
                        *(f32x4*)(zo + c) = xv * ALPHA + gv * acc[ai][bj][m][n]; } }
    }
};

template <class Epi, class Sched, bool ALIGN_EPI = false, bool SP2 = false>
__device__ __forceinline__ void gemm_phase(PG8_LAS unsigned char* lds, const Gemm g, const Sched& S, const Epi& E, const int tid  ) {
    const int wid = __builtin_amdgcn_readfirstlane(tid >> 6), lane = tid & 63, wr = wid >> 2, wc = wid & 3, fr = lane & 15, fq = lane >> 4;
    const int K = g.K, nt = K / BK;
    unsigned voffA[2], voffB[2];
#pragma unroll
    for (int i = 0; i < 2; ++i) { int R, C; stage_rc(tid * 16 + i * 8192, R, C); const int Rb = Epi::PERM ? ((R & ~31) + perm32(R & 31)) : R;
        voffA[i] = (unsigned)(R * K + C) * 2u; voffB[i] = (unsigned)(Rb * K + C) * 2u; }
    const size_t kstep = (size_t)(BK * 2);
    const size_t hstep = (size_t)HALF * K * 2;
    const size_t tstep = 2 * hstep;
    const unsigned ldsw = (unsigned)wid * 1024u;
    const int aoff = lds_byte(wr * 64 + fr, fq * 8), boff = lds_byte(wc * 32 + fr, fq * 8);
#define PG8_SA(b, h) (((b) * 2 + (h)) * HTB)
#define PG8_SB(b, h) ((4 + (b) * 2 + (h)) * HTB)
#define PG8_STAGE(bufoff, gbase, voff) do { _Pragma("unroll") for (int _i = 0; _i < 2; ++_i) \
        __builtin_amdgcn_global_load_lds((const unsigned*)((const char*)(gbase) + (voff)[_i]), (PG8_LAS unsigned*)(lds + (bufoff) + ldsw + _i * 8192), 16, 0, 0); } while (0)
#define PG8_LDA(dst, b, h) do { _Pragma("unroll") for (int m = 0; m < 4; ++m) _Pragma("unroll") for (int k = 0; k < 2; ++k) dst[m][k] = *(const PG8_LAS bf16x8*)(lds + PG8_SA(b, h) + aoff + m * 2048 + k * 1024); } while (0)
#define PG8_LDB(dst, b, h) do { _Pragma("unroll") for (int n = 0; n < 2; ++n) _Pragma("unroll") for (int k = 0; k < 2; ++k) dst[n][k] = *(const PG8_LAS bf16x8*)(lds + PG8_SB(b, h) + boff + n * 2048 + k * 1024); } while (0)
#define PG8_MMA(ai, bj, At, Bt) do { __builtin_amdgcn_s_setprio(1); _Pragma("unroll") for (int m = 0; m < 4; ++m) _Pragma("unroll") for (int n = 0; n < 2; ++n) _Pragma("unroll") for (int k = 0; k < 2; ++k) \
        acc[ai][bj][m][n] = __builtin_amdgcn_mfma_f32_16x16x32_bf16(Bt[n][k], At[m][k], acc[ai][bj][m][n], 0, 0, 0); __builtin_amdgcn_s_setprio(0); } while (0)
#define PG8_WAIT_V(n) asm volatile("s_waitcnt vmcnt(" #n ")" ::: "memory")
#define PG8_WAIT_L(n) asm volatile("s_waitcnt lgkmcnt(" #n ")" ::: "memory")
#define PG8_BAR __builtin_amdgcn_s_barrier()
#define PG8_SCHED __builtin_amdgcn_sched_barrier(0)
    Unit cur, nxt; int ui = 0;
    if (!S.next(0, cur)) return;
    f32x4 acc[2][2][4][2];
#pragma unroll
    for (int a = 0; a < 2; ++a)
#pragma unroll
        for (int b = 0; b < 2; ++b)
#pragma unroll
            for (int m = 0; m < 4; ++m)
#pragma unroll
                for (int n = 0; n < 2; ++n) acc[a][b][m][n] = (f32x4){0.f, 0.f, 0.f, 0.f};
    bf16x8 At[4][2], B0[2][2], B1[2][2];
    const char* cA = (const char*)g.A + (size_t)cur.pm * tstep; const char* cB = (const char*)g.Bt + (size_t)cur.pn * tstep;
    S.a_ready(cur);
    if constexpr (SP2) {
        PG8_STAGE(PG8_SB(0, 0), cB, voffB); PG8_STAGE(PG8_SB(0, 1), cB + hstep, voffB); PG8_STAGE(PG8_SA(0, 0), cA, voffA); PG8_STAGE(PG8_SA(0, 1), cA + hstep, voffA);
        if (wr == 1) PG8_BAR;
        PG8_WAIT_V(2); PG8_BAR;
        PG8_STAGE(PG8_SB(1, 0), cB + kstep, voffB); PG8_STAGE(PG8_SA(1, 0), cA + kstep, voffA); PG8_STAGE(PG8_SB(1, 1), cB + hstep + kstep, voffB);
        PG8_WAIT_V(6); PG8_BAR;
    } else {
        PG8_STAGE(PG8_SB(0, 0), cB, voffB); PG8_STAGE(PG8_SA(0, 0), cA, voffA); PG8_STAGE(PG8_SB(0, 1), cB + hstep, voffB); PG8_STAGE(PG8_SA(0, 1), cA + hstep, voffA);
        if (wr == 1) PG8_BAR;
        PG8_WAIT_V(4); PG8_BAR;
        PG8_STAGE(PG8_SB(1, 0), cB + kstep, voffB); PG8_STAGE(PG8_SA(1, 0), cA + kstep, voffA); PG8_STAGE(PG8_SB(1, 1), cB + hstep + kstep, voffB);
        PG8_WAIT_V(6); PG8_BAR;
    }
    for (;;) {
        const bool has_next = S.next(ui + 1, nxt);
        const char* nA = has_next ? (const char*)g.A + (size_t)nxt.pm * tstep : cA; const char* nB = has_next ? (const char*)g.Bt + (size_t)nxt.pn * tstep : cB;
        for (int t = 0; t < nt; t += 2) {
            const bool last = (t == nt - 2);
            const char* a1 = cA + (size_t)(t + 1) * kstep;
            const char* a2 = last ? nA : cA + (size_t)(t + 2) * kstep; const char* b2 = last ? nB : cB + (size_t)(t + 2) * kstep;
            const char* a3 = a2 + kstep; const char* b3 = b2 + kstep;
            if (last && has_next) S.a_ready(nxt);
            if constexpr (SP2) {
            PG8_LDB(B0, 0, 0); PG8_LDB(B1, 0, 1); PG8_SCHED; PG8_LDA(At, 0, 0); PG8_STAGE(PG8_SA(1, 1), a1 + hstep, voffA);
            PG8_WAIT_V(8); PG8_WAIT_L(0); PG8_BAR; PG8_MMA(0, 0, At, B0); PG8_MMA(0, 1, At, B1); PG8_BAR; PG8_SCHED;
            PG8_LDA(At, 0, 1); PG8_STAGE(PG8_SB(0, 0), b2, voffB); PG8_STAGE(PG8_SB(0, 1), b2 + hstep, voffB); PG8_STAGE(PG8_SA(0, 0), a2, voffA);
            PG8_WAIT_V(8); PG8_WAIT_L(0); PG8_BAR; PG8_MMA(1, 0, At, B0); PG8_MMA(1, 1, At, B1); PG8_BAR; PG8_SCHED;
            PG8_LDB(B0, 1, 0); PG8_LDB(B1, 1, 1); PG8_SCHED; PG8_LDA(At, 1, 0); PG8_STAGE(PG8_SA(0, 1), a2 + hstep, voffA);
            PG8_WAIT_V(8); PG8_WAIT_L(0); PG8_BAR; PG8_MMA(0, 0, At, B0); PG8_MMA(0, 1, At, B1); PG8_BAR; PG8_SCHED;
            PG8_LDA(At, 1, 1); PG8_STAGE(PG8_SB(1, 0), b3, voffB); PG8_STAGE(PG8_SB(1, 1), b3 + hstep, voffB); PG8_STAGE(PG8_SA(1, 0), a3, voffA);
            PG8_WAIT_V(8); PG8_WAIT_L(0); PG8_BAR; PG8_MMA(1, 0, At, B0); PG8_MMA(1, 1, At, B1); PG8_BAR; PG8_SCHED;
            } else {
            PG8_LDB(B0, 0, 0); PG8_SCHED; PG8_LDA(At, 0, 0); PG8_STAGE(PG8_SA(1, 1), a1 + hstep, voffA);
            PG8_WAIT_L(8); PG8_BAR; PG8_WAIT_L(0); PG8_MMA(0, 0, At, B0); PG8_BAR; PG8_SCHED;
            PG8_LDB(B1, 0, 1); PG8_STAGE(PG8_SB(0, 0), b2, voffB);
            PG8_BAR; PG8_WAIT_L(0); PG8_MMA(0, 1, At, B1); PG8_BAR;
            PG8_LDA(At, 0, 1); PG8_STAGE(PG8_SA(0, 0), a2, voffA);
            PG8_BAR; PG8_WAIT_L(0); PG8_MMA(1, 0, At, B0); PG8_BAR; PG8_SCHED;
            PG8_STAGE(PG8_SB(0, 1), b2 + hstep, voffB);
            PG8_WAIT_V(6); PG8_BAR; PG8_MMA(1, 1, At, B1); PG8_BAR;
            PG8_LDB(B0, 1, 0); PG8_SCHED; PG8_LDA(At, 1, 0); PG8_STAGE(PG8_SA(0, 1), a2 + hstep, voffA);
            PG8_WAIT_L(8); PG8_BAR; PG8_WAIT_L(0); PG8_MMA(0, 0, At, B0); PG8_BAR; PG8_SCHED;
            PG8_LDB(B1, 1, 1); PG8_STAGE(PG8_SB(1, 0), b3, voffB);
            PG8_BAR; PG8_WAIT_L(0); PG8_MMA(0, 1, At, B1); PG8_BAR;
            PG8_LDA(At, 1, 1); PG8_STAGE(PG8_SA(1, 0), a3, voffA);
            PG8_BAR; PG8_WAIT_L(0); PG8_MMA(1, 0, At, B0); PG8_BAR; PG8_SCHED;
            PG8_STAGE(PG8_SB(1, 1), b3 + hstep, voffB);
            PG8_WAIT_V(6); PG8_BAR; PG8_MMA(1, 1, At, B1); PG8_BAR;
            }
        }
        if constexpr (ALIGN_EPI) { if (wr == 0) PG8_BAR; }
        if constexpr (!Epi::AFTER_DRAIN) { E(acc, cur, wr, wc, fr, fq); S.done(cur); }
        if (!has_next) break;
#pragma unroll
        for (int a = 0; a < 2; ++a)
#pragma unroll
            for (int b = 0; b < 2; ++b)
#pragma unroll
                for (int m = 0; m < 4; ++m)
#pragma unroll
                    for (int n = 0; n < 2; ++n) acc[a][b][m][n] = (f32x4){0.f, 0.f, 0.f, 0.f};
        cur = nxt; cA = nA; cB = nB; ++ui;
        if constexpr (ALIGN_EPI) { if (wr == 1) PG8_BAR; }
    }
    PG8_WAIT_V(0);
    if constexpr (!ALIGN_EPI) { if (wr == 0) PG8_BAR; }
    PG8_BAR;
    if constexpr (Epi::AFTER_DRAIN) { E.fused(acc, cur, wr, wc, fr, fq, lds, wid, lane); S.done(cur); }
#undef PG8_SA
#undef PG8_SB
#undef PG8_STAGE
#undef PG8_LDA
#undef PG8_LDB
#undef PG8_MMA
#undef PG8_WAIT_V
#undef PG8_WAIT_L
#undef PG8_BAR
#undef PG8_SCHED
}
}

namespace {
#define LAS __attribute__((address_space(3)))
typedef unsigned short bf16_t;
typedef unsigned v4u __attribute__((ext_vector_type(4)));
typedef float f32x4 __attribute__((ext_vector_type(4)));
#define LDS_WAIT() asm volatile("s_waitcnt lgkmcnt(0)" ::: "memory")

__device__ __forceinline__ unsigned f2bf(float f) { unsigned u = __float_as_uint(f); return (u + 0x7fffu + ((u >> 16) & 1u)) >> 16; }
__device__ __forceinline__ unsigned pk2(float lo, float hi) { return f2bf(lo) | (f2bf(hi) << 16); }
__device__ __forceinline__ float bf2f(bf16_t b) { return __uint_as_float(((unsigned)b) << 16); }
__device__ __forceinline__ float fexp(float x) { return __builtin_amdgcn_exp2f(x * 1.4426950408889634f); }
__device__ __forceinline__ float frcp(float x) { return __builtin_amdgcn_rcpf(x); }
__device__ __forceinline__ float frsq(float x) { return __builtin_amdgcn_rsqf(x); }
__device__ __forceinline__ float fsqrt_(float x) { return __builtin_amdgcn_sqrtf(x); }
__device__ __forceinline__ float flog(float x) { return __builtin_amdgcn_logf(x) * 0.6931471805599453f; }
__device__ __forceinline__ float sigmoidf_(float x) { return frcp(1.0f + fexp(-x)); }
__device__ __forceinline__ float siluf_(float x) { return x * frcp(1.0f + fexp(-x)); }
__device__ __forceinline__ float softplusf_(float x) { const float e = fexp(x); return x > 15.f ? x : (e < 1e-3f ? e * (1.0f - 0.5f * e) : flog(1.0f + e)); }
__device__ __forceinline__ int lane_id_v() { int l; asm volatile("v_mbcnt_lo_u32_b32 %0, -1, 0\n\tv_mbcnt_hi_u32_b32 %0, -1, %0" : "=v"(l)); return l; }
__device__ __forceinline__ float shx(float v, int mask) { return __builtin_bit_cast(float, __builtin_amdgcn_ds_bpermute((lane_id_v() ^ mask) << 2, __builtin_bit_cast(int, v))); }
__device__ __forceinline__ float shidx(float v, int src) { return __builtin_bit_cast(float, __builtin_amdgcn_ds_bpermute(src << 2, __builtin_bit_cast(int, v))); }
__device__ __forceinline__ float wave_sum(float v) {
#pragma unroll
    for (int o = 32; o >= 1; o >>= 1) v += shx(v, o);
    return v; }
__device__ __forceinline__ float wave_max(float v) {
#pragma unroll
    for (int o = 32; o >= 1; o >>= 1) v = fmaxf(v, shx(v, o));
    return v; }

constexpr size_t MiB = 1u << 20;
constexpr size_t WS_CTL = 0, CTL_ZERO_BYTES = 65536;
constexpr size_t WS_MOD = 1 * MiB;
constexpr size_t WS_WTIN = 2 * MiB;
constexpr size_t WS_WTOUT = 10 * MiB;
constexpr size_t WS_X = 12 * MiB;
constexpr size_t WS_UF = 80 * MiB;
constexpr size_t WS_P = 114 * MiB;
constexpr size_t WS_GDNX = 226 * MiB;
constexpr size_t WS_VT = 230 * MiB;
constexpr size_t WS_RGS = 247 * MiB;
constexpr size_t WS_END = 250 * MiB;
constexpr size_t WS_RGWT = 1 * MiB + 576 * 1024;
constexpr size_t WS_RGTAB = 1 * MiB + 768 * 1024;
constexpr size_t WS_ROPE = 1 * MiB + 512 * 1024;
constexpr int LDS_BAR_OFF = 155648;
constexpr int LDS_BYTES = 155648 + 256;
constexpr size_t WS_BAR = 16384;

struct Params { const void* ptr[22]; };

__device__ __forceinline__ void phase_mods(const float* c, const float* cctx, const float* w_mod, const float* b_mod, float* mod, LAS float* sc, int wid, int lane) {
    for (int item = blockIdx.x; item < DEPTH * 48; item += gridDim.x) {
        const int l = item / 48, n = (item % 48) * 64 + lane;
        float a0 = 0, a1 = 0, a2 = 0, a3 = 0, a4 = 0;
        const float* w = w_mod + (size_t)l * 1024 * 3072 + n;
        for (int k = wid * 128; k < wid * 128 + 128; ++k) {
            const float wv = w[(size_t)k * 3072];
            a0 += siluf_(c[k]) * wv; a1 += siluf_(c[1024 + k]) * wv; a2 += siluf_(c[2048 + k]) * wv; a3 += siluf_(c[3072 + k]) * wv; a4 += siluf_(cctx[k]) * wv;
        }
        sc[(wid * 5 + 0) * 64 + lane] = a0; sc[(wid * 5 + 1) * 64 + lane] = a1; sc[(wid * 5 + 2) * 64 + lane] = a2; sc[(wid * 5 + 3) * 64 + lane] = a3; sc[(wid * 5 + 4) * 64 + lane] = a4;
        __syncthreads();
        if (wid < 5) { float s = 0.f;
#pragma unroll
            for (int w8 = 0; w8 < 8; ++w8) s += sc[(w8 * 5 + wid) * 64 + lane];
            mod[(size_t)(l * 5 + wid) * 3072 + n] = s + b_mod[l * 3072 + n]; }
        __syncthreads();
    }
}
__device__ __forceinline__ void transpose_item(const float* W, int K, int N, int nblk, bf16_t* WT, LAS float* scr, int item, int lane) {
    const int kb = item / nblk, nb = item % nblk, k0 = 64 * kb, n0 = 32 * nb;
    const int nn = n0 + (lane & 31);
#pragma unroll 8
    for (int i = 0; i < 32; ++i) { const int kk = 2 * i + (lane >> 5); scr[kk * 33 + (lane & 31)] = nn < N ? W[(size_t)(k0 + kk) * N + nn] : 0.f; }
    LDS_WAIT();
    const int c = lane & 7;
#pragma unroll
    for (int j = 0; j < 4; ++j) { const int n = (lane >> 3) + 8 * j; const LAS float* s = scr + (8 * c) * 33 + n;
        v4u o; o.x = pk2(s[0 * 33], s[1 * 33]); o.y = pk2(s[2 * 33], s[3 * 33]); o.z = pk2(s[4 * 33], s[5 * 33]); o.w = pk2(s[6 * 33], s[7 * 33]);
        *(v4u*)(WT + (size_t)(n0 + n) * K + k0 + 8 * c) = o; }
    LDS_WAIT();
}
__device__ __forceinline__ void convert_weights(const float* w_in_l, const float* w_out_l, bf16_t* WTIN, bf16_t* WTOUT, LAS float* scr, int gw, int NGW, int lane) {
    constexpr int I_IN = 16 * 105, I_OUT = 16 * 32;
    for (int it = gw; it < I_IN + I_OUT; it += NGW) {
        if (it < I_IN) transpose_item(w_in_l, 1024, DIN, 105, WTIN, scr, it, lane);
        else transpose_item(w_out_l, 1024, 1024, 32, WTOUT, scr, it - I_IN, lane);
    }
}
__device__ __forceinline__ void convert_rg(const float* wa, const float* ba, const float* wx, const float* bx, const float* lam, bf16_t* RGWT, float* rgtab, int gtid, int ngt) {
    for (int idx = gtid; idx < 24 * 4096 + 768; idx += ngt) {
        if (idx < 24 * 4096) { const int dd = idx & 63, e = (idx >> 6) & 63, m = idx >> 12, kind = m & 1, dn = m >> 1;
            RGWT[idx] = (bf16_t)f2bf((kind ? wx : wa)[((size_t)dn * 64 + dd) * 64 + e]); }
        else { const int k = idx - 24 * 4096; rgtab[k] = ba[k]; rgtab[768 + k] = bx[k]; rgtab[1536 + k] = -8.0f * log1pf(expf(-lam[k])); }
    }
}
__device__ __forceinline__ void prep_rows0(const float* x, const float* ctx, const float* modl, bf16_t* U, int gw, int NGW, int lane) {
    for (int t = gw; t < T; t += NGW) {
        const int b = t / SEQT, sp = t - b * SEQT, j = sp < CTX ? 4 : b;
        const float* xs = sp < CTX ? ctx + ((size_t)b * CTX + sp) * D : x + ((size_t)b * SEQ + (sp - CTX)) * D;
        const float* sh = modl + j * 3072; const float* sc = sh + 1024;
#pragma unroll
        for (int q = 0; q < 4; ++q) { const int k = (q * 64 + lane) * 4; const f32x4 v = *(const f32x4*)(xs + k), s1 = *(const f32x4*)(sc + k), s0 = *(const f32x4*)(sh + k);
            const f32x4 u = v * (s1 + 1.0f) + s0; uint2 o; o.x = pk2(u[0], u[1]); o.y = pk2(u[2], u[3]); *(uint2*)(U + (size_t)t * D + k) = o; }
    }
}
__device__ __forceinline__ void ln_rows(const float* X, float* Xw, const float* g, const float* bta, float* final_out, const float* modn, bf16_t* U, int gw, int NGW, int lane) {
    for (int t0 = gw; t0 < T; t0 += 2 * NGW) {
        int tt[2]; bool ok[2]; f32x4 v[2][4]; float s[2];
#pragma unroll
        for (int r2 = 0; r2 < 2; ++r2) { tt[r2] = t0 + r2 * NGW; ok[r2] = tt[r2] < T; if (ok[r2] && final_out && (tt[r2] % SEQT) < CTX) ok[r2] = false;
            const float* xr = X + (size_t)(ok[r2] ? tt[r2] : t0) * D; s[r2] = 0.f;
#pragma unroll
            for (int q = 0; q < 4; ++q) { v[r2][q] = *(const f32x4*)(xr + (q * 64 + lane) * 4); s[r2] += (v[r2][q][0] + v[r2][q][1]) + (v[r2][q][2] + v[r2][q][3]); } }
#pragma unroll
        for (int o = 32; o >= 1; o >>= 1) { s[0] += shx(s[0], o); s[1] += shx(s[1], o); }
        float s2[2];
#pragma unroll
        for (int r2 = 0; r2 < 2; ++r2) { const float mean = s[r2] * (1.0f / D); s2[r2] = 0.f;
#pragma unroll
            for (int q = 0; q < 4; ++q) { v[r2][q] = v[r2][q] - mean; s2[r2] += (v[r2][q][0] * v[r2][q][0] + v[r2][q][1] * v[r2][q][1]) + (v[r2][q][2] * v[r2][q][2] + v[r2][q][3] * v[r2][q][3]); } }
#pragma unroll
        for (int o = 32; o >= 1; o >>= 1) { s2[0] += shx(s2[0], o); s2[1] += shx(s2[1], o); }
#pragma unroll
        for (int r2 = 0; r2 < 2; ++r2) { if (!ok[r2]) continue;
            const int t = tt[r2], b = t / SEQT, sp = t - b * SEQT, j = sp < CTX ? 4 : b;
            const float rstd = frsq(s2[r2] * (1.0f / D) + 1e-5f); float* xw = Xw + (size_t)t * D;
#pragma unroll
            for (int q = 0; q < 4; ++q) { const int k = (q * 64 + lane) * 4; const f32x4 y = v[r2][q] * rstd * *(const f32x4*)(g + k) + *(const f32x4*)(bta + k);
                if (final_out) *(f32x4*)(final_out + ((size_t)b * SEQ + (sp - CTX)) * D + k) = y;
                else { *(f32x4*)(xw + k) = y; const f32x4 u = y * (*(const f32x4*)(modn + j * 3072 + 1024 + k) + 1.0f) + *(const f32x4*)(modn + j * 3072 + k);
                    uint2 o; o.x = pk2(u[0], u[1]); o.y = pk2(u[2], u[3]); *(uint2*)(U + (size_t)t * D + k) = o; } } }
    }
}

__device__ __forceinline__ float conv_at(const bf16_t* P, const float* cw, int t, int c) {
    const int sp = t % SEQT;
    const int lo = sp < CTX ? 0 : CTX, hi = sp < CTX ? CTX : SEQT;
    float acc = 0.f;
#pragma unroll
    for (int j = 0; j < 4; ++j) { const int s2 = sp + j - 2; if (s2 >= lo && s2 < hi) acc += cw[j * CONV_CH + c] * bf2f(P[(size_t)(t + j - 2) * LDP + c]); }
    return acc;
}
__device__ __forceinline__ int step_to_sp(int step, int d) { return d == 0 ? step : (step < CTX ? CTX - 1 - step : SEQT - 1 - (step - CTX)); }

__device__ __forceinline__ void combine_rows(const bf16_t* P, const float* nw, bf16_t* F, int gw, int NGW, int lane) {
    for (int t = gw; t < T; t += NGW) {
#pragma unroll
        for (int hh = 0; hh < 4; ++hh) { const int c = hh * 64 + lane;
            const float o = bf2f(P[(size_t)t * LDP + C_QG + c]) + bf2f(P[(size_t)t * LDP + C_KG + c]);
            const float ms = wave_sum(o * o) * (1.0f / 64.0f);
            F[(size_t)t * 1024 + 768 + c] = (bf16_t)f2bf(o * frsq(ms + 1e-6f) * nw[lane] * siluf_(bf2f(P[(size_t)t * LDP + C_ZG + c]))); }
    }
}


constexpr int LS = 72;
constexpr int G_KN = 0, G_KNT = 9216, G_QN = 18432, G_QK = 27648, G_XT = 36864, G_LB = 55296, G_TI = 64512, G_SM = 72704, G_CW = 73728, G_HALF = 77824;
#ifndef GP_S1
#define GP_S1 1
#endif
#ifndef GP_S1B
#define GP_S1B 1
#endif
#ifndef GP_S2
#define GP_S2 1
#endif
#ifndef GP_S4
#define GP_S4 1
#endif
#ifdef TPROBE
#define TP_BEGIN(k_) unsigned long long tp_t##k_ = 0; if (tidf == 0 && bidx == 0) tp_t##k_ = __builtin_amdgcn_s_memtime()
#define TP_END(k_, slot_) do { if (tidf == 0 && bidx == 0) { asm volatile("s_waitcnt lgkmcnt(0)" ::: "memory"); *(LAS unsigned long long*)(lds + 155648 + 64 + 8 * (slot_)) += __builtin_amdgcn_s_memtime() - tp_t##k_; } } while (0)
#else
#define TP_BEGIN(k_) do {} while (0)
#define TP_END(k_, slot_) do {} while (0)
#endif
__device__ __forceinline__ int opq3(int i) { asm volatile("" : "+s"(i)); return i; }
constexpr int GDN_ITEMS = NB * 4 * 2 * 68;
constexpr size_t GDN_ITEM_BYTES = 32768;
typedef short bf16x8_t __attribute__((ext_vector_type(8)));
typedef unsigned v2u __attribute__((ext_vector_type(2)));
typedef float f32x4_t __attribute__((ext_vector_type(4)));

typedef __bf16 bf16v2_t __attribute__((ext_vector_type(2)));
typedef float f32v2_t __attribute__((ext_vector_type(2)));
__device__ __forceinline__ unsigned cvtpk(float lo, float hi) { const f32v2_t v = {lo, hi}; return __builtin_bit_cast(unsigned, __builtin_convertvector(v, bf16v2_t)); }
__device__ __forceinline__ float fsilu(float x) { return x * frcp(1.0f + fexp(-x)); }
__device__ __forceinline__ bf16x8_t lds_frag(const LAS unsigned char* base, int row, int col) { return *(const LAS bf16x8_t*)(base + (row * LS + col) * 2); }
__device__ __forceinline__ unsigned char* gdn_item_ptr(unsigned char* dout, unsigned char* wsx, int it) { return it < 2048 ? dout + (size_t)it * GDN_ITEM_BYTES : wsx + (size_t)(it - 2048) * GDN_ITEM_BYTES; }
__device__ __forceinline__ int gdn_sp(int c, int i, int d) {
    if (c < 4) { const int s = c * 64 + i; return d == 0 ? s : CTX - 1 - s; }
    const int s = (c - 4) * 64 + i; return d == 0 ? CTX + s : SEQT - 1 - s;
}

__device__ __forceinline__ void gdn_pass1(const bf16_t* P, const float* cw, const float* alog, const float* dtb, const float* rcos, const float* rsin,
                                          unsigned char* dout, unsigned char* wsx, LAS unsigned char* lds, int wid8  , int bidx, int nblk) {
    const int n_iter = (544 + 127) / 128;
    {   const int tv0 = wid8 * 64 + lane_id_v();
        const int half0 = tv0 >> 8, t0 = tv0 & 255, hq = (bidx * 2 + half0) & 3;
        LAS float* cwl = (LAS float*)(lds + half0 * G_HALF + G_CW);
        for (int e = t0; e < 768; e += 256) { const int m3 = e >> 8, j = (e >> 6) & 3, ch = e & 63; cwl[e] = cw[j * CONV_CH + (m3 == 0 ? C_QG : (m3 == 1 ? C_KG : C_VG)) + hq * 64 + ch]; }
    }
#define GDN_BAR() do { asm volatile("s_waitcnt lgkmcnt(0)" ::: "memory"); __builtin_amdgcn_s_barrier(); asm volatile("" ::: "memory"); } while (0)
    GDN_BAR();
#pragma unroll 1
    for (int iter = 0; iter < n_iter; ++iter) {
        const int tidf = wid8 * 64 + lane_id_v();
        const int half = __builtin_amdgcn_readfirstlane(tidf >> 8), t256 = tidf & 255, w = __builtin_amdgcn_readfirstlane(t256 >> 6), lane = tidf & 63, g = lane >> 4, l15 = lane & 15;
        LAS unsigned char* hb = lds + half * G_HALF;
        LAS float* sm = (LAS float*)(hb + G_SM);
        const int hq2 = bidx * 2 + half, hh = hq2 & 3, kidx = iter * 128 + (hq2 >> 2);
        const bool valid = kidx < 544;
        const int c = kidx % 68, bd = kidx / 68, d = bd & 1, b = bd >> 1;
        const int it = ((b * 4 + hh) * 2 + d) * 68 + c;
        const int i = t256 >> 2, qd = t256 & 3;
        float qv[16], kv[16], vv[16];
        TP_BEGIN(0); TP_BEGIN(1);
        _Pragma("unroll 1") for (int rq = 0, nq = opq3(GP_S1); rq < nq; ++rq)
        if (valid) {
            const int sp = gdn_sp(c, i, d), t = b * SEQT + sp;
            const int lo = sp < CTX ? 0 : CTX, hi = sp < CTX ? CTX : SEQT;
            v4u raw[4][3][2];
#pragma unroll
            for (int j = 0; j < 4; ++j) { const int s2 = sp + j - 2; const bool ok = s2 >= lo && s2 < hi;
                const bf16_t* pr = P + (size_t)(b * SEQT + (ok ? s2 : sp)) * LDP + hh * 64 + 16 * qd;
#pragma unroll
                for (int m3 = 0; m3 < 3; ++m3) { const int cb = m3 == 0 ? C_QG : (m3 == 1 ? C_KG : C_VG);
                    raw[j][m3][0] = ok ? *(const v4u*)(pr + cb) : (v4u){0u, 0u, 0u, 0u}; raw[j][m3][1] = ok ? *(const v4u*)(pr + cb + 8) : (v4u){0u, 0u, 0u, 0u}; } }
            if (t256 < 64) {
                const int t2 = b * SEQT + gdn_sp(c, lane, d);
                const float beta = sigmoidf_(bf2f(P[(size_t)t2 * LDP + C_BR + d * 4 + hh]));
                const float gg = -fexp(alog[d * 4 + hh]) * softplusf_(bf2f(P[(size_t)t2 * LDP + C_AR + d * 4 + hh]) + dtb[d * 4 + hh]);
                float G = gg;
#pragma unroll
                for (int o = 1; o < 64; o <<= 1) { const float v = shidx(G, lane >= o ? lane - o : lane); if (lane >= o) G += v; }
                const float gl = shidx(G, 63);
                sm[lane] = beta; sm[64 + lane] = G; sm[128 + lane] = fexp(G); sm[192 + lane] = fexp(gl - G);
            }
            const LAS float* cwl = (const LAS float*)(hb + G_CW);
            asm volatile("s_waitcnt vmcnt(0)" ::: "memory");
#pragma unroll
            for (int e = 0; e < 16; ++e) { qv[e] = 0.f; kv[e] = 0.f; vv[e] = 0.f; }
#pragma unroll
            for (int j = 0; j < 4; ++j) {
#pragma unroll
                for (int m3 = 0; m3 < 3; ++m3) {
                    const LAS float* wl = cwl + (m3 * 4 + j) * 64 + 16 * qd;
                    const f32x4_t w0 = *(const LAS f32x4_t*)wl, w1 = *(const LAS f32x4_t*)(wl + 4), w2 = *(const LAS f32x4_t*)(wl + 8), w3 = *(const LAS f32x4_t*)(wl + 12);
                    const float wv[16] = {w0[0], w0[1], w0[2], w0[3], w1[0], w1[1], w1[2], w1[3], w2[0], w2[1], w2[2], w2[3], w3[0], w3[1], w3[2], w3[3]};
                    const unsigned aw[8] = {raw[j][m3][0].x, raw[j][m3][0].y, raw[j][m3][0].z, raw[j][m3][0].w, raw[j][m3][1].x, raw[j][m3][1].y, raw[j][m3][1].z, raw[j][m3][1].w};
#pragma unroll
                    for (int e2 = 0; e2 < 8; ++e2) {
                        const float x0 = __uint_as_float(aw[e2] << 16), x1 = __uint_as_float(aw[e2] & 0xffff0000u);
                        if (m3 == 0) { qv[2 * e2] += wv[2 * e2] * x0; qv[2 * e2 + 1] += wv[2 * e2 + 1] * x1; }
                        else if (m3 == 1) { kv[2 * e2] += wv[2 * e2] * x0; kv[2 * e2 + 1] += wv[2 * e2 + 1] * x1; }
                        else { vv[2 * e2] += wv[2 * e2] * x0; vv[2 * e2 + 1] += wv[2 * e2 + 1] * x1; }
                    }
#define PIN16(a_) asm volatile("" : "+v"(a_[0]), "+v"(a_[1]), "+v"(a_[2]), "+v"(a_[3]), "+v"(a_[4]), "+v"(a_[5]), "+v"(a_[6]), "+v"(a_[7]), "+v"(a_[8]), "+v"(a_[9]), "+v"(a_[10]), "+v"(a_[11]), "+v"(a_[12]), "+v"(a_[13]), "+v"(a_[14]), "+v"(a_[15]) :: "memory")
                    if (m3 == 0) PIN16(qv); else if (m3 == 1) PIN16(kv); else PIN16(vv);
#undef PIN16
                }
            }
            float sq = 0.f, sk = 0.f;
#pragma unroll
            for (int e = 0; e < 16; ++e) { qv[e] = fsilu(qv[e]); kv[e] = fsilu(kv[e]); vv[e] = fsilu(vv[e]); sq += qv[e] * qv[e]; sk += kv[e] * kv[e]; }
            sq += shx(sq, 1); sq += shx(sq, 2); sk += shx(sk, 1); sk += shx(sk, 2);
            const float rq = frsq(sq + 1e-6f), rk = frsq(sk + 1e-6f);
            const bool lat = sp >= CTX;
            const int s = sp - CTX, pos = qd < 2 ? (s >> 6) : (s & 63);
#pragma unroll
            for (int e = 0; e < 16; ++e) {
                float q1 = qv[e] * rq, k1 = kv[e] * rk;
                const float qp = shx(q1, 1), kp = shx(k1, 1);
                if (lat) { const float cs = rcos[pos * 16 + e], sn = rsin[pos * 16 + e];
                    if (qd & 1) { q1 = q1 * cs + qp * sn; k1 = k1 * cs + kp * sn; } else { q1 = q1 * cs - qp * sn; k1 = k1 * cs - kp * sn; } }
                qv[e] = q1 * 0.125f; kv[e] = k1;
            }
        }
        GDN_BAR(); TP_END(1, 1); TP_BEGIN(2);
        _Pragma("unroll 1") for (int rq = 0, nq = opq3(GP_S1B); rq < nq; ++rq)
        if (valid) {
            const float beta = sm[i], eG = sm[128 + i], eGl = sm[192 + i];
            v4u o0, o1;
            o0.x = cvtpk(kv[0], kv[1]); o0.y = cvtpk(kv[2], kv[3]); o0.z = cvtpk(kv[4], kv[5]); o0.w = cvtpk(kv[6], kv[7]);
            o1.x = cvtpk(kv[8], kv[9]); o1.y = cvtpk(kv[10], kv[11]); o1.z = cvtpk(kv[12], kv[13]); o1.w = cvtpk(kv[14], kv[15]);
            *(LAS v4u*)(hb + G_KN + (i * LS + 16 * qd) * 2) = o0; *(LAS v4u*)(hb + G_KN + (i * LS + 16 * qd + 8) * 2) = o1;
            o0.x = cvtpk(qv[0], qv[1]); o0.y = cvtpk(qv[2], qv[3]); o0.z = cvtpk(qv[4], qv[5]); o0.w = cvtpk(qv[6], qv[7]);
            o1.x = cvtpk(qv[8], qv[9]); o1.y = cvtpk(qv[10], qv[11]); o1.z = cvtpk(qv[12], qv[13]); o1.w = cvtpk(qv[14], qv[15]);
            *(LAS v4u*)(hb + G_QN + (i * LS + 16 * qd) * 2) = o0; *(LAS v4u*)(hb + G_QN + (i * LS + 16 * qd + 8) * 2) = o1;
            const float bw = beta * eG;
#pragma unroll
            for (int e = 0; e < 16; ++e) {
                const int f = 16 * qd + e;
                const unsigned p0 = cvtpk(kv[e] * eGl, beta * vv[e]), p1 = cvtpk(bw * kv[e], 0.f);
                *(LAS bf16_t*)(hb + G_KNT + (f * LS + i) * 2) = (bf16_t)(p0 & 0xffffu);
                *(LAS bf16_t*)(hb + G_XT + (f * LS + i) * 2) = (bf16_t)(p0 >> 16);
                *(LAS bf16_t*)(hb + G_XT + ((64 + f) * LS + i) * 2) = (bf16_t)(p1 & 0xffffu);
            }
        }
        GDN_BAR(); TP_END(2, 2); TP_BEGIN(3);
        _Pragma("unroll 1") for (int rq = 0, nq = opq3(GP_S2); rq < nq; ++rq)
        if (valid) {
            const bf16x8_t ak0 = lds_frag(hb + G_KN, 16 * w + l15, 8 * g), ak1 = lds_frag(hb + G_KN, 16 * w + l15, 32 + 8 * g);
            const bf16x8_t aq0 = lds_frag(hb + G_QN, 16 * w + l15, 8 * g), aq1 = lds_frag(hb + G_QN, 16 * w + l15, 32 + 8 * g);
            const f32x4_t Gi = *(const LAS f32x4_t*)(sm + 64 + 16 * w + 4 * g), Bi = *(const LAS f32x4_t*)(sm + 16 * w + 4 * g);
#pragma unroll
            for (int nt = 0; nt < 4; ++nt) {
                const bf16x8_t b0 = lds_frag(hb + G_KN, 16 * nt + l15, 8 * g), b1 = lds_frag(hb + G_KN, 16 * nt + l15, 32 + 8 * g);
                f32x4_t kk = {0.f, 0.f, 0.f, 0.f}, qk = {0.f, 0.f, 0.f, 0.f};
                kk = __builtin_amdgcn_mfma_f32_16x16x32_bf16(ak0, b0, kk, 0, 0, 0); kk = __builtin_amdgcn_mfma_f32_16x16x32_bf16(ak1, b1, kk, 0, 0, 0);
                qk = __builtin_amdgcn_mfma_f32_16x16x32_bf16(aq0, b0, qk, 0, 0, 0); qk = __builtin_amdgcn_mfma_f32_16x16x32_bf16(aq1, b1, qk, 0, 0, 0);
                const int jj = 16 * nt + l15; const float Gj = sm[64 + jj];
#pragma unroll
                for (int r = 0; r < 4; ++r) {
                    const int ii = 16 * w + 4 * g + r;
                    const float e = fexp(fminf(Gi[r] - Gj, 0.f));
                    const unsigned pk = cvtpk(jj < ii ? -(Bi[r] * kk[r] * e) : 0.f, jj <= ii ? qk[r] * e : 0.f);
                    *(LAS bf16_t*)(hb + G_LB + (ii * LS + jj) * 2) = (bf16_t)(pk & 0xffffu);
                    *(LAS bf16_t*)(hb + G_QK + (ii * LS + jj) * 2) = (bf16_t)(pk >> 16);
                }
            }
        }
        GDN_BAR(); TP_END(3, 3); TP_BEGIN(4);
        if (valid) {
            LAS unsigned char* ti = hb + G_TI + w * 2048;
            {   float tv[16];
#pragma unroll
                for (int i2 = 0; i2 < 16; ++i2) {
                    float acc = (i2 == l15) ? 1.0f : 0.0f;
                    if (i2 > 0) { const LAS unsigned char* lr = hb + G_LB + ((16 * g + i2) * LS + 16 * g) * 2;
                        const v4u r0 = *(const LAS v4u*)lr, r1 = *(const LAS v4u*)(lr + 16); const unsigned rw[8] = {r0.x, r0.y, r0.z, r0.w, r1.x, r1.y, r1.z, r1.w};
#pragma unroll
                        for (int j2 = 0; j2 < i2; ++j2) acc += ((j2 & 1) ? __uint_as_float(rw[j2 >> 1] & 0xffff0000u) : __uint_as_float(rw[j2 >> 1] << 16)) * tv[j2]; }
                    tv[i2] = acc;
                }
#pragma unroll
                for (int i2 = 0; i2 < 16; i2 += 2) { const unsigned pk = cvtpk(tv[i2], tv[i2 + 1]);
                    *(LAS bf16_t*)(ti + ((g * 16 + i2) * 16 + l15) * 2) = (bf16_t)(pk & 0xffffu); *(LAS bf16_t*)(ti + ((g * 16 + i2 + 1) * 16 + l15) * 2) = (bf16_t)(pk >> 16); }
            }
            LDS_WAIT();
#pragma unroll
            for (int I = 0; I < 4; ++I) {
                const v2u traw = *(const LAS v2u*)(ti + ((I * 16 + l15) * 16 + 4 * g) * 2);
                const v4u tpk = {traw.x, traw.y, 0u, 0u}; const bf16x8_t a_ti = __builtin_bit_cast(bf16x8_t, tpk);
#pragma unroll
                for (int cti = 0; cti < 2; ++cti) {
                    const int cr = 32 * w + 16 * cti + l15;
                    LAS unsigned char* xp = hb + G_XT + (cr * LS + 16 * I + 4 * g) * 2;
                    const v2u rr = *(const LAS v2u*)xp;
                    f32x4_t acc = {__uint_as_float(rr.x << 16), __uint_as_float(rr.x & 0xffff0000u), __uint_as_float(rr.y << 16), __uint_as_float(rr.y & 0xffff0000u)};
#pragma unroll
                    for (int s2 = 0; s2 < (16 * I + 31) / 32; ++s2) {
                        bf16x8_t al = lds_frag(hb + G_LB, 16 * I + l15, 32 * s2 + 8 * g);
                        if (32 * s2 + 8 * g >= 16 * I) al = (bf16x8_t){0, 0, 0, 0, 0, 0, 0, 0};
                        acc = __builtin_amdgcn_mfma_f32_16x16x32_bf16(al, lds_frag(hb + G_XT, cr, 32 * s2 + 8 * g), acc, 0, 0, 0);
                    }
                    const v4u rpk = {cvtpk(acc[0], acc[1]), cvtpk(acc[2], acc[3]), 0u, 0u};
                    f32x4_t xa = {0.f, 0.f, 0.f, 0.f};
                    xa = __builtin_amdgcn_mfma_f32_16x16x32_bf16(a_ti, __builtin_bit_cast(bf16x8_t, rpk), xa, 0, 0, 0);
                    v2u o; o.x = cvtpk(xa[0], xa[1]); o.y = cvtpk(xa[2], xa[3]); *(LAS v2u*)xp = o;
                }
                LDS_WAIT();
            }
        }
        GDN_BAR(); TP_END(4, 4); TP_BEGIN(5);
        _Pragma("unroll 1") for (int rq = 0, nq = opq3(GP_S4); rq < nq; ++rq)
        if (valid) {
            unsigned char* blk = gdn_item_ptr(dout, wsx, it);
            bf16_t* gM = (bf16_t*)blk; bf16_t* gP = gM + 4096; bf16_t* gN = gM + 8192; bf16_t* gQ = gM + 12288;
            const bf16x8_t akd0 = lds_frag(hb + G_KNT, 16 * w + l15, 8 * g), akd1 = lds_frag(hb + G_KNT, 16 * w + l15, 32 + 8 * g);
            const bf16x8_t aqk0 = lds_frag(hb + G_QK, 16 * w + l15, 8 * g), aqk1 = lds_frag(hb + G_QK, 16 * w + l15, 32 + 8 * g);
            const bf16x8_t aw0 = lds_frag(hb + G_XT, 64 + 16 * w + l15, 8 * g), aw1 = lds_frag(hb + G_XT, 64 + 16 * w + l15, 32 + 8 * g);
            const float egl = sm[128 + 63];
            const int pcol = 16 * w + 4 * g;
#pragma unroll
            for (int nt = 0; nt < 4; ++nt) {
                const bf16x8_t bu0 = lds_frag(hb + G_XT, 16 * nt + l15, 8 * g), bu1 = lds_frag(hb + G_XT, 16 * nt + l15, 32 + 8 * g);
                f32x4_t nn = {0.f, 0.f, 0.f, 0.f}, qm = {0.f, 0.f, 0.f, 0.f};
                nn = __builtin_amdgcn_mfma_f32_16x16x32_bf16(akd0, bu0, nn, 0, 0, 0); nn = __builtin_amdgcn_mfma_f32_16x16x32_bf16(akd1, bu1, nn, 0, 0, 0);
                qm = __builtin_amdgcn_mfma_f32_16x16x32_bf16(aqk0, bu0, qm, 0, 0, 0); qm = __builtin_amdgcn_mfma_f32_16x16x32_bf16(aqk1, bu1, qm, 0, 0, 0);
                const int cc = 16 * nt + l15;
                v2u o; o.x = cvtpk(nn[0], nn[1]); o.y = cvtpk(nn[2], nn[3]); *(v2u*)(gN + cc * 64 + 16 * w + 4 * g) = o;
                o.x = cvtpk(qm[0], qm[1]); o.y = cvtpk(qm[2], qm[3]); *(v2u*)(gQ + cc * 64 + 16 * w + 4 * g) = o;
                const bf16x8_t bk0 = lds_frag(hb + G_KNT, 16 * nt + l15, 8 * g), bk1 = lds_frag(hb + G_KNT, 16 * nt + l15, 32 + 8 * g);
                const bf16x8_t bq0 = lds_frag(hb + G_QK, 16 * nt + l15, 8 * g), bq1 = lds_frag(hb + G_QK, 16 * nt + l15, 32 + 8 * g);
                f32x4_t mm = {0.f, 0.f, 0.f, 0.f}, pm = {0.f, 0.f, 0.f, 0.f};
                mm = __builtin_amdgcn_mfma_f32_16x16x32_bf16(aw0, bk0, mm, 0, 0, 0); mm = __builtin_amdgcn_mfma_f32_16x16x32_bf16(aw1, bk1, mm, 0, 0, 0);
                pm = __builtin_amdgcn_mfma_f32_16x16x32_bf16(aw0, bq0, pm, 0, 0, 0); pm = __builtin_amdgcn_mfma_f32_16x16x32_bf16(aw1, bq1, pm, 0, 0, 0);
                const int frow = 16 * nt + l15;
                float mv[4], pv[4];
                const v2u qraw = *(const LAS v2u*)(hb + G_QN + (frow * LS + 16 * w + 4 * g) * 2);
                const float qf[4] = {__uint_as_float(qraw.x << 16), __uint_as_float(qraw.x & 0xffff0000u), __uint_as_float(qraw.y << 16), __uint_as_float(qraw.y & 0xffff0000u)};
                const float eGi = sm[128 + frow];
#pragma unroll
                for (int r = 0; r < 4; ++r) { mv[r] = ((16 * w + 4 * g + r) == frow ? egl : 0.f) - mm[r]; pv[r] = qf[r] * eGi - pm[r]; }
                o.x = cvtpk(mv[0], mv[1]); o.y = cvtpk(mv[2], mv[3]); *(v2u*)(gM + frow * 64 + pcol) = o;
                o.x = cvtpk(pv[0], pv[1]); o.y = cvtpk(pv[2], pv[3]); *(v2u*)(gP + frow * 64 + pcol) = o;
            }
        }
        GDN_BAR(); TP_END(5, 5); TP_END(0, 0);
    }
#undef GDN_BAR
}

constexpr int CH_SB = 0, CH_OB = 18432, CH_RING = 36864, CH_SLOT = 36864;
__device__ __forceinline__ void gdn_chain(unsigned char* dout, unsigned char* wsx, bf16_t* Pw, int bhd, LAS unsigned char* cb, int wid, int lane) {
    const int d = bhd & 1, hh = (bhd >> 1) & 3, b = bhd >> 3, g = lane >> 4, l15 = lane & 15, w = wid & 3;
    const bool helper = wid >= 4;
    LAS unsigned char* sbuf = cb + CH_SB; LAS unsigned char* obuf = cb + CH_OB; LAS unsigned char* ring = cb + CH_RING;
    bf16_t* Og = Pw + (d == 0 ? C_QG : C_KG) + hh * 64;
#define GDN_BAR() do { asm volatile("s_waitcnt lgkmcnt(0)" ::: "memory"); __builtin_amdgcn_s_barrier(); asm volatile("" ::: "memory"); } while (0)
    if (helper) {
        v4u st[5][8];
#define CH_LOAD(s_, c_) do { if ((c_) < 68) { const unsigned char* blk_ = gdn_item_ptr(dout, wsx, bhd * 68 + (c_)); \
            _Pragma("unroll") for (int k = 0; k < 8; ++k) st[s_][k] = *(const v4u*)(blk_ + (size_t)(k * 256 + w * 64 + lane) * 16); } } while (0)
#define CH_PARK(s_, c_) do { if ((c_) < 68) { LAS unsigned char* sl_ = ring + ((c_) & 1) * CH_SLOT; \
            _Pragma("unroll") for (int k = 0; k < 8; ++k) { const int p = k * 256 + w * 64 + lane; *(LAS v4u*)(sl_ + (p >> 9) * 9216 + ((p >> 3) & 63) * 144 + (p & 7) * 16) = st[s_][k]; } } } while (0)
#define CH_HSTORE(c_) do { _Pragma("unroll") for (int k2 = 0; k2 < 2; ++k2) { const int pc = w * 64 + lane + 256 * k2, row = pc >> 3, seg = pc & 7; \
            const v4u ov = *(const LAS v4u*)(obuf + ((c_) & 1) * 9216 + (row * LS + 8 * seg) * 2); \
            *(v4u*)(Og + (size_t)(b * SEQT + gdn_sp((c_), row, d)) * LDP + 8 * seg) = ov; } } while (0)
        CH_LOAD(0, 0); CH_LOAD(1, 1); CH_LOAD(2, 2); CH_LOAD(3, 3); CH_LOAD(4, 4);
        CH_PARK(0, 0); CH_LOAD(0, 5);
        GDN_BAR();
#pragma unroll 1
        for (int c6 = 0; c6 < 70; c6 += 5) {
#pragma unroll
            for (int u = 0; u < 5; ++u) { const int c = c6 + u;
                if (c < 68) {
                    if (c > 0) CH_HSTORE(c - 1);
                    CH_PARK((u + 1) % 5, c + 1); CH_LOAD((u + 1) % 5, c + 6);
                    GDN_BAR();
                } }
        }
        CH_HSTORE(67);
#undef CH_LOAD
#undef CH_PARK
#undef CH_HSTORE
    } else {
#pragma unroll
        for (int nt = 0; nt < 4; ++nt) *(LAS v2u*)(sbuf + ((16 * nt + l15) * LS + 16 * w + 4 * g) * 2) = (v2u){0u, 0u};
        GDN_BAR();
#pragma unroll 1
        for (int c = 0; c < 68; ++c) {
            const LAS unsigned char* rb = sbuf + (c & 1) * 9216; LAS unsigned char* wb = sbuf + ((c + 1) & 1) * 9216; LAS unsigned char* ob = obuf + (c & 1) * 9216;
            const LAS unsigned char* sl = ring + (c & 1) * CH_SLOT;
            const bf16x8_t aM0 = lds_frag(sl, 16 * w + l15, 8 * g), aM1 = lds_frag(sl, 16 * w + l15, 32 + 8 * g);
            const bf16x8_t aP0 = lds_frag(sl + 9216, 16 * w + l15, 8 * g), aP1 = lds_frag(sl + 9216, 16 * w + l15, 32 + 8 * g);
            f32x4_t Sn[4], Oc[4];
#pragma unroll
            for (int nt = 0; nt < 4; ++nt) {
                const v2u nN = *(const LAS v2u*)(sl + 2 * 9216 + ((16 * nt + l15) * LS + 16 * w + 4 * g) * 2), nQ = *(const LAS v2u*)(sl + 3 * 9216 + ((16 * nt + l15) * LS + 16 * w + 4 * g) * 2);
                const bf16x8_t b0 = lds_frag(rb, 16 * nt + l15, 8 * g), b1 = lds_frag(rb, 16 * nt + l15, 32 + 8 * g);
                Sn[nt] = (f32x4_t){__uint_as_float(nN.x << 16), __uint_as_float(nN.x & 0xffff0000u), __uint_as_float(nN.y << 16), __uint_as_float(nN.y & 0xffff0000u)};
                Oc[nt] = (f32x4_t){__uint_as_float(nQ.x << 16), __uint_as_float(nQ.x & 0xffff0000u), __uint_as_float(nQ.y << 16), __uint_as_float(nQ.y & 0xffff0000u)};
                Sn[nt] = __builtin_amdgcn_mfma_f32_16x16x32_bf16(aM0, b0, Sn[nt], 0, 0, 0); Sn[nt] = __builtin_amdgcn_mfma_f32_16x16x32_bf16(aM1, b1, Sn[nt], 0, 0, 0);
                Oc[nt] = __builtin_amdgcn_mfma_f32_16x16x32_bf16(aP0, b0, Oc[nt], 0, 0, 0); Oc[nt] = __builtin_amdgcn_mfma_f32_16x16x32_bf16(aP1, b1, Oc[nt], 0, 0, 0);
            }
#pragma unroll
            for (int nt = 0; nt < 4; ++nt) { v2u o; o.x = cvtpk(Sn[nt][0], Sn[nt][1]); o.y = cvtpk(Sn[nt][2], Sn[nt][3]); *(LAS v2u*)(wb + ((16 * nt + l15) * LS + 16 * w + 4 * g) * 2) = o; }
#pragma unroll
            for (int nt = 0; nt < 4; ++nt) { const unsigned p01 = cvtpk(Oc[nt][0], Oc[nt][1]), p23 = cvtpk(Oc[nt][2], Oc[nt][3]);
                LAS unsigned char* op = ob + ((16 * w + 4 * g) * LS + 16 * nt + l15) * 2;
                *(LAS bf16_t*)op = (bf16_t)(p01 & 0xffffu); *(LAS bf16_t*)(op + LS * 2) = (bf16_t)(p01 >> 16); *(LAS bf16_t*)(op + 2 * LS * 2) = (bf16_t)(p23 & 0xffffu); *(LAS bf16_t*)(op + 3 * LS * 2) = (bf16_t)(p23 >> 16); }
            GDN_BAR();
        }
    }
#undef GDN_BAR
}

constexpr int R_U = 0, R_A0 = 9216, R_A1 = R_A0 + 16384, R_B0 = R_A1 + 16384, R_B1 = R_B0 + 8192, R_HALF = 58368;
constexpr int R_W = 2 * R_HALF, R_TB = R_W + 4 * 9216;
#ifndef RGP_GATES
#define RGP_GATES 1
#endif
#ifndef RGP_SCAN
#define RGP_SCAN 1
#endif
#ifndef RGP_CONV
#define RGP_CONV 1
#endif
constexpr int RG_ITEMS = NB * 68 * 6;
#define RG_BAR() do { asm volatile("s_waitcnt lgkmcnt(0)" ::: "memory"); __builtin_amdgcn_s_barrier(); asm volatile("" ::: "memory"); } while (0)

__device__ __forceinline__ int opq2(int i) { asm volatile("" : "+s"(i)); return i; }
template <int MODE>
__device__ __forceinline__ void rg_pass(const bf16_t* P, const float* cw, const bf16_t* RGWT, const float* rgtab  ,
                                        float* SUMA, float* SUMH, const float* HIN, bf16_t* F, LAS unsigned char* lds, int wid8  , int bidx, int nblk) {
    const int n = bidx % 6, nwg = (nblk - n + 5) / 6, hq = bidx / 6;
    const int n_iter = (272 + 2 * nwg - 1) / (2 * nwg);
    {   const int tv0 = wid8 * 64 + lane_id_v();
        for (int e = tv0; e < 4 * 512; e += 512) { const int m = e >> 9, row = (e >> 3) & 63, seg = e & 7;
            *(LAS v4u*)(lds + R_W + m * 9216 + (row * LS + 8 * seg) * 2) = *(const v4u*)(RGWT + (size_t)(((m >> 1) * 6 + n) * 2 + (m & 1)) * 4096 + row * 64 + 8 * seg); }
        if (tv0 < 384) { const int d = tv0 / 192, k = (tv0 % 192) >> 6, e = tv0 & 63; ((LAS float*)(lds + R_TB))[tv0] = rgtab[k * 768 + d * 384 + n * 64 + e]; }
    }
    v4u pre[4][2];
#define RG_ITEM_OF(iter_, half_) ((iter_) * 2 * nwg + hq * 2 + (half_))
#define RG_PREFETCH(kp_, tv_) do { const int tc_ = (kp_) % 68, b_ = (kp_) / 68; const int i_ = ((tv_) & 255) >> 2, qd_ = (tv_) & 3, sp_ = tc_ * 64 + i_; \
        const int lo_ = sp_ < CTX ? 0 : CTX, hi_ = sp_ < CTX ? CTX : SEQT; \
        _Pragma("unroll") for (int j = 0; j < 4; ++j) { const int s2_ = sp_ + j - 2; const bool ok_ = (kp_) < 272 && s2_ >= lo_ && s2_ < hi_; \
            const bf16_t* pr_ = P + (size_t)(b_ * SEQT + (ok_ ? s2_ : sp_)) * LDP + C_XA + n * 64 + 16 * qd_; \
            pre[j][0] = ok_ ? *(const v4u*)pr_ : (v4u){0u, 0u, 0u, 0u}; pre[j][1] = ok_ ? *(const v4u*)(pr_ + 8) : (v4u){0u, 0u, 0u, 0u}; } } while (0)
    { const int tv0 = wid8 * 64 + lane_id_v(); RG_PREFETCH(RG_ITEM_OF(0, tv0 >> 8), tv0); }
    RG_BAR();
#pragma unroll 1
    for (int iter = 0; iter < n_iter; ++iter) {
        const int tidf = wid8 * 64 + lane_id_v();
        const int half = __builtin_amdgcn_readfirstlane(tidf >> 8), t256 = tidf & 255, w = __builtin_amdgcn_readfirstlane(t256 >> 6), lane = tidf & 63, g = lane >> 4, l15 = lane & 15;
        LAS unsigned char* hb = lds + half * R_HALF;
        const int kp = RG_ITEM_OF(iter, half);
        const bool valid = kp < 272;
        const int tc = kp % 68, b = kp / 68;
        const int i = t256 >> 2, qd = t256 & 3;
        const int t = b * SEQT + tc * 64 + i;
        TP_BEGIN(8); TP_BEGIN(9);
        _Pragma("unroll 1") for (int rq = 0, nq = opq2(RGP_CONV); rq < nq; ++rq)
        {
            float u[16];
#pragma unroll
            for (int e = 0; e < 16; ++e) u[e] = 0.f;
#pragma unroll
            for (int j = 0; j < 4; ++j) { const float* wr_ = cw + j * CONV_CH + C_XA + n * 64 + 16 * qd;
                const f32x4_t w0 = *(const f32x4_t*)wr_, w1 = *(const f32x4_t*)(wr_ + 4), w2 = *(const f32x4_t*)(wr_ + 8), w3 = *(const f32x4_t*)(wr_ + 12);
                const float wv[16] = {w0[0], w0[1], w0[2], w0[3], w1[0], w1[1], w1[2], w1[3], w2[0], w2[1], w2[2], w2[3], w3[0], w3[1], w3[2], w3[3]};
                const unsigned aw[8] = {pre[j][0].x, pre[j][0].y, pre[j][0].z, pre[j][0].w, pre[j][1].x, pre[j][1].y, pre[j][1].z, pre[j][1].w};
#pragma unroll
                for (int e2 = 0; e2 < 8; ++e2) { u[2 * e2] += wv[2 * e2] * __uint_as_float(aw[e2] << 16); u[2 * e2 + 1] += wv[2 * e2 + 1] * __uint_as_float(aw[e2] & 0xffff0000u); } }
            v4u o0, o1;
            o0.x = cvtpk(u[0], u[1]); o0.y = cvtpk(u[2], u[3]); o0.z = cvtpk(u[4], u[5]); o0.w = cvtpk(u[6], u[7]);
            o1.x = cvtpk(u[8], u[9]); o1.y = cvtpk(u[10], u[11]); o1.z = cvtpk(u[12], u[13]); o1.w = cvtpk(u[14], u[15]);
            *(LAS v4u*)(hb + R_U + (i * LS + 16 * qd) * 2) = o0; *(LAS v4u*)(hb + R_U + (i * LS + 16 * qd + 8) * 2) = o1;
        }
        RG_PREFETCH(RG_ITEM_OF(iter + 1, half), tidf);
        RG_BAR(); if (MODE == 3) { TP_END(9, 9); } TP_BEGIN(10);
        _Pragma("unroll 1") for (int rq = 0, nq = opq2(RGP_GATES); rq < nq; ++rq)
        if (valid) {
            const bf16x8_t a0 = lds_frag(hb + R_U, 16 * w + l15, 8 * g), a1 = lds_frag(hb + R_U, 16 * w + l15, 32 + 8 * g);
            const LAS float* tbl = (const LAS float*)(lds + R_TB);
#pragma unroll
            for (int d = 0; d < 2; ++d) {
                LAS float* Ad = (LAS float*)(hb + (d == 0 ? R_A0 : R_A1)); LAS bf16_t* Bd = (LAS bf16_t*)(hb + (d == 0 ? R_B0 : R_B1));
                const LAS unsigned char* wa_l = lds + R_W + (d * 2) * 9216; const LAS unsigned char* wx_l = wa_l + 9216;
#pragma unroll
                for (int nt = 0; nt < 4; ++nt) {
                    const int e = 16 * nt + l15;
                    f32x4_t ra = {0.f, 0.f, 0.f, 0.f}, ri = {0.f, 0.f, 0.f, 0.f};
                    ra = __builtin_amdgcn_mfma_f32_16x16x32_bf16(a0, lds_frag(wa_l, e, 8 * g), ra, 0, 0, 0); ra = __builtin_amdgcn_mfma_f32_16x16x32_bf16(a1, lds_frag(wa_l, e, 32 + 8 * g), ra, 0, 0, 0);
                    ri = __builtin_amdgcn_mfma_f32_16x16x32_bf16(a0, lds_frag(wx_l, e, 8 * g), ri, 0, 0, 0); ri = __builtin_amdgcn_mfma_f32_16x16x32_bf16(a1, lds_frag(wx_l, e, 32 + 8 * g), ri, 0, 0, 0);
                    const float bav = tbl[d * 192 + e], bxv = tbl[d * 192 + 64 + e], ls8 = tbl[d * 192 + 128 + e];
#pragma unroll
                    for (int r = 0; r < 4; r += 2) {
                        const int tok = 16 * w + 4 * g + r;
                        float av[2], bv[2];
#pragma unroll
                        for (int q = 0; q < 2; ++q) {
                            const float rr = frcp(1.0f + fexp(-(ra[r + q] + bav))), ig = frcp(1.0f + fexp(-(ri[r + q] + bxv)));
                            const float log_a = rr * ls8, y = 2.0f * log_a;
                            const float om = -y * (1.0f + y * (0.5f + y * ((1.0f / 6.0f) + y * ((1.0f / 24.0f) + y * ((1.0f / 120.0f) + y * ((1.0f / 720.0f) + y * (1.0f / 5040.0f)))))));
                            av[q] = fexp(log_a); bv[q] = fsqrt_(om) * ig; }
                        const unsigned bp = cvtpk(bv[0], bv[1]);
                        Ad[tok * 64 + e] = av[0]; Ad[(tok + 1) * 64 + e] = av[1];
                        Bd[tok * 64 + e] = (bf16_t)(bp & 0xffffu); Bd[(tok + 1) * 64 + e] = (bf16_t)(bp >> 16);
                    }
                }
            }
        }
        v4u z0 = {0u, 0u, 0u, 0u}, z1 = z0;
        if (MODE == 3 && valid) { const bf16_t* zp = P + (size_t)t * LDP + C_ZA + n * 64 + 16 * qd; z0 = *(const v4u*)zp; z1 = *(const v4u*)(zp + 8); }
        RG_BAR(); if (MODE == 3) { TP_END(10, 10); } TP_BEGIN(11);
        _Pragma("unroll 1") for (int rq = 0, nq = (MODE == 1 ? opq2(RGP_SCAN) : 1); rq < nq; ++rq)
        if (valid && w < 2) {
            const int d = w;
            const LAS float* Ad = (const LAS float*)(hb + (d == 0 ? R_A0 : R_A1)); LAS bf16_t* Bd = (LAS bf16_t*)(hb + (d == 0 ? R_B0 : R_B1));
            const int ch = n * 64 + lane; const size_t si = ((size_t)(d * NB + b) * 68 + tc) * 384 + ch;
            float h = MODE == 3 ? HIN[si] : 0.f, ap = 1.f;
#pragma unroll 8
            for (int step = 0; step < 64; ++step) { const int tok = d ? 63 - step : step; const float a = Ad[tok * 64 + lane];
                h = a * h + bf2f(Bd[tok * 64 + lane]) * bf2f(*(const LAS bf16_t*)(hb + R_U + (tok * LS + lane) * 2)); if (MODE == 3) Bd[tok * 64 + lane] = (bf16_t)(cvtpk(h, 0.f) & 0xffffu); else ap *= a; }
            if (MODE == 1) { SUMA[si] = ap; SUMH[si] = h; }
        }
        if (MODE == 3) {
            RG_BAR(); TP_END(11, 11);
            if (valid) {
                const LAS bf16_t* B0 = (const LAS bf16_t*)(hb + R_B0); const LAS bf16_t* B1 = (const LAS bf16_t*)(hb + R_B1);
                const unsigned zw[8] = {z0.x, z0.y, z0.z, z0.w, z1.x, z1.y, z1.z, z1.w};
                unsigned ow[8];
#pragma unroll
                for (int e2 = 0; e2 < 8; ++e2) { const int e = 16 * qd + 2 * e2;
                    const float h0 = bf2f(B0[i * 64 + e]) + bf2f(B1[i * 64 + e]), h1 = bf2f(B0[i * 64 + e + 1]) + bf2f(B1[i * 64 + e + 1]);
                    ow[e2] = cvtpk(h0 * siluf_(__uint_as_float(zw[e2] << 16)), h1 * siluf_(__uint_as_float(zw[e2] & 0xffff0000u))); }
                v4u o0 = {ow[0], ow[1], ow[2], ow[3]}, o1 = {ow[4], ow[5], ow[6], ow[7]};
                bf16_t* fp = F + (size_t)t * 1024 + n * 64 + 16 * qd;
                *(v4u*)fp = o0; *(v4u*)(fp + 8) = o1;
            }
        }
        TP_BEGIN(12);
        RG_BAR(); if (MODE == 3) { TP_END(12, 12); TP_END(8, 8); }
    }
#undef RG_PREFETCH
#undef RG_ITEM_OF
}
#undef RG_BAR
__device__ __forceinline__ void rg_carry(const float* SUMA, const float* SUMH, float* HIN, int idx) {
    const int ch = idx % 384, b = (idx / 384) % NB, d = idx / (384 * NB);
    const size_t base = ((size_t)(d * NB + b) * 68) * 384 + ch;
    float h = 0.f;
#pragma unroll 4
    for (int s = 0; s < 68; ++s) { const int tc = d == 0 ? s : (s < 4 ? 3 - s : 71 - s);
        const size_t k = base + (size_t)tc * 384; HIN[k] = h; h = SUMA[k] * h + SUMH[k]; }
}

constexpr int NA_LAT_ITEMS = NB * 6 * 64 * 4, NA_CTX_ITEMS = NB * 6 * 16;
__device__ __forceinline__ void na_mfma_item(const bf16_t* P, const bf16_t* VT, const LAS float* rpbl, bf16_t* F, int item, int lane) {
    const int g = lane >> 4, l15 = lane & 15;
    const bool latent = item < NA_LAT_ITEMS;
    int b, hh, r, qb;
    if (latent) { qb = item & 3; r = (item >> 2) & 63; const int bh = item >> 8; hh = bh % 6; b = bh / 6; }
    else { const int it2 = item - NA_LAT_ITEMS; qb = it2 & 15; const int bh = it2 >> 4; hh = bh % 6; b = bh / 6; r = 0; }
    const int tq = latent ? b * SEQT + CTX + r * 64 + 16 * qb + l15 : b * SEQT + 16 * qb + l15;
    const bf16_t* qp = P + (size_t)tq * LDP + C_QN + hh * 64 + 8 * g;
    const bf16x8_t bq0 = *(const bf16x8_t*)qp, bq1 = *(const bf16x8_t*)(qp + 32);
    const int c0 = qb == 0 ? 0 : (qb == 1 ? 8 : (qb == 2 ? 24 : 32));
    const int r0 = min(max(r - 4, 0), 56), jq = 16 * qb + l15, cs = min(max(jq - 8, 0), 48);
    const int ia = 8 * (l15 >> 2) + (l15 & 3);
    float sc[16][8];
#define NA_TOK0(G_) ((G_) < 8 ? b * SEQT + CTX + (r0 + (G_)) * 64 + c0 : b * SEQT + 32 * ((G_) - 8))
#define NA_QK_BATCH(G0_, NG_) do { bf16x8_t kf[NG_][4]; \
        _Pragma("unroll") for (int q = 0; q < (NG_); ++q) { const bf16_t* ka = P + (size_t)(NA_TOK0((G0_) + q) + ia) * LDP + C_KN + hh * 64 + 8 * g; const bf16_t* kb = ka + 4 * LDP; \
            kf[q][0] = *(const bf16x8_t*)ka; kf[q][1] = *(const bf16x8_t*)(ka + 32); kf[q][2] = *(const bf16x8_t*)kb; kf[q][3] = *(const bf16x8_t*)(kb + 32); } \
        _Pragma("unroll") for (int q = 0; q < (NG_); ++q) { const int G = (G0_) + q; \
            f32x4_t sa = {0.f, 0.f, 0.f, 0.f}, sb = {0.f, 0.f, 0.f, 0.f}; \
            sa = __builtin_amdgcn_mfma_f32_16x16x32_bf16(kf[q][0], bq0, sa, 0, 0, 0); sa = __builtin_amdgcn_mfma_f32_16x16x32_bf16(kf[q][1], bq1, sa, 0, 0, 0); \
            sb = __builtin_amdgcn_mfma_f32_16x16x32_bf16(kf[q][2], bq0, sb, 0, 0, 0); sb = __builtin_amdgcn_mfma_f32_16x16x32_bf16(kf[q][3], bq1, sb, 0, 0, 0); \
            _Pragma("unroll") for (int e = 0; e < 8; ++e) { float v = (e < 4 ? sa[e & 3] : sb[e & 3]) * 0.125f; \
                if (G < 8) { const int kc = c0 + 8 * g + e; const bool ok = kc >= cs && kc < cs + 16; \
                    const float bias = rpbl[hh * 465 + (r0 + G - r + 7) * 31 + (ok ? kc - jq + 15 : 0)]; v = ok ? v + bias : -1e30f; } \
                sc[G][e] = v; } } } while (0)
    if (latent) NA_QK_BATCH(0, 8);
    else {
#pragma unroll
        for (int G = 0; G < 8; ++G)
#pragma unroll
            for (int e = 0; e < 8; ++e) sc[G][e] = -1e30f;
    }
    NA_QK_BATCH(8, 4);
    NA_QK_BATCH(12, 4);
    float m = -1e30f;
#pragma unroll
    for (int G = 0; G < 16; ++G)
#pragma unroll
        for (int e = 0; e < 8; ++e) m = fmaxf(m, sc[G][e]);
    m = fmaxf(m, shx(m, 16)); m = fmaxf(m, shx(m, 32));
    bf16x8_t pf[16]; float lsum = 0.f;
#pragma unroll
    for (int G = 0; G < 16; ++G) { float pv[8];
#pragma unroll
        for (int e = 0; e < 8; ++e) { pv[e] = fexp(sc[G][e] - m); lsum += pv[e]; }
        v4u pk; pk.x = cvtpk(pv[0], pv[1]); pk.y = cvtpk(pv[2], pv[3]); pk.z = cvtpk(pv[4], pv[5]); pk.w = cvtpk(pv[6], pv[7]);
        pf[G] = __builtin_bit_cast(bf16x8_t, pk); }
    f32x4_t o[4];
#pragma unroll
    for (int dt = 0; dt < 4; ++dt) o[dt] = (f32x4_t){0.f, 0.f, 0.f, 0.f};
    const bf16_t* vbase = VT + (size_t)(hh * 64 + l15) * T + 8 * g;
#define NA_PV_BATCH(G0_, NG_) do { bf16x8_t vf[NG_][4]; \
        _Pragma("unroll") for (int q = 0; q < (NG_); ++q) { const int tok0 = NA_TOK0((G0_) + q); \
            _Pragma("unroll") for (int dt = 0; dt < 4; ++dt) vf[q][dt] = *(const bf16x8_t*)(vbase + (size_t)(16 * dt) * T + tok0); } \
        _Pragma("unroll") for (int q = 0; q < (NG_); ++q) { _Pragma("unroll") for (int dt = 0; dt < 4; ++dt) o[dt] = __builtin_amdgcn_mfma_f32_16x16x32_bf16(vf[q][dt], pf[(G0_) + q], o[dt], 0, 0, 0); } } while (0)
    if (latent) NA_PV_BATCH(0, 8);
    NA_PV_BATCH(8, 8);
#undef NA_TOK0
#undef NA_QK_BATCH
#undef NA_PV_BATCH
    lsum += shx(lsum, 16); lsum += shx(lsum, 32);
    const float inv = frcp(lsum);
#pragma unroll
    for (int dt = 0; dt < 4; ++dt) {
        const v2u zr = *(const v2u*)(P + (size_t)tq * LDP + C_ZN + hh * 64 + 16 * dt + 4 * g);
        const float z0 = __uint_as_float(zr.x << 16), z1 = __uint_as_float(zr.x & 0xffff0000u), z2 = __uint_as_float(zr.y << 16), z3 = __uint_as_float(zr.y & 0xffff0000u);
        v2u ov; ov.x = cvtpk(o[dt][0] * inv * siluf_(z0), o[dt][1] * inv * siluf_(z1)); ov.y = cvtpk(o[dt][2] * inv * siluf_(z2), o[dt][3] * inv * siluf_(z3));
        *(v2u*)(F + (size_t)tq * 1024 + 384 + hh * 64 + 16 * dt + 4 * g) = ov;
    }
}
constexpr int NAW_K = 12288, NAW_KROW = 144, NAW_VROW = 1680, NAW_ITEMW = 12032;
constexpr int NAW_LAT = NB * 6 * 32, NAW_CTX = NB * 6 * 2;
__device__ __forceinline__ void na_wg_item(const bf16_t* P, const bf16_t* VT, LAS unsigned char* lds, bf16_t* F, int item, int wid, int lane) {
    const LAS float* rpbl = (const LAS float*)lds;
    const int g = lane >> 4, l15 = lane & 15, tid = wid * 64 + lane;
    const bool latent = item < NAW_LAT;
    int b, hh, rp;
    if (latent) { rp = item & 31; const int bh = item >> 5; hh = bh % 6; b = bh / 6; } else { const int it2 = item - NAW_LAT; rp = it2 & 1; const int bh = it2 >> 1; hh = bh % 6; b = bh / 6; }
    const int r = latent ? 2 * rp + (wid >> 2) : 0, qb = latent ? (wid & 3) : 8 * rp + wid;
    const int R0 = min(max(2 * rp - 4, 0), 56);
    const int tq = latent ? b * SEQT + CTX + r * 64 + 16 * qb + l15 : b * SEQT + 16 * qb + l15;
    const bf16_t* qp = P + (size_t)tq * LDP + C_QN + hh * 64 + 8 * g;
    const bf16x8_t bq0 = *(const bf16x8_t*)qp, bq1 = *(const bf16x8_t*)(qp + 32);
    LAS unsigned char* kreg = lds + NAW_K;
    {   v4u kr[13];
#pragma unroll
        for (int k = 0; k < 13; ++k) { const int p = tid + 512 * k, key = p >> 3, seg = p & 7;
            const int tok = key < 576 ? b * SEQT + CTX + min(R0 + (key >> 6), 63) * 64 + (key & 63) : b * SEQT + (key - 576);
            kr[k] = (latent || key >= 576) ? *(const v4u*)(P + (size_t)tok * LDP + C_KN + hh * 64 + 8 * seg) : (v4u){0u, 0u, 0u, 0u}; }
#pragma unroll
        for (int k = 0; k < 13; ++k) { const int p = tid + 512 * k, key = p >> 3, seg = p & 7; *(LAS v4u*)(kreg + key * NAW_KROW + seg * 16) = kr[k]; }
    }
    __syncthreads();
    const int c0 = (qb & 3) == 0 ? 0 : ((qb & 3) == 1 ? 8 : ((qb & 3) == 2 ? 24 : 32));
    const int r0 = min(max(r - 4, 0), 56), jq = 16 * (qb & 3) + l15, cs = min(max(jq - 8, 0), 48);
    const int ia = 8 * (l15 >> 2) + (l15 & 3);
    float sc[16][8];
#define NAW_KEY0(G_) ((G_) < 8 ? (r0 - R0 + (G_)) * 64 + c0 : 576 + 32 * ((G_) - 8))
#pragma unroll
    for (int G = 0; G < 16; ++G) {
        if (G < 8 && !latent) {
#pragma unroll
            for (int e = 0; e < 8; ++e) sc[G][e] = -1e30f;
            continue; }
        const LAS unsigned char* ka = kreg + (NAW_KEY0(G) + ia) * NAW_KROW + 16 * g; const LAS unsigned char* kb = ka + 4 * NAW_KROW;
        const bf16x8_t aa0 = *(const LAS bf16x8_t*)ka, aa1 = *(const LAS bf16x8_t*)(ka + 64), ab0 = *(const LAS bf16x8_t*)kb, ab1 = *(const LAS bf16x8_t*)(kb + 64);
        f32x4_t sa = {0.f, 0.f, 0.f, 0.f}, sb = {0.f, 0.f, 0.f, 0.f};
        sa = __builtin_amdgcn_mfma_f32_16x16x32_bf16(aa0, bq0, sa, 0, 0, 0); sa = __builtin_amdgcn_mfma_f32_16x16x32_bf16(aa1, bq1, sa, 0, 0, 0);
        sb = __builtin_amdgcn_mfma_f32_16x16x32_bf16(ab0, bq0, sb, 0, 0, 0); sb = __builtin_amdgcn_mfma_f32_16x16x32_bf16(ab1, bq1, sb, 0, 0, 0);
#pragma unroll
        for (int e = 0; e < 8; ++e) {
            float v = (e < 4 ? sa[e & 3] : sb[e & 3]) * 0.125f;
            if (G < 8) { const int kc = c0 + 8 * g + e; const bool ok = kc >= cs && kc < cs + 16;
                const float bias = rpbl[hh * 465 + (r0 + G - r + 7) * 31 + (ok ? kc - jq + 15 : 0)]; v = ok ? v + bias : -1e30f; }
            sc[G][e] = v;
        }
    }
    v4u vr[13];
#define NAW_VLOAD(k0_, k1_) do { _Pragma("unroll") for (int k = (k0_); k < (k1_); ++k) { const int p = tid + 512 * k, dim = p / 104, q = p - dim * 104; \
        const bf16_t* src = VT + (size_t)(hh * 64 + dim) * T + (q < 72 ? b * SEQT + CTX + min(R0 + (q >> 3), 63) * 64 + (q & 7) * 8 : b * SEQT + (q - 72) * 8); \
        vr[k] = (latent || q >= 72) ? *(const v4u*)src : (v4u){0u, 0u, 0u, 0u}; } } while (0)
    NAW_VLOAD(0, 5);
    float m = -1e30f;
#pragma unroll
    for (int G = 0; G < 16; ++G)
#pragma unroll
        for (int e = 0; e < 8; ++e) m = fmaxf(m, sc[G][e]);
    m = fmaxf(m, shx(m, 16)); m = fmaxf(m, shx(m, 32));
    bf16x8_t pf[16]; float lsum = 0.f;
#pragma unroll
    for (int G = 0; G < 16; ++G) { float pv[8];
#pragma unroll
        for (int e = 0; e < 8; ++e) { pv[e] = fexp(sc[G][e] - m); lsum += pv[e]; }
        v4u pk; pk.x = cvtpk(pv[0], pv[1]); pk.y = cvtpk(pv[2], pv[3]); pk.z = cvtpk(pv[4], pv[5]); pk.w = cvtpk(pv[6], pv[7]);
        pf[G] = __builtin_bit_cast(bf16x8_t, pk); }
    NAW_VLOAD(5, 13);
#undef NAW_VLOAD
    __syncthreads();
#pragma unroll
    for (int k = 0; k < 13; ++k) { const int p = tid + 512 * k, dim = p / 104, q = p - dim * 104; const int key = q < 72 ? (q >> 3) * 64 + (q & 7) * 8 : 576 + (q - 72) * 8;
        *(LAS v4u*)(kreg + dim * NAW_VROW + key * 2) = vr[k]; }
    __syncthreads();
    f32x4_t o[4];
#pragma unroll
    for (int dt = 0; dt < 4; ++dt) o[dt] = (f32x4_t){0.f, 0.f, 0.f, 0.f};
#pragma unroll
    for (int G = 0; G < 16; ++G) {
        if (G < 8 && !latent) continue;
        const LAS unsigned char* vb = kreg + l15 * NAW_VROW + (NAW_KEY0(G) + 8 * g) * 2;
#pragma unroll
        for (int dt = 0; dt < 4; ++dt) o[dt] = __builtin_amdgcn_mfma_f32_16x16x32_bf16(*(const LAS bf16x8_t*)(vb + 16 * dt * NAW_VROW), pf[G], o[dt], 0, 0, 0);
    }
#undef NAW_KEY0
    lsum += shx(lsum, 16); lsum += shx(lsum, 32);
    const float inv = frcp(lsum);
    int tq2 = tq; asm volatile("" : "+v"(tq2));
#pragma unroll
    for (int dt = 0; dt < 4; ++dt) {
        const v2u zr = *(const v2u*)(P + (size_t)tq2 * LDP + C_ZN + hh * 64 + 16 * dt + 4 * g);
        const float z0 = __uint_as_float(zr.x << 16), z1 = __uint_as_float(zr.x & 0xffff0000u), z2 = __uint_as_float(zr.y << 16), z3 = __uint_as_float(zr.y & 0xffff0000u);
        v2u ov; ov.x = cvtpk(o[dt][0] * inv * siluf_(z0), o[dt][1] * inv * siluf_(z1)); ov.y = cvtpk(o[dt][2] * inv * siluf_(z2), o[dt][3] * inv * siluf_(z3));
        *(v2u*)(F + (size_t)tq2 * 1024 + 384 + hh * 64 + 16 * dt + 4 * g) = ov;
    }
    __syncthreads();
}
__device__ __forceinline__ void vt_transpose(const bf16_t* P, bf16_t* VT, LAS unsigned char* scr, int gw, int NGW, int lane) {
    for (int it = gw; it < NB * 68 * 6; it += NGW) {
        const int hh = it % 6, tcb = it / 6, t0 = (tcb / 68) * SEQT + (tcb % 68) * 64;
        const bf16_t* src = P + (size_t)(t0 + lane) * LDP + C_VN + hh * 64;
#pragma unroll
        for (int q8 = 0; q8 < 8; ++q8) *(LAS v4u*)(scr + (lane * LS + 8 * q8) * 2) = *(const v4u*)(src + 8 * q8);
        LDS_WAIT();
        bf16_t* dst = VT + (size_t)(hh * 64 + lane) * T + t0;
#pragma unroll
        for (int q8 = 0; q8 < 8; ++q8) { unsigned w4[4];
#pragma unroll
            for (int e2 = 0; e2 < 4; ++e2) { const unsigned lo = *(const LAS bf16_t*)(scr + ((8 * q8 + 2 * e2) * LS + lane) * 2), hi = *(const LAS bf16_t*)(scr + ((8 * q8 + 2 * e2 + 1) * LS + lane) * 2); w4[e2] = lo | (hi << 16); }
            v4u o = {w4[0], w4[1], w4[2], w4[3]}; *(v4u*)(dst + 8 * q8) = o; }
        LDS_WAIT();
    }
}
#define XB_TMO      128
#define XB_XCNT(j)  (256  + 64 * (j))
#define XB_XSUB(j)  (1280 + 64 * (j))
#define XB_XGEN(j)  (2304 + 64 * (j))
#define XB_TOP      3328
#define XB_TOPGEN   3392
#define XCD_BAR_WORDS 3456
#define XB_SPIN_CAP (1u << 18)

__device__ __forceinline__ unsigned xb_ld(unsigned* p)              { return __hip_atomic_load(p, __ATOMIC_RELAXED, __HIP_MEMORY_SCOPE_AGENT); }
__device__ __forceinline__ unsigned xb_add(unsigned* p, unsigned v) { return __hip_atomic_fetch_add(p, v, __ATOMIC_RELAXED, __HIP_MEMORY_SCOPE_AGENT); }
__device__ __forceinline__ unsigned xb_xcc_id() { return (unsigned)__builtin_amdgcn_s_getreg((3 << 11) | 20) & 0xFu; }
#define XB_SPIN(cond, bar) do { unsigned _sp = 0; while (cond) { __builtin_amdgcn_s_sleep(1); \
    if ((++_sp & 255u) == 0u) { if (xb_ld(&(bar)[XB_TMO])) break; if (_sp > XB_SPIN_CAP) { atomicAdd(&(bar)[XB_TMO], 1u); break; } } } } while (0)

struct XcdBarrier {
    unsigned* bar; unsigned x;
    volatile LAS unsigned* st;
};

__device__ __forceinline__ XcdBarrier xcd_barrier_post(unsigned* bar, volatile LAS unsigned* st) {
    XcdBarrier b; b.bar = bar; b.x = xb_xcc_id(); b.st = st;
    if (threadIdx.x == 0) (void)xb_add(&bar[XB_XCNT(b.x)], 1u);
    return b;
}
__device__ __forceinline__ void xcd_barrier_complete(unsigned* bar, unsigned x, unsigned& nloc, unsigned& nx) {
    const unsigned G = gridDim.x * gridDim.y * gridDim.z;
    unsigned sum, cnt, mine, sp = 0u;
    for (;;) {
        sum = 0u; cnt = 0u; mine = 0u;
#pragma unroll
        for (unsigned j = 0; j < 16; ++j) { const unsigned c = xb_ld(&bar[XB_XCNT(j)]); sum += c; cnt += (c > 0u) ? 1u : 0u; mine = (j == x) ? c : mine; }
        if (sum == G) break;
        __builtin_amdgcn_s_sleep(1);
        if ((++sp & 255u) == 0u) { if (xb_ld(&bar[XB_TMO])) break; if (sp > XB_SPIN_CAP) { atomicAdd(&bar[XB_TMO], 1u); break; } }
    }
    nloc = mine > 0u ? mine : 1u; nx = cnt > 0u ? cnt : 1u;
}

__device__ __forceinline__ void xcd_barrier(const XcdBarrier& b) {
    asm volatile("s_waitcnt vmcnt(0)" ::: "memory");
    __syncthreads();
    if (threadIdx.x == 0) {
        unsigned* bar = b.bar;
        __builtin_amdgcn_s_waitcnt(0);
        unsigned nloc = b.st[0], nx = b.st[1];
        if (nloc == 0u) { xcd_barrier_complete(bar, b.x, nloc, nx); b.st[0] = nloc; b.st[1] = nx; }
        const unsigned old = xb_add(&bar[XB_XSUB(b.x)], 1u);
        const unsigned gen = old / nloc;
        if (old + 1u == (gen + 1u) * nloc) {
            __builtin_amdgcn_fence(__ATOMIC_RELEASE, "agent");
            asm volatile("s_waitcnt vmcnt(0)" ::: "memory");
            const unsigned og = xb_add(&bar[XB_TOP], 1u);
            const unsigned tg = og / nx;
            if (og + 1u == (tg + 1u) * nx) xb_add(&bar[XB_TOPGEN], 1u);
            else XB_SPIN(xb_ld(&bar[XB_TOPGEN]) == tg, bar);
            __builtin_amdgcn_fence(__ATOMIC_ACQUIRE, "agent");
            xb_add(&bar[XB_XGEN(b.x)], 1u);
            asm volatile("s_waitcnt vmcnt(0)" ::: "memory");
        } else {
            XB_SPIN(xb_ld(&bar[XB_XGEN(b.x)]) == gen, bar);
            __builtin_amdgcn_fence(__ATOMIC_ACQUIRE, "agent");
            asm volatile("s_waitcnt vmcnt(0)" ::: "memory");
        }
    }
    __syncthreads();
}


#ifndef REP_P2A
#define REP_P2A 1
#endif
#ifndef REP_P2B
#define REP_P2B 1
#endif
#ifndef REP_CH
#define REP_CH 1
#endif
#ifndef REP_NA
#define REP_NA 1
#endif
#ifndef REP_GDN1
#define REP_GDN1 1
#endif
#ifndef REP_RG1
#define REP_RG1 1
#endif
#ifndef REP_VT
#define REP_VT 1
#endif
#ifndef REP_COMB
#define REP_COMB 1
#endif
#ifndef REP_RG3
#define REP_RG3 1
#endif
#ifndef REP_G2
#define REP_G2 1
#endif
#ifndef REP_P5
#define REP_P5 1
#endif
#ifndef REP_P3
#define REP_P3 1
#endif
#ifndef REP_G1
#define REP_G1 1
#endif
#ifndef REP_SYNC
#define REP_SYNC 1
#endif
#ifdef PHPROBE
#define PH_MARK(id_) do { if (bid == 0 && threadIdx.x == 0) { const unsigned long long now_ = __builtin_amdgcn_s_memrealtime(); LAS unsigned long long* ph_ = (LAS unsigned long long*)(lds + LDS_BAR_OFF + 64); ph_[16 + (id_)] += now_ - ph_[15]; ph_[15] = now_; } } while (0)
#else
#define PH_MARK(id_) do {} while (0)
#endif
#define GSYNC() do { _Pragma("unroll 1") for (int rs_ = 0, nrs_ = opq(REP_SYNC); rs_ < nrs_; ++rs_) { XcdBarrier xb_; xb_.bar = (unsigned*)(WSB + WS_BAR); xb_.x = xb_xcc_id(); xb_.st = (volatile LAS unsigned*)(lds + LDS_BAR_OFF); xcd_barrier(xb_); } } while (0)
__device__ __forceinline__ int opq(int i) { asm volatile("" : "+s"(i)); return i; }
#define IN(i) ((const float*)p.ptr[opq(i)])
#define WSB ((unsigned char*)p.ptr[opq(21)])
#define OUTP ((float*)p.ptr[opq(20)])
#define ctl ((unsigned*)(WSB + WS_CTL))
#define mod ((float*)(WSB + WS_MOD))
#define WTIN ((bf16_t*)(WSB + WS_WTIN))
#define WTOUT ((bf16_t*)(WSB + WS_WTOUT))
#define X ((float*)(WSB + WS_X))
#define UF ((bf16_t*)(WSB + WS_UF))
#define P ((bf16_t*)(WSB + WS_P))
#define gdn0 ((unsigned char*)OUTP)
#define gdnx (WSB + WS_GDNX)
#define VT ((bf16_t*)(WSB + WS_VT))
#define rcos ((float*)(WSB + WS_ROPE))
#define rsin ((float*)(WSB + WS_ROPE) + 1024)
#define RGWT ((bf16_t*)(WSB + WS_RGWT))
#define rgtab ((float*)(WSB + WS_RGTAB))
#define SUMA ((float*)(WSB + WS_RGS))
#define SUMH ((float*)(WSB + WS_RGS) + (1 << 18))
#define HIN ((float*)(WSB + WS_RGS) + (2 << 18))
__device__ __forceinline__ int fresh_v(int v) { asm volatile("" : "+v"(v)); return v; }
__device__ __forceinline__ int lane_now() { int l; asm volatile("v_mbcnt_lo_u32_b32 %0, -1, 0\n\tv_mbcnt_hi_u32_b32 %0, -1, %0" : "=v"(l)); return l; }
enum { I_X = 0, I_C, I_CTX, I_CCTX, I_WMOD, I_BMOD, I_WIN, I_CONVW, I_RGWA, I_RGBA, I_RGWX, I_RGBX, I_RGLAM, I_RPB, I_ALOG, I_DTB, I_NW, I_WOUT, I_LNG, I_LNB };
__global__ void __launch_bounds__(512, 2) mega_fwd(Params p) {
    extern __shared__ __attribute__((aligned(16))) unsigned char lds_raw[];
    LAS unsigned char* lds = (LAS unsigned char*)lds_raw;
    cg::grid_group grid = cg::this_grid();
    const int bid = (int)blockIdx.x; __builtin_assume(bid >= 0 && bid < 256);
    const int wid = __builtin_amdgcn_readfirstlane((int)threadIdx.x >> 6);
#define lane0 lane_now()
#define tid (wid * 64 + lane_now())
#define BIDL opq(bid)
#define WIDL opq(wid)
    const int gw0 = bid * 8 + wid, NGW = 2048;
    if (threadIdx.x < 2) ((volatile LAS unsigned*)(lds + LDS_BAR_OFF))[threadIdx.x] = 0u;
#if defined(TPROBE) || defined(PHPROBE)
    if (threadIdx.x < 64) ((volatile LAS unsigned*)(lds + LDS_BAR_OFF + 64))[threadIdx.x] = 0u;
#endif
    __syncthreads();
    (void)xcd_barrier_post((unsigned*)(WSB + WS_BAR), (volatile LAS unsigned*)(lds + LDS_BAR_OFF));
#ifdef PHPROBE
    if (bid == 0 && threadIdx.x == 0) ((LAS unsigned long long*)(lds + LDS_BAR_OFF + 64))[15] = __builtin_amdgcn_s_memrealtime();
#endif
    const int gw = gw0;
    LAS float* wscr = (LAS float*)(lds + wid * 16384);
    { const int lane = lane_now();

    phase_mods(IN(I_C), IN(I_CCTX), IN(I_WMOD), IN(I_BMOD), mod, (LAS float*)lds, wid, lane);
    convert_weights(IN(I_WIN), IN(I_WOUT), WTIN, WTOUT, wscr, gw, NGW, lane);
    convert_rg(IN(I_RGWA), IN(I_RGBA), IN(I_RGWX), IN(I_RGBX), IN(I_RGLAM), RGWT, rgtab, (int)blockIdx.x * 512 + tid, (int)gridDim.x * 512);
    if (blockIdx.x == 0) { for (int e = tid; e < 1024; e += 512) { const float ang = (float)(e >> 4) * expf(-(float)(e & 15) * (9.210340371976184f / 16.0f)); rcos[e] = cosf(ang); rsin[e] = sinf(ang); } }
    grid.sync(); PH_MARK(0);
    prep_rows0(IN(I_X), IN(I_CTX), mod, UF, gw, NGW, lane);
    }
    GSYNC(); PH_MARK(1);
#pragma unroll 1
    for (int l = 0; l < DEPTH; ++l) {
        const float* modl = mod + (size_t)l * 5 * 3072;
        { pg8::Gemm g{UF, WTIN, T, NPAD, D}; pg8::StaticOrder S; S.init(T, NPAD, 256, BIDL);
          pg8::EpiP E{P};
          _Pragma("unroll 1") for (int rp = 0, nrp = opq(REP_G1); rp < nrp; ++rp)
          pg8::gemm_phase<pg8::EpiP, pg8::StaticOrder, true, true>(lds, g, S, E, WIDL * 64 + lane_now());
        }
        GSYNC(); PH_MARK(2);
        _Pragma("unroll 1") for (int rp = 0, nrp = opq(REP_P2A); rp < nrp; ++rp) {
#ifndef ABL_P1
        _Pragma("unroll 1") for (int r2 = 0, n2 = opq(REP_GDN1); r2 < n2; ++r2)
        gdn_pass1(P, IN(I_CONVW) + (size_t)l * 4 * CONV_CH, IN(I_ALOG) + l * 8, IN(I_DTB) + l * 8, rcos, rsin, gdn0, gdnx, lds, WIDL, BIDL, opq(256));
#endif
        _Pragma("unroll 1") for (int r2 = 0, n2 = opq(REP_RG1); r2 < n2; ++r2)
        rg_pass<1>(P, IN(I_CONVW) + (size_t)l * 4 * CONV_CH, RGWT, rgtab, SUMA, SUMH, nullptr, nullptr, lds, WIDL, BIDL, opq(256));
        _Pragma("unroll 1") for (int r2 = 0, n2 = opq(REP_VT); r2 < n2; ++r2)
        vt_transpose(P, VT, lds + WIDL * 16384, (BIDL * 8 + WIDL), NGW, fresh_v(lane0));
        __syncthreads(); }
        GSYNC(); PH_MARK(3);
        _Pragma("unroll 1") for (int rp = 0, nrp = opq(REP_P2B); rp < nrp; ++rp) { const int lane = fresh_v(lane0); const int bx = BIDL;
            const float* rpb = IN(I_RPB) + (size_t)l * 6 * 15 * 31;
            for (int e = (WIDL * 64 + lane_now()); e < 6 * 465; e += 512) ((LAS float*)lds)[e] = rpb[e];
            __syncthreads();
#ifndef ABL_CH
            if (bx < 32) _Pragma("unroll 1") for (int r2 = 0, n2 = opq(REP_CH); r2 < n2; ++r2) gdn_chain(gdn0, gdnx, P, bx, lds + 12288, WIDL, lane);
#endif
            if (bx >= 32 && bx < 38) rg_carry(SUMA, SUMH, HIN, (bx - 32) * 512 + (WIDL * 64 + lane_now()));
            __syncthreads();
            const int n_items = NAW_LAT + (l < DEPTH - 1 ? NAW_CTX : 0);
            _Pragma("unroll 1") for (int r3 = 0, n3 = opq(REP_NA); r3 < n3; ++r3) {
            unsigned* cnt = ctl + 64 * (l + 1) + 16 * rp + 8 * r3;
            for (;;) {
                if ((WIDL * 64 + lane_now()) == 0) *(LAS int*)(lds + NAW_ITEMW) = (int)__hip_atomic_fetch_add(cnt, 1u, __ATOMIC_RELAXED, __HIP_MEMORY_SCOPE_AGENT);
                __syncthreads();
                const int it = __builtin_amdgcn_readfirstlane(*(const LAS int*)(lds + NAW_ITEMW));
                if (it >= n_items) break;
                na_wg_item(P, VT, lds, UF, it, WIDL, lane_now());
            } }
            __syncthreads();
        }
        GSYNC(); PH_MARK(4);
        _Pragma("unroll 1") for (int rp = 0, nrp = opq(REP_P3); rp < nrp; ++rp) {
        _Pragma("unroll 1") for (int r2 = 0, n2 = opq(REP_RG3); r2 < n2; ++r2)
        rg_pass<3>(P, IN(I_CONVW) + (size_t)l * 4 * CONV_CH, RGWT, rgtab, nullptr, nullptr, HIN, UF, lds, WIDL, BIDL, opq(256));
        { const int lane = fresh_v(lane0); const int gw = (BIDL * 8 + WIDL); _Pragma("unroll 1") for (int r2 = 0, n2 = opq(REP_COMB); r2 < n2; ++r2) combine_rows(P, IN(I_NW) + l * 64, UF, gw, NGW, lane); } }
        GSYNC(); PH_MARK(5);
        { pg8::Gemm g{UF, WTOUT, T, D, D};
          pg8::EpiZ E{IN(I_X), IN(I_CTX), X, X, modl, l == 0 ? 1 : 0};
          if (l < DEPTH - 1) { pg8::StaticOrder S; S.init(T, D, 256, BIDL); pg8::gemm_phase<pg8::EpiZ, pg8::StaticOrder, true, true>(lds, g, S, E, WIDL * 64 + lane_now()); }
          else { pg8::LatOrder S{BIDL}; pg8::gemm_phase<pg8::EpiZ, pg8::LatOrder, false, true>(lds, g, S, E, WIDL * 64 + lane_now()); }
        }
        GSYNC(); PH_MARK(6);
        if (l < DEPTH - 1) { const int lane = fresh_v(lane0); const int gw = (BIDL * 8 + WIDL);
            if (opq(REP_P5) > 1) { ln_rows(X, (float*)P, IN(I_LNG) + l * D, IN(I_LNB) + l * D, nullptr, mod + (size_t)(l + 1) * 5 * 3072, (bf16_t*)((unsigned char*)P + 72 * MiB), gw, NGW, lane);
                convert_weights(IN(I_WIN) + (size_t)(l + 1) * D * DIN, IN(I_WOUT) + (size_t)(l + 1) * D * D, WTIN, WTOUT, (LAS float*)(lds + WIDL * 16384), gw, NGW, lane); }
            ln_rows(X, X, IN(I_LNG) + l * D, IN(I_LNB) + l * D, nullptr, mod + (size_t)(l + 1) * 5 * 3072, UF, gw, NGW, lane);
            convert_weights(IN(I_WIN) + (size_t)(l + 1) * D * DIN, IN(I_WOUT) + (size_t)(l + 1) * D * D, WTIN, WTOUT, (LAS float*)(lds + WIDL * 16384), gw, NGW, lane);
            convert_rg(IN(I_RGWA) + (size_t)(l + 1) * 49152, IN(I_RGBA) + (l + 1) * 768, IN(I_RGWX) + (size_t)(l + 1) * 49152, IN(I_RGBX) + (l + 1) * 768, IN(I_RGLAM) + (l + 1) * 768, RGWT, rgtab, BIDL * 512 + (WIDL * 64 + lane_now()), opq(256) * 512);
            GSYNC(); PH_MARK(7);
        } else { const int lane = fresh_v(lane0); const int gw = (BIDL * 8 + WIDL); ln_rows(X, X, IN(I_LNG) + l * D, IN(I_LNB) + l * D, OUTP, nullptr, nullptr, gw, NGW, lane); }
    }
#ifdef PHPROBE
    GSYNC(); PH_MARK(7);
    if (bid == 0 && threadIdx.x == 0) { const LAS unsigned long long* ph = (const LAS unsigned long long*)(lds + LDS_BAR_OFF + 64); OUTP[0] = 0.01f * (float)ph[16 + PHPROBE]; }
#endif
#ifdef TPROBE
#ifndef TPBASE
#define TPBASE 0
#endif
    GSYNC();
    if (bid == 0 && threadIdx.x == 0) { const LAS unsigned long long* tp = (const LAS unsigned long long*)(lds + LDS_BAR_OFF + 64);
        OUTP[0] = 1000.0f * (float)tp[TPROBE] / (float)tp[TPBASE]; }
#endif
}
#undef ctl
#undef mod
#undef WTIN
#undef WTOUT
#undef X
#undef UF
#undef P
#undef gdn0
#undef gdnx
#undef VT
#undef rcos
#undef rsin
#undef RGWT
#undef rgtab
#undef SUMA
#undef SUMH
#undef HIN
#undef lane0
#undef BIDL
#undef WIDL
#undef tid
}

extern "C" void kernel_launch(void* const* d_in, const int* in_sizes, int n_in, void* d_out, int out_size, void* d_ws, size_t ws_size, hipStream_t stream) {
    static int grid = 0;
    if (grid == 0) {
        if (n_in != 20 || ws_size < WS_END) { fprintf(stderr, "kernel_launch: unexpected n_in %d / ws_size %zu\n", n_in, ws_size); grid = -1; return; }
        int dev = 0, cus = 0, per_cu = 0;
        hipGetDevice(&dev);
        hipDeviceGetAttribute(&cus, hipDeviceAttributeMultiprocessorCount, dev);
        if (hipFuncSetAttribute((const void*)mega_fwd, hipFuncAttributeMaxDynamicSharedMemorySize, LDS_BYTES) != hipSuccess) { fprintf(stderr, "kernel_launch: hipFuncSetAttribute failed\n"); grid = -1; return; }
        if (hipOccupancyMaxActiveBlocksPerMultiprocessor(&per_cu, (const void*)mega_fwd, 512, LDS_BYTES) != hipSuccess || per_cu < 1) { fprintf(stderr, "kernel_launch: occupancy query gave %d\n", per_cu); per_cu = 1; }
        (void)hipGetLastError();
        grid = 256;
        if (cus < 256) { fprintf(stderr, "kernel_launch: needs 256 CUs, device has %d\n", cus); grid = -1; return; }
        fprintf(stderr, "kernel_launch: cus %d per_cu %d grid %d\n", cus, per_cu, grid);
    }
    if (grid < 0) return;
    hipMemsetAsync((char*)d_ws + WS_CTL, 0, CTL_ZERO_BYTES, stream);
    Params prm{};
    for (int i = 0; i < 20; ++i) prm.ptr[i] = d_in[i];
    prm.ptr[20] = d_out; prm.ptr[21] = d_ws;
    void* args[] = {&prm};
    hipError_t e = hipLaunchCooperativeKernel((const void*)mega_fwd, dim3(grid), dim3(512), args, LDS_BYTES, stream);
    if (e != hipSuccess) fprintf(stderr, "cooperative launch failed: %s (grid %d)\n", hipGetErrorString(e), grid);
}
```

```cpp
#include <hip/hip_runtime.h>
#include <hip/hip_cooperative_groups.h>
#include <cstdio>
#include <cstdint>
namespace cg = cooperative_groups;

namespace {
constexpr int D = 1024, NB = 4, SEQ = 4096, DEPTH = 4, CTX = 256;
constexpr int SEQT = CTX + SEQ;
constexpr int T = NB * SEQT;
constexpr int DIN = 3344, LDP = 3360, NPAD = 3584;
constexpr int CONV_CH = 1152;
constexpr int C_XA = 0, C_QG = 384, C_KG = 640, C_VG = 896, C_ZA = 1152, C_QN = 1536, C_KN = 1920, C_VN = 2304,
              C_ZN = 2688, C_ZG = 3072, C_BR = 3328, C_AR = 3336;
constexpr float ALPHA = 1.681792830507429f;
}
namespace pg8 {
#define PG8_LAS __attribute__((address_space(3)))
typedef unsigned short bf16_t;
typedef short bf16x8 __attribute__((ext_vector_type(8)));
typedef float f32x4 __attribute__((ext_vector_type(4)));
typedef unsigned u32x4 __attribute__((ext_vector_type(4)));
constexpr int BM = 256, BK = 64, HALF = 128, HTB = HALF * BK * 2  , STAGE_BYTES = 8 * HTB, NXCD = 8, WGM = 8;

__host__ __device__ __forceinline__ int lds_byte(int r, int c) { const int st = (r >> 4) * 2 + (c >> 5), rr = r & 15, cc = c & 31, ob = rr * 64 + cc * 2; return st * 1024 + (ob ^ (((ob >> 9) & 1) << 5)); }
__host__ __device__ __forceinline__ void stage_rc(int b, int& R, int& C) { const int st = b / 1024, sb = b % 1024, swz = sb ^ (((sb >> 9) & 1) << 5); R = (st >> 1) * 16 + swz / 64; C = (st & 1) * 32 + (swz % 64) / 2; }
__host__ __device__ __forceinline__ int perm32(int rho) { const int n = rho >> 4, i = rho & 15; return 8 * (i >> 2) + 4 * n + (i & 3); }

struct Unit { int pm, pn; };
struct Gemm { const bf16_t* A; const bf16_t* Bt; int M, N, K; };

struct StaticOrder {
    int nM, nN, nwg, G, c;
    __host__ __device__ void init(int M, int N, int G_, int c_) { nM = M / BM; nN = N / BM; nwg = nM * nN; G = G_; c = c_; }
    __host__ __device__ bool next(int i, Unit& u) const {
        const long L = (long)i * G + c; if (L >= nwg) return false;
        int wgid = (int)L; { const int q = nwg / NXCD, r = nwg % NXCD, xcd = wgid % NXCD, off = wgid / NXCD; wgid = (xcd < r ? xcd * (q + 1) : r * (q + 1) + (xcd - r) * q) + off; }
        const int nig = WGM * nN, gid = wgid / nig, fm = gid * WGM, gsz = (nM - fm) < WGM ? (nM - fm) : WGM;
        u.pm = fm + ((wgid % nig) % gsz); u.pn = (wgid % nig) / gsz; return true;
    }
    __device__ __forceinline__ void a_ready(const Unit&) const {}
    __device__ __forceinline__ void done(const Unit&) const {}
};
struct LatOrder { int c;
    __host__ __device__ bool next(int i, Unit& u) const { if (i > 0) return false; const int k = c >> 3, pl = (c & 7) * 8 + (k >> 2);
        u.pm = (pl >> 4) * 17 + 1 + (pl & 15); u.pn = k & 3; return true; }
    __device__ __forceinline__ void a_ready(const Unit&) const {}
    __device__ __forceinline__ void done(const Unit&) const {} };
struct CtxOrder { int c;
    __host__ __device__ bool next(int i, Unit& u) const { if (i > 0 || c >= 16) return false; u.pm = 17 * (c >> 2); u.pn = c & 3; return true; }
    __device__ __forceinline__ void a_ready(const Unit&) const {}
    __device__ __forceinline__ void done(const Unit&) const {} };

typedef __bf16 bf16v2 __attribute__((ext_vector_type(2)));
typedef float f32v2 __attribute__((ext_vector_type(2)));
__device__ __forceinline__ unsigned cvt_pk_bf16(float lo, float hi) { const f32v2 v = {lo, hi}; return __builtin_bit_cast(unsigned, __builtin_convertvector(v, bf16v2)); }
struct EpiP {
    static constexpr bool PERM = true, AFTER_DRAIN = false;
    bf16_t* P;
    __device__ __forceinline__ void operator()(const f32x4 (&acc)[2][2][4][2], const Unit& u, int wr, int wc, int fr, int fq) const {
        asm volatile("" : "+v"(fr), "+v"(fq));
        const int row0 = u.pm * BM + wr * 64 + fr, col0 = u.pn * BM + wc * 32 + 8 * fq;
#pragma unroll
        for (int ai = 0; ai < 2; ++ai)
#pragma unroll
            for (int m = 0; m < 4; ++m) { bf16_t* rowp = P + (size_t)(row0 + ai * HALF + m * 16) * LDP + col0;
#pragma unroll
                for (int bj = 0; bj < 2; ++bj) { if (col0 + bj * HALF < LDP) { const f32x4 v0 = acc[ai][bj][m][0], v1 = acc[ai][bj][m][1];
                    u32x4 w; w.x = cvt_pk_bf16(v0[0], v0[1]); w.y = cvt_pk_bf16(v0[2], v0[3]); w.z = cvt_pk_bf16(v1[0], v1[1]); w.w = cvt_pk_bf16(v1[2], v1[3]);
                    *(u32x4*)(rowp + bj * HALF) = w; } } }
    }
};
struct EpiZ {
    static constexpr bool PERM = false, AFTER_DRAIN = false;
    const float* x_in; const float* ctx_in; const float* X; float* Xout; const float* modl; int layer0;
    __device__ __forceinline__ void operator()(const f32x4 (&acc)[2][2][4][2], const Unit& u, int wr, int wc, int fr, int fq) const {
        asm volatile("" : "+v"(fr), "+v"(fq));
        const int row0 = u.pm * BM + wr * 64 + fr, col0 = u.pn * BM + wc * 32 + 4 * fq;
#pragma unroll
        for (int ai = 0; ai < 2; ++ai)
#pragma unroll
            for (int m = 0; m < 4; ++m) { const int r = row0 + ai * HALF + m * 16; const int b = r / SEQT, sp = r - b * SEQT; const int j = sp < CTX ? 4 : b;
                const float* xs = layer0 ? (sp < CTX ? ctx_in + ((size_t)b * CTX + sp) * D : x_in + ((size_t)b * SEQ + (sp - CTX)) * D) : X + (size_t)r * D;
                float* zo = Xout + (size_t)r * D; const float* gp = modl + j * 3072 + 2048;
#pragma unroll
                for (int bj = 0; bj < 2; ++bj)
#pragma unroll
                    for (int n = 0; n < 2; ++n) { const int c = col0 + bj * HALF + n * 16; const f32x4 xv = *(const f32x4*)(xs + c), gv = *(const f32x4*)(gp + c);
                        *(f32x4*)(zo + c) = xv * ALPHA + gv * acc[ai][bj][m][n]; } }
    }
};

template <class Epi, class Sched, bool ALIGN_EPI = false, bool SP2 = false>
__device__ __forceinline__ void gemm_phase(PG8_LAS unsigned char* lds, const Gemm g, const Sched& S, const Epi& E, const int tid  ) {
    const int wid = __builtin_amdgcn_readfirstlane(tid >> 6), lane = tid & 63, wr = wid >> 2, wc = wid & 3, fr = lane & 15, fq = lane >> 4;
    const int K = g.K, nt = K / BK;
    unsigned voffA[2], voffB[2];
#pragma unroll
    for (int i = 0; i < 2; ++i) { int R, C; stage_rc(tid * 16 + i * 8192, R, C); const int Rb = Epi::PERM ? ((R & ~31) + perm32(R & 31)) : R;
        voffA[i] = (unsigned)(R * K + C) * 2u; voffB[i] = (unsigned)(Rb * K + C) * 2u; }
    const size_t kstep = (size_t)(BK * 2);
    const size_t hstep = (size_t)HALF * K * 2;
    const size_t tstep = 2 * hstep;
    const unsigned ldsw = (unsigned)wid * 1024u;
    const int aoff = lds_byte(wr * 64 + fr, fq * 8), boff = lds_byte(wc * 32 + fr, fq * 8);
#define PG8_SA(b, h) (((b) * 2 + (h)) * HTB)
#define PG8_SB(b, h) ((4 + (b) * 2 + (h)) * HTB)
#define PG8_STAGE(bufoff, gbase, voff) do { _Pragma("unroll") for (int _i = 0; _i < 2; ++_i) \
        __builtin_amdgcn_global_load_lds((const unsigned*)((const char*)(gbase) + (voff)[_i]), (PG8_LAS unsigned*)(lds + (bufoff) + ldsw + _i * 8192), 16, 0, 0); } while (0)
#define PG8_LDA(dst, b, h) do { _Pragma("unroll") for (int m = 0; m < 4; ++m) _Pragma("unroll") for (int k = 0; k < 2; ++k) dst[m][k] = *(const PG8_LAS bf16x8*)(lds + PG8_SA(b, h) + aoff + m * 2048 + k * 1024); } while (0)
#define PG8_LDB(dst, b, h) do { _Pragma("unroll") for (int n = 0; n < 2; ++n) _Pragma("unroll") for (int k = 0; k < 2; ++k) dst[n][k] = *(const PG8_LAS bf16x8*)(lds + PG8_SB(b, h) + boff + n * 2048 + k * 1024); } while (0)
#define PG8_MMA(ai, bj, At, Bt) do { __builtin_amdgcn_s_setprio(1); _Pragma("unroll") for (int m = 0; m < 4; ++m) _Pragma("unroll") for (int n = 0; n < 2; ++n) _Pragma("unroll") for (int k = 0; k < 2; ++k) \
        acc[ai][bj][m][n] = __builtin_amdgcn_mfma_f32_16x16x32_bf16(Bt[n][k], At[m][k], acc[ai][bj][m][n], 0, 0, 0); __builtin_amdgcn_s_setprio(0); } while (0)
#define PG8_WAIT_V(n) asm volatile("s_waitcnt vmcnt(" #n ")" ::: "memory")
#define PG8_WAIT_L(n) asm volatile("s_waitcnt lgkmcnt(" #n ")" ::: "memory")
#define PG8_BAR __builtin_amdgcn_s_barrier()
#define PG8_SCHED __builtin_amdgcn_sched_barrier(0)
    Unit cur, nxt; int ui = 0;
    if (!S.next(0, cur)) return;
    f32x4 acc[2][2][4][2];
#pragma unroll
    for (int a = 0; a < 2; ++a)
#pragma unroll
        for (int b = 0; b < 2; ++b)
#pragma unroll
            for (int m = 0; m < 4; ++m)
#pragma unroll
                for (int n = 0; n < 2; ++n) acc[a][b][m][n] = (f32x4){0.f, 0.f, 0.f, 0.f};
    bf16x8 At[4][2], B0[2][2], B1[2][2];
    const char* cA = (const char*)g.A + (size_t)cur.pm * tstep; const char* cB = (const char*)g.Bt + (size_t)cur.pn * tstep;
    S.a_ready(cur);
    if constexpr (SP2) {
        PG8_STAGE(PG8_SB(0, 0), cB, voffB); PG8_STAGE(PG8_SB(0, 1), cB + hstep, voffB); PG8_STAGE(PG8_SA(0, 0), cA, voffA); PG8_STAGE(PG8_SA(0, 1), cA + hstep, voffA);
        if (wr == 1) PG8_BAR;
        PG8_WAIT_V(2); PG8_BAR;
        PG8_STAGE(PG8_SB(1, 0), cB + kstep, voffB); PG8_STAGE(PG8_SA(1, 0), cA + kstep, voffA); PG8_STAGE(PG8_SB(1, 1), cB + hstep + kstep, voffB);
        PG8_WAIT_V(6); PG8_BAR;
    } else {
        PG8_STAGE(PG8_SB(0, 0), cB, voffB); PG8_STAGE(PG8_SA(0, 0), cA, voffA); PG8_STAGE(PG8_SB(0, 1), cB + hstep, voffB); PG8_STAGE(PG8_SA(0, 1), cA + hstep, voffA);
        if (wr == 1) PG8_BAR;
        PG8_WAIT_V(4); PG8_BAR;
        PG8_STAGE(PG8_SB(1, 0), cB + kstep, voffB); PG8_STAGE(PG8_SA(1, 0), cA + kstep, voffA); PG8_STAGE(PG8_SB(1, 1), cB + hstep + kstep, voffB);
        PG8_WAIT_V(6); PG8_BAR;
    }
    for (;;) {
        const bool has_next = S.next(ui + 1, nxt);
        const char* nA = has_next ? (const char*)g.A + (size_t)nxt.pm * tstep : cA; const char* nB = has_next ? (const char*)g.Bt + (size_t)nxt.pn * tstep : cB;
        for (int t = 0; t < nt; t += 2) {
            const bool last = (t == nt - 2);
            const char* a1 = cA + (size_t)(t + 1) * kstep;
            const char* a2 = last ? nA : cA + (size_t)(t + 2) * kstep; const char* b2 = last ? nB : cB + (size_t)(t + 2) * kstep;
            const char* a3 = a2 + kstep; const char* b3 = b2 + kstep;
            if (last && has_next) S.a_ready(nxt);
            if constexpr (SP2) {
            PG8_LDB(B0, 0, 0); PG8_LDB(B1, 0, 1); PG8_SCHED; PG8_LDA(At, 0, 0); PG8_STAGE(PG8_SA(1, 1), a1 + hstep, voffA);
            PG8_WAIT_V(8); PG8_WAIT_L(0); PG8_BAR; PG8_MMA(0, 0, At, B0); PG8_MMA(0, 1, At, B1); PG8_BAR; PG8_SCHED;
            PG8_LDA(At, 0, 1); PG8_STAGE(PG8_SB(0, 0), b2, voffB); PG8_STAGE(PG8_SB(0, 1), b2 + hstep, voffB); PG8_STAGE(PG8_SA(0, 0), a2, voffA);
            PG8_WAIT_V(8); PG8_WAIT_L(0); PG8_BAR; PG8_MMA(1, 0, At, B0); PG8_MMA(1, 1, At, B1); PG8_BAR; PG8_SCHED;
            PG8_LDB(B0, 1, 0); PG8_LDB(B1, 1, 1); PG8_SCHED; PG8_LDA(At, 1, 0); PG8_STAGE(PG8_SA(0, 1), a2 + hstep, voffA);
            PG8_WAIT_V(8); PG8_WAIT_L(0); PG8_BAR; PG8_MMA(0, 0, At, B0); PG8_MMA(0, 1, At, B1); PG8_BAR; PG8_SCHED;
            PG8_LDA(At, 1, 1); PG8_STAGE(PG8_SB(1, 0), b3, voffB); PG8_STAGE(PG8_SB(1, 1), b3 + hstep, voffB); PG8_STAGE(PG8_SA(1, 0), a3, voffA);
            PG8_WAIT_V(8); PG8_WAIT_L(0); PG8_BAR; PG8_MMA(1, 0, At, B0); PG8_MMA(1, 1, At, B1); PG8_BAR; PG8_SCHED;
            } else {
            PG8_LDB(B0, 0, 0); PG8_SCHED; PG8_LDA(At, 0, 0); PG8_STAGE(PG8_SA(1, 1), a1 + hstep, voffA);
            PG8_WAIT_L(8); PG8_BAR; PG8_WAIT_L(0); PG8_MMA(0, 0, At, B0); PG8_BAR; PG8_SCHED;
            PG8_LDB(B1, 0, 1); PG8_STAGE(PG8_SB(0, 0), b2, voffB);
            PG8_BAR; PG8_WAIT_L(0); PG8_MMA(0, 1, At, B1); PG8_BAR;
            PG8_LDA(At, 0, 1); PG8_STAGE(PG8_SA(0, 0), a2, voffA);
            PG8_BAR; PG8_WAIT_L(0); PG8_MMA(1, 0, At, B0); PG8_BAR; PG8_SCHED;
            PG8_STAGE(PG8_SB(0, 1), b2 + hstep, voffB);
            PG8_WAIT_V(6); PG8_BAR; PG8_MMA(1, 1, At, B1); PG8_BAR;
            PG8_LDB(B0, 1, 0); PG8_SCHED; PG8_LDA(At, 1, 0); PG8_STAGE(PG8_SA(0, 1), a2 + hstep, voffA);
            PG8_WAIT_L(8); PG8_BAR; PG8_WAIT_L(0); PG8_MMA(0, 0, At, B0); PG8_BAR; PG8_SCHED;
            PG8_LDB(B1, 1, 1); PG8_STAGE(PG8_SB(1, 0), b3, voffB);
            PG8_BAR; PG8_WAIT_L(0); PG8_MMA(0, 1, At, B1); PG8_BAR;
            PG8_LDA(At, 1, 1); PG8_STAGE(PG8_SA(1, 0), a3, voffA);
            PG8_BAR; PG8_WAIT_L(0); PG8_MMA(1, 0, At, B0); PG8_BAR; PG8_SCHED;
            PG8_STAGE(PG8_SB(1, 1), b3 + hstep, voffB);
            PG8_WAIT_V(6); PG8_BAR; PG8_MMA(1, 1, At, B1); PG8_BAR;
            }
        }
        if constexpr (ALIGN_EPI) { if (wr == 0) PG8_BAR; }
        if constexpr (!Epi::AFTER_DRAIN) { E(acc, cur, wr, wc, fr, fq); S.done(cur); }
        if (!has_next) break;
#pragma unroll
        for (int a = 0; a < 2; ++a)
#pragma unroll
            for (int b = 0; b < 2; ++b)
#pragma unroll
                for (int m = 0; m < 4; ++m)
#pragma unroll
                    for (int n = 0; n < 2; ++n) acc[a][b][m][n] = (f32x4){0.f, 0.f, 0.f, 0.f};
        cur = nxt; cA = nA; cB = nB; ++ui;
        if constexpr (ALIGN_EPI) { if (wr == 1) PG8_BAR; }
    }
    PG8_WAIT_V(0);
    if constexpr (!ALIGN_EPI) { if (wr == 0) PG8_BAR; }
    PG8_BAR;
    if constexpr (Epi::AFTER_DRAIN) { E.fused(acc, cur, wr, wc, fr, fq, lds, wid, lane); S.done(cur); }
#undef PG8_SA
#undef PG8_SB
#undef PG8_STAGE
#undef PG8_LDA
#undef PG8_LDB
#undef PG8_MMA
#undef PG8_WAIT_V
#undef PG8_WAIT_L
#undef PG8_BAR
#undef PG8_SCHED
}
}

namespace {
#define LAS __attribute__((address_space(3)))
typedef unsigned short bf16_t;
typedef unsigned v4u __attribute__((ext_vector_type(4)));
typedef float f32x4 __attribute__((ext_vector_type(4)));
#define LDS_WAIT() asm volatile("s_waitcnt lgkmcnt(0)" ::: "memory")

__device__ __forceinline__ unsigned f2bf(float f) { unsigned u = __float_as_uint(f); return (u + 0x7fffu + ((u >> 16) & 1u)) >> 16; }
__device__ __forceinline__ unsigned pk2(float lo, float hi) { return f2bf(lo) | (f2bf(hi) << 16); }
__device__ __forceinline__ float bf2f(bf16_t b) { return __uint_as_float(((unsigned)b) << 16); }
__device__ __forceinline__ float fexp(float x) { return __builtin_amdgcn_exp2f(x * 1.4426950408889634f); }
__device__ __forceinline__ float frcp(float x) { return __builtin_amdgcn_rcpf(x); }
__device__ __forceinline__ float frsq(float x) { return __builtin_amdgcn_rsqf(x); }
__device__ __forceinline__ float fsqrt_(float x) { return __builtin_amdgcn_sqrtf(x); }
__device__ __forceinline__ float flog(float x) { return __builtin_amdgcn_logf(x) * 0.6931471805599453f; }
__device__ __forceinline__ float sigmoidf_(float x) { return frcp(1.0f + fexp(-x)); }
__device__ __forceinline__ float siluf_(float x) { return x * frcp(1.0f + fexp(-x)); }
__device__ __forceinline__ float softplusf_(float x) { const float e = fexp(x); return x > 15.f ? x : (e < 1e-3f ? e * (1.0f - 0.5f * e) : flog(1.0f + e)); }
__device__ __forceinline__ int lane_id_v() { int l; asm volatile("v_mbcnt_lo_u32_b32 %0, -1, 0\n\tv_mbcnt_hi_u32_b32 %0, -1, %0" : "=v"(l)); return l; }
__device__ __forceinline__ float shx(float v, int mask) { return __builtin_bit_cast(float, __builtin_amdgcn_ds_bpermute((lane_id_v() ^ mask) << 2, __builtin_bit_cast(int, v))); }
__device__ __forceinline__ float shx1(float v) { return __builtin_bit_cast(float, __builtin_amdgcn_update_dpp(0, __builtin_bit_cast(int, v), 0xB1, 0xf, 0xf, true)); }
__device__ __forceinline__ float shx2(float v) { return __builtin_bit_cast(float, __builtin_amdgcn_update_dpp(0, __builtin_bit_cast(int, v), 0x4E, 0xf, 0xf, true)); }
__device__ __forceinline__ float shidx(float v, int src) { return __builtin_bit_cast(float, __builtin_amdgcn_ds_bpermute(src << 2, __builtin_bit_cast(int, v))); }
__device__ __forceinline__ float wave_sum(float v) {
#pragma unroll
    for (int o = 32; o >= 1; o >>= 1) v += shx(v, o);
    return v; }
__device__ __forceinline__ float wave_max(float v) {
#pragma unroll
    for (int o = 32; o >= 1; o >>= 1) v = fmaxf(v, shx(v, o));
    return v; }

constexpr size_t MiB = 1u << 20;
constexpr size_t WS_CTL = 0, CTL_ZERO_BYTES = 65536;
constexpr size_t WS_MOD = 1 * MiB;
constexpr size_t WS_WTIN = 2 * MiB;
constexpr size_t WS_WTOUT = 10 * MiB;
constexpr size_t WS_X = 12 * MiB;
constexpr size_t WS_UF = 80 * MiB;
constexpr size_t WS_P = 114 * MiB;
constexpr size_t WS_GDNX = 226 * MiB;
constexpr size_t WS_VT = 230 * MiB;
constexpr size_t WS_RGS = 247 * MiB;
constexpr size_t WS_END = 250 * MiB;
constexpr size_t WS_RGWT = 1 * MiB + 576 * 1024;
constexpr size_t WS_RGTAB = 1 * MiB + 768 * 1024;
constexpr size_t WS_ROPE = 1 * MiB + 512 * 1024;
constexpr int LDS_BAR_OFF = 155648;
constexpr int LDS_BYTES = 155648 + 256;
constexpr size_t WS_BAR = 16384;

struct Params { const void* ptr[22]; };

__device__ __forceinline__ void phase_mods(const float* c, const float* cctx, const float* w_mod, const float* b_mod, float* mod, LAS float* sc, int wid, int lane) {
    for (int item = blockIdx.x; item < DEPTH * 48; item += gridDim.x) {
        const int l = item / 48, n = (item % 48) * 64 + lane;
        float a0 = 0, a1 = 0, a2 = 0, a3 = 0, a4 = 0;
        const float* w = w_mod + (size_t)l * 1024 * 3072 + n;
        for (int k = wid * 128; k < wid * 128 + 128; ++k) {
            const float wv = w[(size_t)k * 3072];
            a0 += siluf_(c[k]) * wv; a1 += siluf_(c[1024 + k]) * wv; a2 += siluf_(c[2048 + k]) * wv; a3 += siluf_(c[3072 + k]) * wv; a4 += siluf_(cctx[k]) * wv;
        }
        sc[(wid * 5 + 0) * 64 + lane] = a0; sc[(wid * 5 + 1) * 64 + lane] = a1; sc[(wid * 5 + 2) * 64 + lane] = a2; sc[(wid * 5 + 3) * 64 + lane] = a3; sc[(wid * 5 + 4) * 64 + lane] = a4;
        __syncthreads();
        if (wid < 5) { float s = 0.f;
#pragma unroll
            for (int w8 = 0; w8 < 8; ++w8) s += sc[(w8 * 5 + wid) * 64 + lane];
            mod[(size_t)(l * 5 + wid) * 3072 + n] = s + b_mod[l * 3072 + n]; }
        __syncthreads();
    }
}
__device__ __forceinline__ void transpose_item(const float* W, int K, int N, int nblk, bf16_t* WT, LAS float* scr, int item, int lane) {
    const int kb = item / nblk, nb = item % nblk, k0 = 64 * kb, n0 = 32 * nb;
    const int nn = n0 + (lane & 31);
#pragma unroll 8
    for (int i = 0; i < 32; ++i) { const int kk = 2 * i + (lane >> 5); scr[kk * 33 + (lane & 31)] = nn < N ? W[(size_t)(k0 + kk) * N + nn] : 0.f; }
    LDS_WAIT();
    const int c = lane & 7;
#pragma unroll
    for (int j = 0; j < 4; ++j) { const int n = (lane >> 3) + 8 * j; const LAS float* s = scr + (8 * c) * 33 + n;
        v4u o; o.x = pk2(s[0 * 33], s[1 * 33]); o.y = pk2(s[2 * 33], s[3 * 33]); o.z = pk2(s[4 * 33], s[5 * 33]); o.w = pk2(s[6 * 33], s[7 * 33]);
        *(v4u*)(WT + (size_t)(n0 + n) * K + k0 + 8 * c) = o; }
    LDS_WAIT();
}
__device__ __forceinline__ void convert_weights(const float* w_in_l, const float* w_out_l, bf16_t* WTIN, bf16_t* WTOUT, LAS float* scr, int gw, int NGW, int lane) {
    constexpr int I_IN = 16 * 105, I_OUT = 16 * 32;
    for (int it = gw; it < I_IN + I_OUT; it += NGW) {
        if (it < I_IN) transpose_item(w_in_l, 1024, DIN, 105, WTIN, scr, it, lane);
        else transpose_item(w_out_l, 1024, 1024, 32, WTOUT, scr, it - I_IN, lane);
    }
}
__device__ __forceinline__ void convert_rg(const float* wa, const float* ba, const float* wx, const float* bx, const float* lam, bf16_t* RGWT, float* rgtab, int gtid, int ngt) {
    for (int idx = gtid; idx < 24 * 4096 + 768; idx += ngt) {
        if (idx < 24 * 4096) { const int dd = idx & 63, e = (idx >> 6) & 63, m = idx >> 12, kind = m & 1, dn = m >> 1;
            RGWT[idx] = (bf16_t)f2bf((kind ? wx : wa)[((size_t)dn * 64 + dd) * 64 + e]); }
        else { const int k = idx - 24 * 4096; rgtab[k] = ba[k]; rgtab[768 + k] = bx[k]; rgtab[1536 + k] = -8.0f * log1pf(expf(-lam[k])); }
    }
}
__device__ __forceinline__ void prep_rows0(const float* x, const float* ctx, const float* modl, bf16_t* U, int gw, int NGW, int lane) {
    constexpr int R = 4;
    for (int t0 = gw; t0 < T; t0 += R * NGW) {
        f32x4 v[R][4];
#pragma unroll
        for (int r2 = 0; r2 < R; ++r2) { const int t = (t0 + r2 * NGW < T) ? t0 + r2 * NGW : t0; const int b = t / SEQT, sp = t - b * SEQT;
            const float* xs = sp < CTX ? ctx + ((size_t)b * CTX + sp) * D : x + ((size_t)b * SEQ + (sp - CTX)) * D;
#pragma unroll
            for (int q = 0; q < 4; ++q) v[r2][q] = *(const f32x4*)(xs + (q * 64 + lane) * 4); }
#pragma unroll
        for (int r2 = 0; r2 < R; ++r2) { const int t = t0 + r2 * NGW; if (t >= T) continue; const int b = t / SEQT, sp = t - b * SEQT, j = sp < CTX ? 4 : b;
            const float* sh = modl + j * 3072; const float* sc = sh + 1024;
#pragma unroll
            for (int q = 0; q < 4; ++q) { const int k = (q * 64 + lane) * 4; const f32x4 s1 = *(const f32x4*)(sc + k), s0 = *(const f32x4*)(sh + k);
                const f32x4 u = v[r2][q] * (s1 + 1.0f) + s0; uint2 o; o.x = pk2(u[0], u[1]); o.y = pk2(u[2], u[3]); *(uint2*)(U + (size_t)t * D + k) = o; } }
    }
}
__device__ __forceinline__ void ln_rows(const float* X, float* Xw, const float* g, const float* bta, float* final_out, const float* modn, bf16_t* U, int gw, int NGW, int lane) {
    constexpr int R = 4;
    for (int t0 = gw; t0 < T; t0 += R * NGW) {
        int tt[R]; bool ok[R]; f32x4 v[R][4]; float s[R];
#pragma unroll
        for (int r2 = 0; r2 < R; ++r2) { tt[r2] = t0 + r2 * NGW; ok[r2] = tt[r2] < T; if (ok[r2] && final_out && (tt[r2] % SEQT) < CTX) ok[r2] = false;
            const float* xr = X + (size_t)(ok[r2] ? tt[r2] : t0) * D; s[r2] = 0.f;
#pragma unroll
            for (int q = 0; q < 4; ++q) { v[r2][q] = *(const f32x4*)(xr + (q * 64 + lane) * 4); s[r2] += (v[r2][q][0] + v[r2][q][1]) + (v[r2][q][2] + v[r2][q][3]); } }
#pragma unroll
        for (int o = 32; o >= 1; o >>= 1)
#pragma unroll
            for (int r2 = 0; r2 < R; ++r2) s[r2] += shx(s[r2], o);
        float s2[R];
#pragma unroll
        for (int r2 = 0; r2 < R; ++r2) { const float mean = s[r2] * (1.0f / D); s2[r2] = 0.f;
#pragma unroll
            for (int q = 0; q < 4; ++q) { v[r2][q] = v[r2][q] - mean; s2[r2] += (v[r2][q][0] * v[r2][q][0] + v[r2][q][1] * v[r2][q][1]) + (v[r2][q][2] * v[r2][q][2] + v[r2][q][3] * v[r2][q][3]); } }
#pragma unroll
        for (int o = 32; o >= 1; o >>= 1)
#pragma unroll
            for (int r2 = 0; r2 < R; ++r2) s2[r2] += shx(s2[r2], o);
#pragma unroll
        for (int r2 = 0; r2 < R; ++r2) { if (!ok[r2]) continue;
            const int t = tt[r2], b = t / SEQT, sp = t - b * SEQT, j = sp < CTX ? 4 : b;
            const float rstd = frsq(s2[r2] * (1.0f / D) + 1e-5f); float* xw = Xw + (size_t)t * D;
#pragma unroll
            for (int q = 0; q < 4; ++q) { const int k = (q * 64 + lane) * 4; const f32x4 y = v[r2][q] * rstd * *(const f32x4*)(g + k) + *(const f32x4*)(bta + k);
                if (final_out) *(f32x4*)(final_out + ((size_t)b * SEQ + (sp - CTX)) * D + k) = y;
                else { *(f32x4*)(xw + k) = y; const f32x4 u = y * (*(const f32x4*)(modn + j * 3072 + 1024 + k) + 1.0f) + *(const f32x4*)(modn + j * 3072 + k);
                    uint2 o; o.x = pk2(u[0], u[1]); o.y = pk2(u[2], u[3]); *(uint2*)(U + (size_t)t * D + k) = o; } } }
    }
}

__device__ __forceinline__ float conv_at(const bf16_t* P, const float* cw, int t, int c) {
    const int sp = t % SEQT;
    const int lo = sp < CTX ? 0 : CTX, hi = sp < CTX ? CTX : SEQT;
    float acc = 0.f;
#pragma unroll
    for (int j = 0; j < 4; ++j) { const int s2 = sp + j - 2; if (s2 >= lo && s2 < hi) acc += cw[j * CONV_CH + c] * bf2f(P[(size_t)(t + j - 2) * LDP + c]); }
    return acc;
}
__device__ __forceinline__ int step_to_sp(int step, int d) { return d == 0 ? step : (step < CTX ? CTX - 1 - step : SEQT - 1 - (step - CTX)); }

__device__ __forceinline__ void combine_rows(const bf16_t* P, const float* nw, bf16_t* F, int gw, int NGW, int lane) {
    const float nwl = nw[lane];
    for (int t0 = gw; t0 < T; t0 += 2 * NGW) {
        float o[2][4], z[2][4], ms[2][4];
#pragma unroll
        for (int r2 = 0; r2 < 2; ++r2) { const int t = (t0 + r2 * NGW < T) ? t0 + r2 * NGW : t0;
#pragma unroll
            for (int hh = 0; hh < 4; ++hh) { const int c = hh * 64 + lane;
                o[r2][hh] = bf2f(P[(size_t)t * LDP + C_QG + c]) + bf2f(P[(size_t)t * LDP + C_KG + c]); z[r2][hh] = bf2f(P[(size_t)t * LDP + C_ZG + c]); ms[r2][hh] = o[r2][hh] * o[r2][hh]; } }
#pragma unroll
        for (int s = 32; s >= 1; s >>= 1)
#pragma unroll
            for (int r2 = 0; r2 < 2; ++r2)
#pragma unroll
                for (int hh = 0; hh < 4; ++hh) ms[r2][hh] += shx(ms[r2][hh], s);
#pragma unroll
        for (int r2 = 0; r2 < 2; ++r2) { const int t = t0 + r2 * NGW; if (t >= T) continue;
#pragma unroll
            for (int hh = 0; hh < 4; ++hh) F[(size_t)t * 1024 + 768 + hh * 64 + lane] = (bf16_t)f2bf(o[r2][hh] * frsq(ms[r2][hh] * (1.0f / 64.0f) + 1e-6f) * nwl * siluf_(z[r2][hh])); }
    }
}


constexpr int LS = 72;
constexpr int G_KN = 0, G_KNT = 9216, G_QN = 18432, G_QK = 27648, G_XT = 36864, G_LB = 55296, G_TI = 64512, G_SM = 72704, G_CW = 73728, G_HALF = 77824;
#ifndef GP_S1
#define GP_S1 1
#endif
#ifndef GP_S1B
#define GP_S1B 1
#endif
#ifndef GP_S2
#define GP_S2 1
#endif
#ifndef GP_S4
#define GP_S4 1
#endif
#ifdef TPROBE
#define TP_BEGIN(k_) unsigned long long tp_t##k_ = 0; if (tidf == 0 && bidx == 0) tp_t##k_ = __builtin_amdgcn_s_memtime()
#define TP_END(k_, slot_) do { if (tidf == 0 && bidx == 0) { asm volatile("s_waitcnt lgkmcnt(0)" ::: "memory"); *(LAS unsigned long long*)(lds + 155648 + 64 + 8 * (slot_)) += __builtin_amdgcn_s_memtime() - tp_t##k_; } } while (0)
#else
#define TP_BEGIN(k_) do {} while (0)
#define TP_END(k_, slot_) do {} while (0)
#endif
__device__ __forceinline__ int opq3(int i) { asm volatile("" : "+s"(i)); return i; }
constexpr int GDN_ITEMS = NB * 4 * 2 * 68;
constexpr size_t GDN_ITEM_BYTES = 32768;
typedef short bf16x8_t __attribute__((ext_vector_type(8)));
typedef unsigned v2u __attribute__((ext_vector_type(2)));
typedef float f32x4_t __attribute__((ext_vector_type(4)));

typedef __bf16 bf16v2_t __attribute__((ext_vector_type(2)));
typedef float f32v2_t __attribute__((ext_vector_type(2)));
__device__ __forceinline__ unsigned cvtpk(float lo, float hi) { const f32v2_t v = {lo, hi}; return __builtin_bit_cast(unsigned, __builtin_convertvector(v, bf16v2_t)); }
__device__ __forceinline__ float fsilu(float x) { return x * frcp(1.0f + fexp(-x)); }
__device__ __forceinline__ bf16x8_t lds_frag(const LAS unsigned char* base, int row, int col) { return *(const LAS bf16x8_t*)(base + (row * LS + col) * 2); }
__device__ __forceinline__ unsigned char* gdn_item_ptr(unsigned char* dout, unsigned char* wsx, int it) { return it < 2048 ? dout + (size_t)it * GDN_ITEM_BYTES : wsx + (size_t)(it - 2048) * GDN_ITEM_BYTES; }
__device__ __forceinline__ int gdn_sp(int c, int i, int d) {
    if (c < 4) { const int s = c * 64 + i; return d == 0 ? s : CTX - 1 - s; }
    const int s = (c - 4) * 64 + i; return d == 0 ? CTX + s : SEQT - 1 - s;
}

__device__ __forceinline__ void gdn_pass1(const bf16_t* P, const float* cw, const float* alog, const float* dtb, const float* rcos, const float* rsin,
                                          unsigned char* dout, unsigned char* wsx, LAS unsigned char* lds, int wid8  , int bidx, int nblk) {
    const int n_iter = (544 + 127) / 128;
    {   const int tv0 = wid8 * 64 + lane_id_v();
        const int half0 = tv0 >> 8, t0 = tv0 & 255, hq = (bidx * 2 + half0) & 3;
        LAS float* cwl = (LAS float*)(lds + half0 * G_HALF + G_CW);
        for (int e = t0; e < 768; e += 256) { const int m3 = e >> 8, j = (e >> 6) & 3, ch = e & 63; cwl[e] = cw[j * CONV_CH + (m3 == 0 ? C_QG : (m3 == 1 ? C_KG : C_VG)) + hq * 64 + ch]; }
    }
#define GDN_BAR() do { asm volatile("s_waitcnt lgkmcnt(0)" ::: "memory"); __builtin_amdgcn_s_barrier(); asm volatile("" ::: "memory"); } while (0)
    v4u raw[4][3][2]; unsigned graw = 0u;
#define GDN_PREFETCH(iter_, tv_, m0_, m1_) do { const int half_ = (tv_) >> 8, t256_ = (tv_) & 255, hq_ = bidx * 2 + half_, hh_ = hq_ & 3, kidx_ = (iter_) * 128 + (hq_ >> 2); \
        const bool v_ = kidx_ < 544; const int c_ = kidx_ % 68, bd_ = kidx_ / 68, d_ = bd_ & 1, b_ = bd_ >> 1; \
        const int sp_ = gdn_sp(c_, t256_ >> 2, d_), lo_ = sp_ < CTX ? 0 : CTX, hi_ = sp_ < CTX ? CTX : SEQT; \
        _Pragma("unroll") for (int j = 0; j < 4; ++j) { const int s2_ = sp_ + j - 2; const bool ok_ = v_ && s2_ >= lo_ && s2_ < hi_; \
            const bf16_t* pr_ = P + (size_t)(b_ * SEQT + (ok_ ? s2_ : (v_ ? sp_ : 0))) * LDP + hh_ * 64 + 16 * (t256_ & 3); \
            _Pragma("unroll") for (int m3 = (m0_); m3 < (m1_); ++m3) { const int cb_ = m3 == 0 ? C_QG : (m3 == 1 ? C_KG : C_VG); \
                raw[j][m3][0] = ok_ ? *(const v4u*)(pr_ + cb_) : (v4u){0u, 0u, 0u, 0u}; raw[j][m3][1] = ok_ ? *(const v4u*)(pr_ + cb_ + 8) : (v4u){0u, 0u, 0u, 0u}; } } \
        if ((m0_) == 0 && t256_ < 64 && v_) { const bf16_t* gp_ = P + (size_t)(b_ * SEQT + gdn_sp(c_, (tv_) & 63, d_)) * LDP; graw = (unsigned)gp_[C_BR + d_ * 4 + hh_] | ((unsigned)gp_[C_AR + d_ * 4 + hh_] << 16); } } while (0)
    { const int tv0 = wid8 * 64 + lane_id_v(); GDN_PREFETCH(0, tv0, 0, 2); }
    GDN_BAR();
#pragma unroll 1
    for (int iter = 0; iter < n_iter; ++iter) {
        const int tidf = wid8 * 64 + lane_id_v();
        const int half = __builtin_amdgcn_readfirstlane(tidf >> 8), t256 = tidf & 255, w = __builtin_amdgcn_readfirstlane(t256 >> 6), lane = tidf & 63, g = lane >> 4, l15 = lane & 15;
        LAS unsigned char* hb = lds + half * G_HALF;
        LAS float* sm = (LAS float*)(hb + G_SM);
        const int hq2 = bidx * 2 + half, hh = hq2 & 3, kidx = iter * 128 + (hq2 >> 2);
        const bool valid = kidx < 544;
        const int c = kidx % 68, bd = kidx / 68, d = bd & 1, b = bd >> 1;
        const int it = ((b * 4 + hh) * 2 + d) * 68 + c;
        const int i = t256 >> 2, qd = t256 & 3;
        float qv[16], kv[16], vv[16];
        TP_BEGIN(0); TP_BEGIN(1);
        _Pragma("unroll 1") for (int rq = 0, nq = opq3(GP_S1); rq < nq; ++rq)
        if (valid) {
            const int sp = gdn_sp(c, i, d);
            GDN_PREFETCH(iter, tidf, 2, 3);
            if (t256 < 64) {
                const float beta = sigmoidf_(__uint_as_float(graw << 16));
                const float gg = -fexp(alog[d * 4 + hh]) * softplusf_(__uint_as_float(graw & 0xffff0000u) + dtb[d * 4 + hh]);
                float G = gg;
#pragma unroll
                for (int o = 1; o < 64; o <<= 1) { const float v = shidx(G, lane >= o ? lane - o : lane); if (lane >= o) G += v; }
                const float gl = shidx(G, 63);
                sm[lane] = beta; sm[64 + lane] = G; sm[128 + lane] = fexp(G); sm[192 + lane] = fexp(gl - G);
            }
            const LAS float* cwl = (const LAS float*)(hb + G_CW);
#pragma unroll
            for (int e = 0; e < 16; ++e) { qv[e] = 0.f; kv[e] = 0.f; vv[e] = 0.f; }
#pragma unroll
            for (int m3 = 0; m3 < 3; ++m3) {
#pragma unroll
                for (int j = 0; j < 4; ++j) {
                    const LAS float* wl = cwl + (m3 * 4 + j) * 64 + 16 * qd;
                    const f32x4_t w0 = *(const LAS f32x4_t*)wl, w1 = *(const LAS f32x4_t*)(wl + 4), w2 = *(const LAS f32x4_t*)(wl + 8), w3 = *(const LAS f32x4_t*)(wl + 12);
                    const float wv[16] = {w0[0], w0[1], w0[2], w0[3], w1[0], w1[1], w1[2], w1[3], w2[0], w2[1], w2[2], w2[3], w3[0], w3[1], w3[2], w3[3]};
                    const unsigned aw[8] = {raw[j][m3][0].x, raw[j][m3][0].y, raw[j][m3][0].z, raw[j][m3][0].w, raw[j][m3][1].x, raw[j][m3][1].y, raw[j][m3][1].z, raw[j][m3][1].w};
#pragma unroll
                    for (int e2 = 0; e2 < 8; ++e2) {
                        const float x0 = __uint_as_float(aw[e2] << 16), x1 = __uint_as_float(aw[e2] & 0xffff0000u);
                        if (m3 == 0) { qv[2 * e2] += wv[2 * e2] * x0; qv[2 * e2 + 1] += wv[2 * e2 + 1] * x1; }
                        else if (m3 == 1) { kv[2 * e2] += wv[2 * e2] * x0; kv[2 * e2 + 1] += wv[2 * e2 + 1] * x1; }
                        else { vv[2 * e2] += wv[2 * e2] * x0; vv[2 * e2 + 1] += wv[2 * e2 + 1] * x1; }
                    }
#define PIN16(a_) asm volatile("" : "+v"(a_[0]), "+v"(a_[1]), "+v"(a_[2]), "+v"(a_[3]), "+v"(a_[4]), "+v"(a_[5]), "+v"(a_[6]), "+v"(a_[7]), "+v"(a_[8]), "+v"(a_[9]), "+v"(a_[10]), "+v"(a_[11]), "+v"(a_[12]), "+v"(a_[13]), "+v"(a_[14]), "+v"(a_[15]) :: "memory")
                    if (m3 == 0) PIN16(qv); else if (m3 == 1) PIN16(kv); else PIN16(vv);
#undef PIN16
                }
            }
            GDN_PREFETCH(iter + 1, tidf, 0, 2);
            float sq = 0.f, sk = 0.f;
#pragma unroll
            for (int e = 0; e < 16; ++e) { qv[e] = fsilu(qv[e]); kv[e] = fsilu(kv[e]); vv[e] = fsilu(vv[e]); sq += qv[e] * qv[e]; sk += kv[e] * kv[e]; }
            sq += shx1(sq); sq += shx2(sq); sk += shx1(sk); sk += shx2(sk);
            const float rq = frsq(sq + 1e-6f), rk = frsq(sk + 1e-6f);
            const bool lat = sp >= CTX;
            const int s = sp - CTX, pos = qd < 2 ? (s >> 6) : (s & 63);
#pragma unroll
            for (int e = 0; e < 16; ++e) {
                float q1 = qv[e] * rq, k1 = kv[e] * rk;
                const float qp = shx1(q1), kp = shx1(k1);
                if (lat) { const float cs = rcos[pos * 16 + e], sn = rsin[pos * 16 + e];
                    if (qd & 1) { q1 = q1 * cs + qp * sn; k1 = k1 * cs + kp * sn; } else { q1 = q1 * cs - qp * sn; k1 = k1 * cs - kp * sn; } }
                qv[e] = q1 * 0.125f; kv[e] = k1;
            }
        }
        GDN_BAR(); TP_END(1, 1); TP_BEGIN(2);
        _Pragma("unroll 1") for (int rq = 0, nq = opq3(GP_S1B); rq < nq; ++rq)
        if (valid) {
            const float beta = sm[i], eG = sm[128 + i], eGl = sm[192 + i];
            v4u o0, o1;
            o0.x = cvtpk(kv[0], kv[1]); o0.y = cvtpk(kv[2], kv[3]); o0.z = cvtpk(kv[4], kv[5]); o0.w = cvtpk(kv[6], kv[7]);
            o1.x = cvtpk(kv[8], kv[9]); o1.y = cvtpk(kv[10], kv[11]); o1.z = cvtpk(kv[12], kv[13]); o1.w = cvtpk(kv[14], kv[15]);
            *(LAS v4u*)(hb + G_KN + (i * LS + 16 * qd) * 2) = o0; *(LAS v4u*)(hb + G_KN + (i * LS + 16 * qd + 8) * 2) = o1;
            o0.x = cvtpk(qv[0], qv[1]); o0.y = cvtpk(qv[2], qv[3]); o0.z = cvtpk(qv[4], qv[5]); o0.w = cvtpk(qv[6], qv[7]);
            o1.x = cvtpk(qv[8], qv[9]); o1.y = cvtpk(qv[10], qv[11]); o1.z = cvtpk(qv[12], qv[13]); o1.w = cvtpk(qv[14], qv[15]);
            *(LAS v4u*)(hb + G_QN + (i * LS + 16 * qd) * 2) = o0; *(LAS v4u*)(hb + G_QN + (i * LS + 16 * qd + 8) * 2) = o1;
            const float bw = beta * eG;
#pragma unroll
            for (int e = 0; e < 16; ++e) {
                const int f = 16 * qd + e;
                const unsigned p0 = cvtpk(kv[e] * eGl, beta * vv[e]), p1 = cvtpk(bw * kv[e], 0.f);
                *(LAS bf16_t*)(hb + G_KNT + (f * LS + i) * 2) = (bf16_t)(p0 & 0xffffu);
                *(LAS bf16_t*)(hb + G_XT + (f * LS + i) * 2) = (bf16_t)(p0 >> 16);
                *(LAS bf16_t*)(hb + G_XT + ((64 + f) * LS + i) * 2) = (bf16_t)(p1 & 0xffffu);
            }
        }
        GDN_BAR(); TP_END(2, 2); TP_BEGIN(3);
        _Pragma("unroll 1") for (int rq = 0, nq = opq3(GP_S2); rq < nq; ++rq)
        if (valid) {
            const bf16x8_t ak0 = lds_frag(hb + G_KN, 16 * w + l15, 8 * g), ak1 = lds_frag(hb + G_KN, 16 * w + l15, 32 + 8 * g);
            const bf16x8_t aq0 = lds_frag(hb + G_QN, 16 * w + l15, 8 * g), aq1 = lds_frag(hb + G_QN, 16 * w + l15, 32 + 8 * g);
            const f32x4_t Gi = *(const LAS f32x4_t*)(sm + 64 + 16 * w + 4 * g), Bi = *(const LAS f32x4_t*)(sm + 16 * w + 4 * g);
#pragma unroll
            for (int nt = 0; nt < 4; ++nt) {
                const bf16x8_t b0 = lds_frag(hb + G_KN, 16 * nt + l15, 8 * g), b1 = lds_frag(hb + G_KN, 16 * nt + l15, 32 + 8 * g);
                f32x4_t kk = {0.f, 0.f, 0.f, 0.f}, qk = {0.f, 0.f, 0.f, 0.f};
                kk = __builtin_amdgcn_mfma_f32_16x16x32_bf16(ak0, b0, kk, 0, 0, 0); kk = __builtin_amdgcn_mfma_f32_16x16x32_bf16(ak1, b1, kk, 0, 0, 0);
                qk = __builtin_amdgcn_mfma_f32_16x16x32_bf16(aq0, b0, qk, 0, 0, 0); qk = __builtin_amdgcn_mfma_f32_16x16x32_bf16(aq1, b1, qk, 0, 0, 0);
                const int jj = 16 * nt + l15; const float Gj = sm[64 + jj];
#pragma unroll
                for (int r = 0; r < 4; ++r) {
                    const int ii = 16 * w + 4 * g + r;
                    const float e = fexp(fminf(Gi[r] - Gj, 0.f));
                    const unsigned pk = cvtpk(jj < ii ? -(Bi[r] * kk[r] * e) : 0.f, jj <= ii ? qk[r] * e : 0.f);
                    *(LAS bf16_t*)(hb + G_LB + (ii * LS + jj) * 2) = (bf16_t)(pk & 0xffffu);
                    *(LAS bf16_t*)(hb + G_QK + (ii * LS + jj) * 2) = (bf16_t)(pk >> 16);
                }
            }
        }
        GDN_BAR(); TP_END(3, 3); TP_BEGIN(4);
        if (valid) {
            LAS unsigned char* ti = hb + G_TI + w * 2048;
            {   float tv[16];
#pragma unroll
                for (int i2 = 0; i2 < 16; ++i2) {
                    float acc = (i2 == l15) ? 1.0f : 0.0f;
                    if (i2 > 0) { const LAS unsigned char* lr = hb + G_LB + ((16 * g + i2) * LS + 16 * g) * 2;
                        const v4u r0 = *(const LAS v4u*)lr, r1 = *(const LAS v4u*)(lr + 16); const unsigned rw[8] = {r0.x, r0.y, r0.z, r0.w, r1.x, r1.y, r1.z, r1.w};
#pragma unroll
                        for (int j2 = 0; j2 < i2; ++j2) acc += ((j2 & 1) ? __uint_as_float(rw[j2 >> 1] & 0xffff0000u) : __uint_as_float(rw[j2 >> 1] << 16)) * tv[j2]; }
                    tv[i2] = acc;
                }
#pragma unroll
                for (int i2 = 0; i2 < 16; i2 += 2) { const unsigned pk = cvtpk(tv[i2], tv[i2 + 1]);
                    *(LAS bf16_t*)(ti + ((g * 16 + i2) * 16 + l15) * 2) = (bf16_t)(pk & 0xffffu); *(LAS bf16_t*)(ti + ((g * 16 + i2 + 1) * 16 + l15) * 2) = (bf16_t)(pk >> 16); }
            }
            LDS_WAIT();
#pragma unroll
            for (int I = 0; I < 4; ++I) {
                const v2u traw = *(const LAS v2u*)(ti + ((I * 16 + l15) * 16 + 4 * g) * 2);
                const v4u tpk = {traw.x, traw.y, 0u, 0u}; const bf16x8_t a_ti = __builtin_bit_cast(bf16x8_t, tpk);
#pragma unroll
                for (int cti = 0; cti < 2; ++cti) {
                    const int cr = 32 * w + 16 * cti + l15;
                    LAS unsigned char* xp = hb + G_XT + (cr * LS + 16 * I + 4 * g) * 2;
                    const v2u rr = *(const LAS v2u*)xp;
                    f32x4_t acc = {__uint_as_float(rr.x << 16), __uint_as_float(rr.x & 0xffff0000u), __uint_as_float(rr.y << 16), __uint_as_float(rr.y & 0xffff0000u)};
#pragma unroll
                    for (int s2 = 0; s2 < (16 * I + 31) / 32; ++s2) {
                        bf16x8_t al = lds_frag(hb + G_LB, 16 * I + l15, 32 * s2 + 8 * g);
                        if (32 * s2 + 8 * g >= 16 * I) al = (bf16x8_t){0, 0, 0, 0, 0, 0, 0, 0};
                        acc = __builtin_amdgcn_mfma_f32_16x16x32_bf16(al, lds_frag(hb + G_XT, cr, 32 * s2 + 8 * g), acc, 0, 0, 0);
                    }
                    const v4u rpk = {cvtpk(acc[0], acc[1]), cvtpk(acc[2], acc[3]), 0u, 0u};
                    f32x4_t xa = {0.f, 0.f, 0.f, 0.f};
                    xa = __builtin_amdgcn_mfma_f32_16x16x32_bf16(a_ti, __builtin_bit_cast(bf16x8_t, rpk), xa, 0, 0, 0);
                    v2u o; o.x = cvtpk(xa[0], xa[1]); o.y = cvtpk(xa[2], xa[3]); *(LAS v2u*)xp = o;
                }
                LDS_WAIT();
            }
        }
        GDN_BAR(); TP_END(4, 4); TP_BEGIN(5);
        _Pragma("unroll 1") for (int rq = 0, nq = opq3(GP_S4); rq < nq; ++rq)
        if (valid) {
            unsigned char* blk = gdn_item_ptr(dout, wsx, it);
            bf16_t* gM = (bf16_t*)blk; bf16_t* gP = gM + 4096; bf16_t* gN = gM + 8192; bf16_t* gQ = gM + 12288;
            const bf16x8_t akd0 = lds_frag(hb + G_KNT, 16 * w + l15, 8 * g), akd1 = lds_frag(hb + G_KNT, 16 * w + l15, 32 + 8 * g);
            const bf16x8_t aqk0 = lds_frag(hb + G_QK, 16 * w + l15, 8 * g), aqk1 = lds_frag(hb + G_QK, 16 * w + l15, 32 + 8 * g);
            const bf16x8_t aw0 = lds_frag(hb + G_XT, 64 + 16 * w + l15, 8 * g), aw1 = lds_frag(hb + G_XT, 64 + 16 * w + l15, 32 + 8 * g);
            const float egl = sm[128 + 63];
            const int pcol = 16 * w + 4 * g;
#pragma unroll
            for (int nt = 0; nt < 4; ++nt) {
                const bf16x8_t bu0 = lds_frag(hb + G_XT, 16 * nt + l15, 8 * g), bu1 = lds_frag(hb + G_XT, 16 * nt + l15, 32 + 8 * g);
                f32x4_t nn = {0.f, 0.f, 0.f, 0.f}, qm = {0.f, 0.f, 0.f, 0.f};
                nn = __builtin_amdgcn_mfma_f32_16x16x32_bf16(akd0, bu0, nn, 0, 0, 0); nn = __builtin_amdgcn_mfma_f32_16x16x32_bf16(akd1, bu1, nn, 0, 0, 0);
                qm = __builtin_amdgcn_mfma_f32_16x16x32_bf16(aqk0, bu0, qm, 0, 0, 0); qm = __builtin_amdgcn_mfma_f32_16x16x32_bf16(aqk1, bu1, qm, 0, 0, 0);
                const int cc = 16 * nt + l15;
                v2u o; o.x = cvtpk(nn[0], nn[1]); o.y = cvtpk(nn[2], nn[3]); *(v2u*)(gN + cc * 64 + 16 * w + 4 * g) = o;
                o.x = cvtpk(qm[0], qm[1]); o.y = cvtpk(qm[2], qm[3]); *(v2u*)(gQ + cc * 64 + 16 * w + 4 * g) = o;
                const bf16x8_t bk0 = lds_frag(hb + G_KNT, 16 * nt + l15, 8 * g), bk1 = lds_frag(hb + G_KNT, 16 * nt + l15, 32 + 8 * g);
                const bf16x8_t bq0 = lds_frag(hb + G_QK, 16 * nt + l15, 8 * g), bq1 = lds_frag(hb + G_QK, 16 * nt + l15, 32 + 8 * g);
                f32x4_t mm = {0.f, 0.f, 0.f, 0.f}, pm = {0.f, 0.f, 0.f, 0.f};
                mm = __builtin_amdgcn_mfma_f32_16x16x32_bf16(aw0, bk0, mm, 0, 0, 0); mm = __builtin_amdgcn_mfma_f32_16x16x32_bf16(aw1, bk1, mm, 0, 0, 0);
                pm = __builtin_amdgcn_mfma_f32_16x16x32_bf16(aw0, bq0, pm, 0, 0, 0); pm = __builtin_amdgcn_mfma_f32_16x16x32_bf16(aw1, bq1, pm, 0, 0, 0);
                const int frow = 16 * nt + l15;
                float mv[4], pv[4];
                const v2u qraw = *(const LAS v2u*)(hb + G_QN + (frow * LS + 16 * w + 4 * g) * 2);
                const float qf[4] = {__uint_as_float(qraw.x << 16), __uint_as_float(qraw.x & 0xffff0000u), __uint_as_float(qraw.y << 16), __uint_as_float(qraw.y & 0xffff0000u)};
                const float eGi = sm[128 + frow];
#pragma unroll
                for (int r = 0; r < 4; ++r) { mv[r] = ((16 * w + 4 * g + r) == frow ? egl : 0.f) - mm[r]; pv[r] = qf[r] * eGi - pm[r]; }
                o.x = cvtpk(mv[0], mv[1]); o.y = cvtpk(mv[2], mv[3]); *(v2u*)(gM + frow * 64 + pcol) = o;
                o.x = cvtpk(pv[0], pv[1]); o.y = cvtpk(pv[2], pv[3]); *(v2u*)(gP + frow * 64 + pcol) = o;
            }
        }
        GDN_BAR(); TP_END(5, 5); TP_END(0, 0);
    }
#undef GDN_BAR
#undef GDN_PREFETCH
}

constexpr int CH_SB = 0, CH_OB = 18432, CH_RING = 36864, CH_SLOT = 36864;
__device__ __forceinline__ void gdn_chain(unsigned char* dout, unsigned char* wsx, bf16_t* Pw, int bhd, LAS unsigned char* cb, int wid, int lane) {
    const int d = bhd & 1, hh = (bhd >> 1) & 3, b = bhd >> 3, g = lane >> 4, l15 = lane & 15, w = wid & 3;
    const bool helper = wid >= 4;
    LAS unsigned char* sbuf = cb + CH_SB; LAS unsigned char* obuf = cb + CH_OB; LAS unsigned char* ring = cb + CH_RING;
    bf16_t* Og = Pw + (d == 0 ? C_QG : C_KG) + hh * 64;
#define GDN_BAR() do { asm volatile("s_waitcnt lgkmcnt(0)" ::: "memory"); __builtin_amdgcn_s_barrier(); asm volatile("" ::: "memory"); } while (0)
    if (helper) {
        v4u st[5][8];
#define CH_LOAD(s_, c_) do { if ((c_) < 68) { const unsigned char* blk_ = gdn_item_ptr(dout, wsx, bhd * 68 + (c_)); \
            _Pragma("unroll") for (int k = 0; k < 8; ++k) st[s_][k] = *(const v4u*)(blk_ + (size_t)(k * 256 + w * 64 + lane) * 16); } } while (0)
#define CH_PARK(s_, c_) do { if ((c_) < 68) { LAS unsigned char* sl_ = ring + ((c_) & 1) * CH_SLOT; \
            _Pragma("unroll") for (int k = 0; k < 8; ++k) { const int p = k * 256 + w * 64 + lane; *(LAS v4u*)(sl_ + (p >> 9) * 9216 + ((p >> 3) & 63) * 144 + (p & 7) * 16) = st[s_][k]; } } } while (0)
#define CH_HSTORE(c_) do { _Pragma("unroll") for (int k2 = 0; k2 < 2; ++k2) { const int pc = w * 64 + lane + 256 * k2, row = pc >> 3, seg = pc & 7; \
            const v4u ov = *(const LAS v4u*)(obuf + ((c_) & 1) * 9216 + (row * LS + 8 * seg) * 2); \
            *(v4u*)(Og + (size_t)(b * SEQT + gdn_sp((c_), row, d)) * LDP + 8 * seg) = ov; } } while (0)
        CH_LOAD(0, 0); CH_LOAD(1, 1); CH_LOAD(2, 2); CH_LOAD(3, 3); CH_LOAD(4, 4);
        CH_PARK(0, 0); CH_LOAD(0, 5);
        GDN_BAR();
#pragma unroll 1
        for (int c6 = 0; c6 < 70; c6 += 5) {
#pragma unroll
            for (int u = 0; u < 5; ++u) { const int c = c6 + u;
                if (c < 68) {
                    if (c > 0) CH_HSTORE(c - 1);
                    CH_PARK((u + 1) % 5, c + 1); CH_LOAD((u + 1) % 5, c + 6);
                    GDN_BAR();
                } }
        }
        CH_HSTORE(67);
#undef CH_LOAD
#undef CH_PARK
#undef CH_HSTORE
    } else {
#pragma unroll
        for (int nt = 0; nt < 4; ++nt) *(LAS v2u*)(sbuf + ((16 * nt + l15) * LS + 16 * w + 4 * g) * 2) = (v2u){0u, 0u};
        GDN_BAR();
#pragma unroll 1
        for (int c = 0; c < 68; ++c) {
            const LAS unsigned char* rb = sbuf + (c & 1) * 9216; LAS unsigned char* wb = sbuf + ((c + 1) & 1) * 9216; LAS unsigned char* ob = obuf + (c & 1) * 9216;
            const LAS unsigned char* sl = ring + (c & 1) * CH_SLOT;
            const bf16x8_t aM0 = lds_frag(sl, 16 * w + l15, 8 * g), aM1 = lds_frag(sl, 16 * w + l15, 32 + 8 * g);
            const bf16x8_t aP0 = lds_frag(sl + 9216, 16 * w + l15, 8 * g), aP1 = lds_frag(sl + 9216, 16 * w + l15, 32 + 8 * g);
            f32x4_t Sn[4], Oc[4];
#pragma unroll
            for (int nt = 0; nt < 4; ++nt) {
                const v2u nN = *(const LAS v2u*)(sl + 2 * 9216 + ((16 * nt + l15) * LS + 16 * w + 4 * g) * 2), nQ = *(const LAS v2u*)(sl + 3 * 9216 + ((16 * nt + l15) * LS + 16 * w + 4 * g) * 2);
                const bf16x8_t b0 = lds_frag(rb, 16 * nt + l15, 8 * g), b1 = lds_frag(rb, 16 * nt + l15, 32 + 8 * g);
                Sn[nt] = (f32x4_t){__uint_as_float(nN.x << 16), __uint_as_float(nN.x & 0xffff0000u), __uint_as_float(nN.y << 16), __uint_as_float(nN.y & 0xffff0000u)};
                Oc[nt] = (f32x4_t){__uint_as_float(nQ.x << 16), __uint_as_float(nQ.x & 0xffff0000u), __uint_as_float(nQ.y << 16), __uint_as_float(nQ.y & 0xffff0000u)};
                Sn[nt] = __builtin_amdgcn_mfma_f32_16x16x32_bf16(aM0, b0, Sn[nt], 0, 0, 0); Sn[nt] = __builtin_amdgcn_mfma_f32_16x16x32_bf16(aM1, b1, Sn[nt], 0, 0, 0);
                Oc[nt] = __builtin_amdgcn_mfma_f32_16x16x32_bf16(aP0, b0, Oc[nt], 0, 0, 0); Oc[nt] = __builtin_amdgcn_mfma_f32_16x16x32_bf16(aP1, b1, Oc[nt], 0, 0, 0);
            }
#pragma unroll
            for (int nt = 0; nt < 4; ++nt) { v2u o; o.x = cvtpk(Sn[nt][0], Sn[nt][1]); o.y = cvtpk(Sn[nt][2], Sn[nt][3]); *(LAS v2u*)(wb + ((16 * nt + l15) * LS + 16 * w + 4 * g) * 2) = o; }
#pragma unroll
            for (int nt = 0; nt < 4; ++nt) { const unsigned p01 = cvtpk(Oc[nt][0], Oc[nt][1]), p23 = cvtpk(Oc[nt][2], Oc[nt][3]);
                LAS unsigned char* op = ob + ((16 * w + 4 * g) * LS + 16 * nt + l15) * 2;
                *(LAS bf16_t*)op = (bf16_t)(p01 & 0xffffu); *(LAS bf16_t*)(op + LS * 2) = (bf16_t)(p01 >> 16); *(LAS bf16_t*)(op + 2 * LS * 2) = (bf16_t)(p23 & 0xffffu); *(LAS bf16_t*)(op + 3 * LS * 2) = (bf16_t)(p23 >> 16); }
            GDN_BAR();
        }
    }
#undef GDN_BAR
}

constexpr int R_U = 0, R_A0 = 9216, R_A1 = R_A0 + 16384, R_B0 = R_A1 + 16384, R_B1 = R_B0 + 8192, R_HALF = 58368;
constexpr int R_W = 2 * R_HALF, R_TB = R_W + 4 * 9216;
#ifndef RGP_GATES
#define RGP_GATES 1
#endif
#ifndef RGP_SCAN
#define RGP_SCAN 1
#endif
#ifndef RGP_CONV
#define RGP_CONV 1
#endif
constexpr int RG_ITEMS = NB * 68 * 6;
#define RG_BAR() do { asm volatile("s_waitcnt lgkmcnt(0)" ::: "memory"); __builtin_amdgcn_s_barrier(); asm volatile("" ::: "memory"); } while (0)

__device__ __forceinline__ int opq2(int i) { asm volatile("" : "+s"(i)); return i; }
template <int MODE>
__device__ __forceinline__ void rg_pass(const bf16_t* P, const float* cw, const bf16_t* RGWT, const float* rgtab  ,
                                        float* SUMA, float* SUMH, const float* HIN, bf16_t* F, LAS unsigned char* lds, int wid8  , int bidx, int nblk) {
    const int n = bidx % 6, nwg = (nblk - n + 5) / 6, hq = bidx / 6;
    const int n_iter = (272 + 2 * nwg - 1) / (2 * nwg);
    {   const int tv0 = wid8 * 64 + lane_id_v();
        for (int e = tv0; e < 4 * 512; e += 512) { const int m = e >> 9, row = (e >> 3) & 63, seg = e & 7;
            *(LAS v4u*)(lds + R_W + m * 9216 + (row * LS + 8 * seg) * 2) = *(const v4u*)(RGWT + (size_t)(((m >> 1) * 6 + n) * 2 + (m & 1)) * 4096 + row * 64 + 8 * seg); }
        if (tv0 < 384) { const int d = tv0 / 192, k = (tv0 % 192) >> 6, e = tv0 & 63; ((LAS float*)(lds + R_TB))[tv0] = rgtab[k * 768 + d * 384 + n * 64 + e]; }
    }
    v4u pre[4][2];
#define RG_ITEM_OF(iter_, half_) ((iter_) * 2 * nwg + hq * 2 + (half_))
#define RG_PREFETCH(kp_, tv_) do { const int tc_ = (kp_) % 68, b_ = (kp_) / 68; const int i_ = ((tv_) & 255) >> 2, qd_ = (tv_) & 3, sp_ = tc_ * 64 + i_; \
        const int lo_ = sp_ < CTX ? 0 : CTX, hi_ = sp_ < CTX ? CTX : SEQT; \
        _Pragma("unroll") for (int j = 0; j < 4; ++j) { const int s2_ = sp_ + j - 2; const bool ok_ = (kp_) < 272 && s2_ >= lo_ && s2_ < hi_; \
            const bf16_t* pr_ = P + (size_t)(b_ * SEQT + (ok_ ? s2_ : sp_)) * LDP + C_XA + n * 64 + 16 * qd_; \
            pre[j][0] = ok_ ? *(const v4u*)pr_ : (v4u){0u, 0u, 0u, 0u}; pre[j][1] = ok_ ? *(const v4u*)(pr_ + 8) : (v4u){0u, 0u, 0u, 0u}; } } while (0)
    { const int tv0 = wid8 * 64 + lane_id_v(); RG_PREFETCH(RG_ITEM_OF(0, tv0 >> 8), tv0); }
    RG_BAR();
#pragma unroll 1
    for (int iter = 0; iter < n_iter; ++iter) {
        const int tidf = wid8 * 64 + lane_id_v();
        const int half = __builtin_amdgcn_readfirstlane(tidf >> 8), t256 = tidf & 255, w = __builtin_amdgcn_readfirstlane(t256 >> 6), lane = tidf & 63, g = lane >> 4, l15 = lane & 15;
        LAS unsigned char* hb = lds + half * R_HALF;
        const int kp = RG_ITEM_OF(iter, half);
        const bool valid = kp < 272;
        const int tc = kp % 68, b = kp / 68;
        const int i = t256 >> 2, qd = t256 & 3;
        const int t = b * SEQT + tc * 64 + i;
        TP_BEGIN(8); TP_BEGIN(9);
        _Pragma("unroll 1") for (int rq = 0, nq = opq2(RGP_CONV); rq < nq; ++rq)
        {
            float u[16];
#pragma unroll
            for (int e = 0; e < 16; ++e) u[e] = 0.f;
#pragma unroll
            for (int j = 0; j < 4; ++j) { const float* wr_ = cw + j * CONV_CH + C_XA + n * 64 + 16 * qd;
                const f32x4_t w0 = *(const f32x4_t*)wr_, w1 = *(const f32x4_t*)(wr_ + 4), w2 = *(const f32x4_t*)(wr_ + 8), w3 = *(const f32x4_t*)(wr_ + 12);
                const float wv[16] = {w0[0], w0[1], w0[2], w0[3], w1[0], w1[1], w1[2], w1[3], w2[0], w2[1], w2[2], w2[3], w3[0], w3[1], w3[2], w3[3]};
                const unsigned aw[8] = {pre[j][0].x, pre[j][0].y, pre[j][0].z, pre[j][0].w, pre[j][1].x, pre[j][1].y, pre[j][1].z, pre[j][1].w};
#pragma unroll
                for (int e2 = 0; e2 < 8; ++e2) { u[2 * e2] += wv[2 * e2] * __uint_as_float(aw[e2] << 16); u[2 * e2 + 1] += wv[2 * e2 + 1] * __uint_as_float(aw[e2] & 0xffff0000u); } }
            v4u o0, o1;
            o0.x = cvtpk(u[0], u[1]); o0.y = cvtpk(u[2], u[3]); o0.z = cvtpk(u[4], u[5]); o0.w = cvtpk(u[6], u[7]);
            o1.x = cvtpk(u[8], u[9]); o1.y = cvtpk(u[10], u[11]); o1.z = cvtpk(u[12], u[13]); o1.w = cvtpk(u[14], u[15]);
            *(LAS v4u*)(hb + R_U + (i * LS + 16 * qd) * 2) = o0; *(LAS v4u*)(hb + R_U + (i * LS + 16 * qd + 8) * 2) = o1;
        }
        RG_PREFETCH(RG_ITEM_OF(iter + 1, half), tidf);
        RG_BAR(); if (MODE == 3) { TP_END(9, 9); } TP_BEGIN(10);
        _Pragma("unroll 1") for (int rq = 0, nq = opq2(RGP_GATES); rq < nq; ++rq)
        if (valid) {
            const bf16x8_t a0 = lds_frag(hb + R_U, 16 * w + l15, 8 * g), a1 = lds_frag(hb + R_U, 16 * w + l15, 32 + 8 * g);
            const LAS float* tbl = (const LAS float*)(lds + R_TB);
#pragma unroll
            for (int d = 0; d < 2; ++d) {
                LAS float* Ad = (LAS float*)(hb + (d == 0 ? R_A0 : R_A1)); LAS bf16_t* Bd = (LAS bf16_t*)(hb + (d == 0 ? R_B0 : R_B1));
                const LAS unsigned char* wa_l = lds + R_W + (d * 2) * 9216; const LAS unsigned char* wx_l = wa_l + 9216;
#pragma unroll
                for (int nt = 0; nt < 4; ++nt) {
                    const int e = 16 * nt + l15;
                    f32x4_t ra = {0.f, 0.f, 0.f, 0.f}, ri = {0.f, 0.f, 0.f, 0.f};
                    ra = __builtin_amdgcn_mfma_f32_16x16x32_bf16(a0, lds_frag(wa_l, e, 8 * g), ra, 0, 0, 0); ra = __builtin_amdgcn_mfma_f32_16x16x32_bf16(a1, lds_frag(wa_l, e, 32 + 8 * g), ra, 0, 0, 0);
                    ri = __builtin_amdgcn_mfma_f32_16x16x32_bf16(a0, lds_frag(wx_l, e, 8 * g), ri, 0, 0, 0); ri = __builtin_amdgcn_mfma_f32_16x16x32_bf16(a1, lds_frag(wx_l, e, 32 + 8 * g), ri, 0, 0, 0);
                    const float bav = tbl[d * 192 + e], bxv = tbl[d * 192 + 64 + e], ls8 = tbl[d * 192 + 128 + e];
#pragma unroll
                    for (int r = 0; r < 4; r += 2) {
                        const int tok = 16 * w + 4 * g + r;
                        float av[2], bv[2];
#pragma unroll
                        for (int q = 0; q < 2; ++q) {
                            const float rr = frcp(1.0f + fexp(-(ra[r + q] + bav))), ig = frcp(1.0f + fexp(-(ri[r + q] + bxv)));
                            const float log_a = rr * ls8, y = 2.0f * log_a;
                            const float om = -y * (1.0f + y * (0.5f + y * ((1.0f / 6.0f) + y * ((1.0f / 24.0f) + y * ((1.0f / 120.0f) + y * ((1.0f / 720.0f) + y * (1.0f / 5040.0f)))))));
                            av[q] = fexp(log_a); bv[q] = fsqrt_(om) * ig; }
                        const unsigned bp = cvtpk(bv[0], bv[1]);
                        Ad[tok * 64 + e] = av[0]; Ad[(tok + 1) * 64 + e] = av[1];
                        Bd[tok * 64 + e] = (bf16_t)(bp & 0xffffu); Bd[(tok + 1) * 64 + e] = (bf16_t)(bp >> 16);
                    }
                }
            }
        }
        v4u z0 = {0u, 0u, 0u, 0u}, z1 = z0;
        if (MODE == 3 && valid) { const bf16_t* zp = P + (size_t)t * LDP + C_ZA + n * 64 + 16 * qd; z0 = *(const v4u*)zp; z1 = *(const v4u*)(zp + 8); }
        RG_BAR(); if (MODE == 3) { TP_END(10, 10); } TP_BEGIN(11);
        _Pragma("unroll 1") for (int rq = 0, nq = (MODE == 1 ? opq2(RGP_SCAN) : 1); rq < nq; ++rq)
        if (valid && w < 2) {
            const int d = w;
            const LAS float* Ad = (const LAS float*)(hb + (d == 0 ? R_A0 : R_A1)); LAS bf16_t* Bd = (LAS bf16_t*)(hb + (d == 0 ? R_B0 : R_B1));
            const int ch = n * 64 + lane; const size_t si = ((size_t)(d * NB + b) * 68 + tc) * 384 + ch;
            float h = MODE == 3 ? HIN[si] : 0.f, ap = 1.f;
#pragma unroll 8
            for (int step = 0; step < 64; ++step) { const int tok = d ? 63 - step : step; const float a = Ad[tok * 64 + lane];
                h = a * h + bf2f(Bd[tok * 64 + lane]) * bf2f(*(const LAS bf16_t*)(hb + R_U + (tok * LS + lane) * 2)); if (MODE == 3) Bd[tok * 64 + lane] = (bf16_t)(cvtpk(h, 0.f) & 0xffffu); else ap *= a; }
            if (MODE == 1) { SUMA[si] = ap; SUMH[si] = h; }
        }
        if (MODE == 3) {
            RG_BAR(); TP_END(11, 11);
            if (valid) {
                const LAS bf16_t* B0 = (const LAS bf16_t*)(hb + R_B0); const LAS bf16_t* B1 = (const LAS bf16_t*)(hb + R_B1);
                const unsigned zw[8] = {z0.x, z0.y, z0.z, z0.w, z1.x, z1.y, z1.z, z1.w};
                unsigned ow[8];
#pragma unroll
                for (int e2 = 0; e2 < 8; ++e2) { const int e = 16 * qd + 2 * e2;
                    const float h0 = bf2f(B0[i * 64 + e]) + bf2f(B1[i * 64 + e]), h1 = bf2f(B0[i * 64 + e + 1]) + bf2f(B1[i * 64 + e + 1]);
                    ow[e2] = cvtpk(h0 * siluf_(__uint_as_float(zw[e2] << 16)), h1 * siluf_(__uint_as_float(zw[e2] & 0xffff0000u))); }
                v4u o0 = {ow[0], ow[1], ow[2], ow[3]}, o1 = {ow[4], ow[5], ow[6], ow[7]};
                bf16_t* fp = F + (size_t)t * 1024 + n * 64 + 16 * qd;
                *(v4u*)fp = o0; *(v4u*)(fp + 8) = o1;
            }
        }
        TP_BEGIN(12);
        RG_BAR(); if (MODE == 3) { TP_END(12, 12); TP_END(8, 8); }
    }
#undef RG_PREFETCH
#undef RG_ITEM_OF
}
#undef RG_BAR
__device__ __forceinline__ void rg_carry(const float* SUMA, const float* SUMH, float* HIN, int idx) {
    const int ch = idx % 384, b = (idx / 384) % NB, d = idx / (384 * NB);
    const size_t base = ((size_t)(d * NB + b) * 68) * 384 + ch;
    float h = 0.f;
#pragma unroll 4
    for (int s = 0; s < 68; ++s) { const int tc = d == 0 ? s : (s < 4 ? 3 - s : 71 - s);
        const size_t k = base + (size_t)tc * 384; HIN[k] = h; h = SUMA[k] * h + SUMH[k]; }
}

constexpr int NA_LAT_ITEMS = NB * 6 * 64 * 4, NA_CTX_ITEMS = NB * 6 * 16;
__device__ __forceinline__ void na_mfma_item(const bf16_t* P, const bf16_t* VT, const LAS float* rpbl, bf16_t* F, int item, int lane) {
    const int g = lane >> 4, l15 = lane & 15;
    const bool latent = item < NA_LAT_ITEMS;
    int b, hh, r, qb;
    if (latent) { qb = item & 3; r = (item >> 2) & 63; const int bh = item >> 8; hh = bh % 6; b = bh / 6; }
    else { const int it2 = item - NA_LAT_ITEMS; qb = it2 & 15; const int bh = it2 >> 4; hh = bh % 6; b = bh / 6; r = 0; }
    const int tq = latent ? b * SEQT + CTX + r * 64 + 16 * qb + l15 : b * SEQT + 16 * qb + l15;
    const bf16_t* qp = P + (size_t)tq * LDP + C_QN + hh * 64 + 8 * g;
    const bf16x8_t bq0 = *(const bf16x8_t*)qp, bq1 = *(const bf16x8_t*)(qp + 32);
    const int c0 = qb == 0 ? 0 : (qb == 1 ? 8 : (qb == 2 ? 24 : 32));
    const int r0 = min(max(r - 4, 0), 56), jq = 16 * qb + l15, cs = min(max(jq - 8, 0), 48);
    const int ia = 8 * (l15 >> 2) + (l15 & 3);
    float sc[16][8];
#define NA_TOK0(G_) ((G_) < 8 ? b * SEQT + CTX + (r0 + (G_)) * 64 + c0 : b * SEQT + 32 * ((G_) - 8))
#define NA_QK_BATCH(G0_, NG_) do { bf16x8_t kf[NG_][4]; \
        _Pragma("unroll") for (int q = 0; q < (NG_); ++q) { const bf16_t* ka = P + (size_t)(NA_TOK0((G0_) + q) + ia) * LDP + C_KN + hh * 64 + 8 * g; const bf16_t* kb = ka + 4 * LDP; \
            kf[q][0] = *(const bf16x8_t*)ka; kf[q][1] = *(const bf16x8_t*)(ka + 32); kf[q][2] = *(const bf16x8_t*)kb; kf[q][3] = *(const bf16x8_t*)(kb + 32); } \
        _Pragma("unroll") for (int q = 0; q < (NG_); ++q) { const int G = (G0_) + q; \
            f32x4_t sa = {0.f, 0.f, 0.f, 0.f}, sb = {0.f, 0.f, 0.f, 0.f}; \
            sa = __builtin_amdgcn_mfma_f32_16x16x32_bf16(kf[q][0], bq0, sa, 0, 0, 0); sa = __builtin_amdgcn_mfma_f32_16x16x32_bf16(kf[q][1], bq1, sa, 0, 0, 0); \
            sb = __builtin_amdgcn_mfma_f32_16x16x32_bf16(kf[q][2], bq0, sb, 0, 0, 0); sb = __builtin_amdgcn_mfma_f32_16x16x32_bf16(kf[q][3], bq1, sb, 0, 0, 0); \
            _Pragma("unroll") for (int e = 0; e < 8; ++e) { float v = (e < 4 ? sa[e & 3] : sb[e & 3]) * 0.125f; \
                if (G < 8) { const int kc = c0 + 8 * g + e; const bool ok = kc >= cs && kc < cs + 16; \
                    const float bias = rpbl[hh * 465 + (r0 + G - r + 7) * 31 + (ok ? kc - jq + 15 : 0)]; v = ok ? v + bias : -1e30f; } \
                sc[G][e] = v; } } } while (0)
    if (latent) NA_QK_BATCH(0, 8);
    else {
#pragma unroll
        for (int G = 0; G < 8; ++G)
#pragma unroll
            for (int e = 0; e < 8; ++e) sc[G][e] = -1e30f;
    }
    NA_QK_BATCH(8, 4);
    NA_QK_BATCH(12, 4);
    float m = -1e30f;
#pragma unroll
    for (int G = 0; G < 16; ++G)
#pragma unroll
        for (int e = 0; e < 8; ++e) m = fmaxf(m, sc[G][e]);
    m = fmaxf(m, shx(m, 16)); m = fmaxf(m, shx(m, 32));
    bf16x8_t pf[16]; float lsum = 0.f;
#pragma unroll
    for (int G = 0; G < 16; ++G) { float pv[8];
#pragma unroll
        for (int e = 0; e < 8; ++e) { pv[e] = fexp(sc[G][e] - m); lsum += pv[e]; }
        v4u pk; pk.x = cvtpk(pv[0], pv[1]); pk.y = cvtpk(pv[2], pv[3]); pk.z = cvtpk(pv[4], pv[5]); pk.w = cvtpk(pv[6], pv[7]);
        pf[G] = __builtin_bit_cast(bf16x8_t, pk); }
    f32x4_t o[4];
#pragma unroll
    for (int dt = 0; dt < 4; ++dt) o[dt] = (f32x4_t){0.f, 0.f, 0.f, 0.f};
    const bf16_t* vbase = VT + (size_t)(hh * 64 + l15) * T + 8 * g;
#define NA_PV_BATCH(G0_, NG_) do { bf16x8_t vf[NG_][4]; \
        _Pragma("unroll") for (int q = 0; q < (NG_); ++q) { const int tok0 = NA_TOK0((G0_) + q); \
            _Pragma("unroll") for (int dt = 0; dt < 4; ++dt) vf[q][dt] = *(const bf16x8_t*)(vbase + (size_t)(16 * dt) * T + tok0); } \
        _Pragma("unroll") for (int q = 0; q < (NG_); ++q) { _Pragma("unroll") for (int dt = 0; dt < 4; ++dt) o[dt] = __builtin_amdgcn_mfma_f32_16x16x32_bf16(vf[q][dt], pf[(G0_) + q], o[dt], 0, 0, 0); } } while (0)
    if (latent) NA_PV_BATCH(0, 8);
    NA_PV_BATCH(8, 8);
#undef NA_TOK0
#undef NA_QK_BATCH
#undef NA_PV_BATCH
    lsum += shx(lsum, 16); lsum += shx(lsum, 32);
    const float inv = frcp(lsum);
#pragma unroll
    for (int dt = 0; dt < 4; ++dt) {
        const v2u zr = *(const v2u*)(P + (size_t)tq * LDP + C_ZN + hh * 64 + 16 * dt + 4 * g);
        const float z0 = __uint_as_float(zr.x << 16), z1 = __uint_as_float(zr.x & 0xffff0000u), z2 = __uint_as_float(zr.y << 16), z3 = __uint_as_float(zr.y & 0xffff0000u);
        v2u ov; ov.x = cvtpk(o[dt][0] * inv * siluf_(z0), o[dt][1] * inv * siluf_(z1)); ov.y = cvtpk(o[dt][2] * inv * siluf_(z2), o[dt][3] * inv * siluf_(z3));
        *(v2u*)(F + (size_t)tq * 1024 + 384 + hh * 64 + 16 * dt + 4 * g) = ov;
    }
}
constexpr int NAW_K = 12288, NAW_KROW = 144, NAW_VROW = 1680, NAW_ITEMW = 12032;
constexpr int NAW_LAT = NB * 6 * 32, NAW_CTX = NB * 6 * 2;
__device__ __forceinline__ void na_wg_item(const bf16_t* P, const bf16_t* VT, LAS unsigned char* lds, bf16_t* F, int item, int wid, int lane) {
    const LAS float* rpbl = (const LAS float*)lds;
    const int g = lane >> 4, l15 = lane & 15, tid = wid * 64 + lane;
    const bool latent = item < NAW_LAT;
    int b, hh, rp;
    if (latent) { rp = item & 31; const int bh = item >> 5; hh = bh % 6; b = bh / 6; } else { const int it2 = item - NAW_LAT; rp = it2 & 1; const int bh = it2 >> 1; hh = bh % 6; b = bh / 6; }
    const int r = latent ? 2 * rp + (wid >> 2) : 0, qb = latent ? (wid & 3) : 8 * rp + wid;
    const int R0 = min(max(2 * rp - 4, 0), 56);
    const int tq = latent ? b * SEQT + CTX + r * 64 + 16 * qb + l15 : b * SEQT + 16 * qb + l15;
    const bf16_t* qp = P + (size_t)tq * LDP + C_QN + hh * 64 + 8 * g;
    const bf16x8_t bq0 = *(const bf16x8_t*)qp, bq1 = *(const bf16x8_t*)(qp + 32);
    LAS unsigned char* kreg = lds + NAW_K;
    {   v4u kr[13];
#pragma unroll
        for (int k = 0; k < 13; ++k) { const int p = tid + 512 * k, key = p >> 3, seg = p & 7;
            const int tok = key < 576 ? b * SEQT + CTX + min(R0 + (key >> 6), 63) * 64 + (key & 63) : b * SEQT + (key - 576);
            kr[k] = (latent || key >= 576) ? *(const v4u*)(P + (size_t)tok * LDP + C_KN + hh * 64 + 8 * seg) : (v4u){0u, 0u, 0u, 0u}; }
#pragma unroll
        for (int k = 0; k < 13; ++k) { const int p = tid + 512 * k, key = p >> 3, seg = p & 7; *(LAS v4u*)(kreg + key * NAW_KROW + seg * 16) = kr[k]; }
    }
    __syncthreads();
    const int c0 = (qb & 3) == 0 ? 0 : ((qb & 3) == 1 ? 8 : ((qb & 3) == 2 ? 24 : 32));
    const int r0 = min(max(r - 4, 0), 56), jq = 16 * (qb & 3) + l15, cs = min(max(jq - 8, 0), 48);
    const int ia = 8 * (l15 >> 2) + (l15 & 3);
    float sc[16][8];
#define NAW_KEY0(G_) ((G_) < 8 ? (r0 - R0 + (G_)) * 64 + c0 : 576 + 32 * ((G_) - 8))
#pragma unroll
    for (int G = 0; G < 16; ++G) {
        if (G < 8 && !latent) {
#pragma unroll
            for (int e = 0; e < 8; ++e) sc[G][e] = -1e30f;
            continue; }
        const LAS unsigned char* ka = kreg + (NAW_KEY0(G) + ia) * NAW_KROW + 16 * g; const LAS unsigned char* kb = ka + 4 * NAW_KROW;
        const bf16x8_t aa0 = *(const LAS bf16x8_t*)ka, aa1 = *(const LAS bf16x8_t*)(ka + 64), ab0 = *(const LAS bf16x8_t*)kb, ab1 = *(const LAS bf16x8_t*)(kb + 64);
        f32x4_t sa = {0.f, 0.f, 0.f, 0.f}, sb = {0.f, 0.f, 0.f, 0.f};
        sa = __builtin_amdgcn_mfma_f32_16x16x32_bf16(aa0, bq0, sa, 0, 0, 0); sa = __builtin_amdgcn_mfma_f32_16x16x32_bf16(aa1, bq1, sa, 0, 0, 0);
        sb = __builtin_amdgcn_mfma_f32_16x16x32_bf16(ab0, bq0, sb, 0, 0, 0); sb = __builtin_amdgcn_mfma_f32_16x16x32_bf16(ab1, bq1, sb, 0, 0, 0);
#pragma unroll
        for (int e = 0; e < 8; ++e) {
            float v = (e < 4 ? sa[e & 3] : sb[e & 3]) * 0.125f;
            if (G < 8) { const int kc = c0 + 8 * g + e; const bool ok = kc >= cs && kc < cs + 16;
                const float bias = rpbl[hh * 465 + (r0 + G - r + 7) * 31 + (ok ? kc - jq + 15 : 0)]; v = ok ? v + bias : -1e30f; }
            sc[G][e] = v;
        }
    }
    v4u vr[13];
#define NAW_VLOAD(k0_, k1_) do { _Pragma("unroll") for (int k = (k0_); k < (k1_); ++k) { const int p = tid + 512 * k, dim = p / 104, q = p - dim * 104; \
        const bf16_t* src = VT + (size_t)(hh * 64 + dim) * T + (q < 72 ? b * SEQT + CTX + min(R0 + (q >> 3), 63) * 64 + (q & 7) * 8 : b * SEQT + (q - 72) * 8); \
        vr[k] = (latent || q >= 72) ? *(const v4u*)src : (v4u){0u, 0u, 0u, 0u}; } } while (0)
    NAW_VLOAD(0, 5);
    float m = -1e30f;
#pragma unroll
    for (int G = 0; G < 16; ++G)
#pragma unroll
        for (int e = 0; e < 8; ++e) m = fmaxf(m, sc[G][e]);
    m = fmaxf(m, shx(m, 16)); m = fmaxf(m, shx(m, 32));
    bf16x8_t pf[16]; float lsum = 0.f;
#pragma unroll
    for (int G = 0; G < 16; ++G) { float pv[8];
#pragma unroll
        for (int e = 0; e < 8; ++e) { pv[e] = fexp(sc[G][e] - m); lsum += pv[e]; }
        v4u pk; pk.x = cvtpk(pv[0], pv[1]); pk.y = cvtpk(pv[2], pv[3]); pk.z = cvtpk(pv[4], pv[5]); pk.w = cvtpk(pv[6], pv[7]);
        pf[G] = __builtin_bit_cast(bf16x8_t, pk); }
    NAW_VLOAD(5, 13);
#undef NAW_VLOAD
    __syncthreads();
#pragma unroll
    for (int k = 0; k < 13; ++k) { const int p = tid + 512 * k, dim = p / 104, q = p - dim * 104; const int key = q < 72 ? (q >> 3) * 64 + (q & 7) * 8 : 576 + (q - 72) * 8;
        *(LAS v4u*)(kreg + dim * NAW_VROW + key * 2) = vr[k]; }
    __syncthreads();
    f32x4_t o[4];
#pragma unroll
    for (int dt = 0; dt < 4; ++dt) o[dt] = (f32x4_t){0.f, 0.f, 0.f, 0.f};
#pragma unroll
    for (int G = 0; G < 16; ++G) {
        if (G < 8 && !latent) continue;
        const LAS unsigned char* vb = kreg + l15 * NAW_VROW + (NAW_KEY0(G) + 8 * g) * 2;
#pragma unroll
        for (int dt = 0; dt < 4; ++dt) o[dt] = __builtin_amdgcn_mfma_f32_16x16x32_bf16(*(const LAS bf16x8_t*)(vb + 16 * dt * NAW_VROW), pf[G], o[dt], 0, 0, 0);
    }
#undef NAW_KEY0
    lsum += shx(lsum, 16); lsum += shx(lsum, 32);
    const float inv = frcp(lsum);
    int tq2 = tq; asm volatile("" : "+v"(tq2));
#pragma unroll
    for (int dt = 0; dt < 4; ++dt) {
        const v2u zr = *(const v2u*)(P + (size_t)tq2 * LDP + C_ZN + hh * 64 + 16 * dt + 4 * g);
        const float z0 = __uint_as_float(zr.x << 16), z1 = __uint_as_float(zr.x & 0xffff0000u), z2 = __uint_as_float(zr.y << 16), z3 = __uint_as_float(zr.y & 0xffff0000u);
        v2u ov; ov.x = cvtpk(o[dt][0] * inv * siluf_(z0), o[dt][1] * inv * siluf_(z1)); ov.y = cvtpk(o[dt][2] * inv * siluf_(z2), o[dt][3] * inv * siluf_(z3));
        *(v2u*)(F + (size_t)tq2 * 1024 + 384 + hh * 64 + 16 * dt + 4 * g) = ov;
    }
    __syncthreads();
}
__device__ __forceinline__ void vt_transpose(const bf16_t* P, bf16_t* VT, LAS unsigned char* scr, int gw, int NGW, int lane) {
    for (int it = gw; it < NB * 68 * 6; it += NGW) {
        const int hh = it % 6, tcb = it / 6, t0 = (tcb / 68) * SEQT + (tcb % 68) * 64;
        const bf16_t* src = P + (size_t)(t0 + lane) * LDP + C_VN + hh * 64;
#pragma unroll
        for (int q8 = 0; q8 < 8; ++q8) *(LAS v4u*)(scr + (lane * LS + 8 * q8) * 2) = *(const v4u*)(src + 8 * q8);
        LDS_WAIT();
        bf16_t* dst = VT + (size_t)(hh * 64 + lane) * T + t0;
#pragma unroll
        for (int q8 = 0; q8 < 8; ++q8) { unsigned w4[4];
#pragma unroll
            for (int e2 = 0; e2 < 4; ++e2) { const unsigned lo = *(const LAS bf16_t*)(scr + ((8 * q8 + 2 * e2) * LS + lane) * 2), hi = *(const LAS bf16_t*)(scr + ((8 * q8 + 2 * e2 + 1) * LS + lane) * 2); w4[e2] = lo | (hi << 16); }
            v4u o = {w4[0], w4[1], w4[2], w4[3]}; *(v4u*)(dst + 8 * q8) = o; }
        LDS_WAIT();
    }
}
#define XB_TMO      128
#define XB_XCNT(j)  (256  + 64 * (j))
#define XB_XSUB(j)  (1280 + 64 * (j))
#define XB_XGEN(j)  (2304 + 64 * (j))
#define XB_TOP      3328
#define XB_TOPGEN   3392
#define XCD_BAR_WORDS 3456
#define XB_SPIN_CAP (1u << 18)

__device__ __forceinline__ unsigned xb_ld(unsigned* p)              { return __hip_atomic_load(p, __ATOMIC_RELAXED, __HIP_MEMORY_SCOPE_AGENT); }
__device__ __forceinline__ unsigned xb_add(unsigned* p, unsigned v) { return __hip_atomic_fetch_add(p, v, __ATOMIC_RELAXED, __HIP_MEMORY_SCOPE_AGENT); }
__device__ __forceinline__ unsigned xb_xcc_id() { return (unsigned)__builtin_amdgcn_s_getreg((3 << 11) | 20) & 0xFu; }
#define XB_SPIN(cond, bar) do { unsigned _sp = 0; while (cond) { __builtin_amdgcn_s_sleep(1); \
    if ((++_sp & 255u) == 0u) { if (xb_ld(&(bar)[XB_TMO])) break; if (_sp > XB_SPIN_CAP) { atomicAdd(&(bar)[XB_TMO], 1u); break; } } } } while (0)

struct XcdBarrier {
    unsigned* bar; unsigned x;
    volatile LAS unsigned* st;
};

__device__ __forceinline__ XcdBarrier xcd_barrier_post(unsigned* bar, volatile LAS unsigned* st) {
    XcdBarrier b; b.bar = bar; b.x = xb_xcc_id(); b.st = st;
    if (threadIdx.x == 0) (void)xb_add(&bar[XB_XCNT(b.x)], 1u);
    return b;
}
__device__ __forceinline__ void xcd_barrier_complete(unsigned* bar, unsigned x, unsigned& nloc, unsigned& nx) {
    const unsigned G = gridDim.x * gridDim.y * gridDim.z;
    unsigned sum, cnt, mine, sp = 0u;
    for (;;) {
        sum = 0u; cnt = 0u; mine = 0u;
#pragma unroll
        for (unsigned j = 0; j < 16; ++j) { const unsigned c = xb_ld(&bar[XB_XCNT(j)]); sum += c; cnt += (c > 0u) ? 1u : 0u; mine = (j == x) ? c : mine; }
        if (sum == G) break;
        __builtin_amdgcn_s_sleep(1);
        if ((++sp & 255u) == 0u) { if (xb_ld(&bar[XB_TMO])) break; if (sp > XB_SPIN_CAP) { atomicAdd(&bar[XB_TMO], 1u); break; } }
    }
    nloc = mine > 0u ? mine : 1u; nx = cnt > 0u ? cnt : 1u;
}

__device__ __forceinline__ void xcd_barrier(const XcdBarrier& b) {
    asm volatile("s_waitcnt vmcnt(0)" ::: "memory");
    __syncthreads();
    if (threadIdx.x == 0) {
        unsigned* bar = b.bar;
        __builtin_amdgcn_s_waitcnt(0);
        unsigned nloc = b.st[0], nx = b.st[1];
        if (nloc == 0u) { xcd_barrier_complete(bar, b.x, nloc, nx); b.st[0] = nloc; b.st[1] = nx; }
        const unsigned old = xb_add(&bar[XB_XSUB(b.x)], 1u);
        const unsigned gen = old / nloc;
        if (old + 1u == (gen + 1u) * nloc) {
            __builtin_amdgcn_fence(__ATOMIC_RELEASE, "agent");
            asm volatile("s_waitcnt vmcnt(0)" ::: "memory");
            const unsigned og = xb_add(&bar[XB_TOP], 1u);
            const unsigned tg = og / nx;
            if (og + 1u == (tg + 1u) * nx) xb_add(&bar[XB_TOPGEN], 1u);
            else XB_SPIN(xb_ld(&bar[XB_TOPGEN]) == tg, bar);
            __builtin_amdgcn_fence(__ATOMIC_ACQUIRE, "agent");
            xb_add(&bar[XB_XGEN(b.x)], 1u);
            asm volatile("s_waitcnt vmcnt(0)" ::: "memory");
        } else {
            XB_SPIN(xb_ld(&bar[XB_XGEN(b.x)]) == gen, bar);
            __builtin_amdgcn_fence(__ATOMIC_ACQUIRE, "agent");
            asm volatile("s_waitcnt vmcnt(0)" ::: "memory");
        }
    }
    __syncthreads();
}


#ifndef REP_P2A
#define REP_P2A 1
#endif
#ifndef REP_P2B
#define REP_P2B 1
#endif
#ifndef REP_CH
#define REP_CH 1
#endif
#ifndef REP_NA
#define REP_NA 1
#endif
#ifndef REP_GDN1
#define REP_GDN1 1
#endif
#ifndef REP_RG1
#define REP_RG1 1
#endif
#ifndef REP_VT
#define REP_VT 1
#endif
#ifndef REP_COMB
#define REP_COMB 1
#endif
#ifndef REP_RG3
#define REP_RG3 1
#endif
#ifndef REP_G2
#define REP_G2 1
#endif
#ifndef REP_P5
#define REP_P5 1
#endif
#ifndef REP_P3
#define REP_P3 1
#endif
#ifndef REP_G1
#define REP_G1 1
#endif
#ifndef REP_SYNC
#define REP_SYNC 1
#endif
#ifdef PHPROBE
#define PH_MARK(id_) do { if (bid == 0 && threadIdx.x == 0) { const unsigned long long now_ = __builtin_amdgcn_s_memrealtime(); LAS unsigned long long* ph_ = (LAS unsigned long long*)(lds + LDS_BAR_OFF + 64); ph_[16 + (id_)] += now_ - ph_[15]; ph_[15] = now_; } } while (0)
#else
#define PH_MARK(id_) do {} while (0)
#endif
#define GSYNC() do { _Pragma("unroll 1") for (int rs_ = 0, nrs_ = opq(REP_SYNC); rs_ < nrs_; ++rs_) { XcdBarrier xb_; xb_.bar = (unsigned*)(WSB + WS_BAR); xb_.x = xb_xcc_id(); xb_.st = (volatile LAS unsigned*)(lds + LDS_BAR_OFF); xcd_barrier(xb_); } } while (0)
__device__ __forceinline__ int opq(int i) { asm volatile("" : "+s"(i)); return i; }
#define IN(i) ((const float*)p.ptr[opq(i)])
#define WSB ((unsigned char*)p.ptr[opq(21)])
#define OUTP ((float*)p.ptr[opq(20)])
#define ctl ((unsigned*)(WSB + WS_CTL))
#define mod ((float*)(WSB + WS_MOD))
#define WTIN ((bf16_t*)(WSB + WS_WTIN))
#define WTOUT ((bf16_t*)(WSB + WS_WTOUT))
#define X ((float*)(WSB + WS_X))
#define UF ((bf16_t*)(WSB + WS_UF))
#define P ((bf16_t*)(WSB + WS_P))
#define gdn0 ((unsigned char*)OUTP)
#define gdnx (WSB + WS_GDNX)
#define VT ((bf16_t*)(WSB + WS_VT))
#define rcos ((float*)(WSB + WS_ROPE))
#define rsin ((float*)(WSB + WS_ROPE) + 1024)
#define RGWT ((bf16_t*)(WSB + WS_RGWT))
#define rgtab ((float*)(WSB + WS_RGTAB))
#define SUMA ((float*)(WSB + WS_RGS))
#define SUMH ((float*)(WSB + WS_RGS) + (1 << 18))
#define HIN ((float*)(WSB + WS_RGS) + (2 << 18))
__device__ __forceinline__ int fresh_v(int v) { asm volatile("" : "+v"(v)); return v; }
__device__ __forceinline__ int lane_now() { int l; asm volatile("v_mbcnt_lo_u32_b32 %0, -1, 0\n\tv_mbcnt_hi_u32_b32 %0, -1, %0" : "=v"(l)); return l; }
enum { I_X = 0, I_C, I_CTX, I_CCTX, I_WMOD, I_BMOD, I_WIN, I_CONVW, I_RGWA, I_RGBA, I_RGWX, I_RGBX, I_RGLAM, I_RPB, I_ALOG, I_DTB, I_NW, I_WOUT, I_LNG, I_LNB };
__global__ void __launch_bounds__(512, 2) mega_fwd(Params p) {
    extern __shared__ __attribute__((aligned(16))) unsigned char lds_raw[];
    LAS unsigned char* lds = (LAS unsigned char*)lds_raw;
    cg::grid_group grid = cg::this_grid();
    const int bid = (int)blockIdx.x; __builtin_assume(bid >= 0 && bid < 256);
    const int wid = __builtin_amdgcn_readfirstlane((int)threadIdx.x >> 6);
#define lane0 lane_now()
#define tid (wid * 64 + lane_now())
#define BIDL opq(bid)
#define WIDL opq(wid)
    const int gw0 = bid * 8 + wid, NGW = 2048;
    if (threadIdx.x < 2) ((volatile LAS unsigned*)(lds + LDS_BAR_OFF))[threadIdx.x] = 0u;
#if defined(TPROBE) || defined(PHPROBE)
    if (threadIdx.x < 64) ((volatile LAS unsigned*)(lds + LDS_BAR_OFF + 64))[threadIdx.x] = 0u;
#endif
    __syncthreads();
    (void)xcd_barrier_post((unsigned*)(WSB + WS_BAR), (volatile LAS unsigned*)(lds + LDS_BAR_OFF));
#ifdef PHPROBE
    if (bid == 0 && threadIdx.x == 0) ((LAS unsigned long long*)(lds + LDS_BAR_OFF + 64))[15] = __builtin_amdgcn_s_memrealtime();
#endif
    const int gw = gw0;
    LAS float* wscr = (LAS float*)(lds + wid * 16384);
    { const int lane = lane_now();

    phase_mods(IN(I_C), IN(I_CCTX), IN(I_WMOD), IN(I_BMOD), mod, (LAS float*)lds, wid, lane);
    convert_weights(IN(I_WIN), IN(I_WOUT), WTIN, WTOUT, wscr, gw, NGW, lane);
    convert_rg(IN(I_RGWA), IN(I_RGBA), IN(I_RGWX), IN(I_RGBX), IN(I_RGLAM), RGWT, rgtab, (int)blockIdx.x * 512 + tid, (int)gridDim.x * 512);
    if (blockIdx.x == 0) { for (int e = tid; e < 1024; e += 512) { const float ang = (float)(e >> 4) * expf(-(float)(e & 15) * (9.210340371976184f / 16.0f)); rcos[e] = cosf(ang); rsin[e] = sinf(ang); } }
    grid.sync(); PH_MARK(0);
    prep_rows0(IN(I_X), IN(I_CTX), mod, UF, gw, NGW, lane);
    }
    GSYNC(); PH_MARK(1);
#pragma unroll 1
    for (int l = 0; l < DEPTH; ++l) {
        const float* modl = mod + (size_t)l * 5 * 3072;
        { pg8::Gemm g{UF, WTIN, T, NPAD, D}; pg8::StaticOrder S; S.init(T, NPAD, 256, BIDL);
          pg8::EpiP E{P};
          _Pragma("unroll 1") for (int rp = 0, nrp = opq(REP_G1); rp < nrp; ++rp)
          pg8::gemm_phase<pg8::EpiP, pg8::StaticOrder, true, true>(lds, g, S, E, WIDL * 64 + lane_now());
        }
        GSYNC(); PH_MARK(2);
        _Pragma("unroll 1") for (int rp = 0, nrp = opq(REP_P2A); rp < nrp; ++rp) {
#ifndef ABL_P1
        _Pragma("unroll 1") for (int r2 = 0, n2 = opq(REP_GDN1); r2 < n2; ++r2)
        gdn_pass1(P, IN(I_CONVW) + (size_t)l * 4 * CONV_CH, IN(I_ALOG) + l * 8, IN(I_DTB) + l * 8, rcos, rsin, gdn0, gdnx, lds, WIDL, BIDL, opq(256));
#endif
        _Pragma("unroll 1") for (int r2 = 0, n2 = opq(REP_RG1); r2 < n2; ++r2)
        rg_pass<1>(P, IN(I_CONVW) + (size_t)l * 4 * CONV_CH, RGWT, rgtab, SUMA, SUMH, nullptr, nullptr, lds, WIDL, BIDL, opq(256));
        _Pragma("unroll 1") for (int r2 = 0, n2 = opq(REP_VT); r2 < n2; ++r2)
        vt_transpose(P, VT, lds + WIDL * 16384, (BIDL * 8 + WIDL), NGW, fresh_v(lane0));
        __syncthreads(); }
        GSYNC(); PH_MARK(3);
        _Pragma("unroll 1") for (int rp = 0, nrp = opq(REP_P2B); rp < nrp; ++rp) { const int lane = fresh_v(lane0); const int bx = BIDL;
            const float* rpb = IN(I_RPB) + (size_t)l * 6 * 15 * 31;
            for (int e = (WIDL * 64 + lane_now()); e < 6 * 465; e += 512) ((LAS float*)lds)[e] = rpb[e];
            __syncthreads();
#ifndef ABL_CH
            if (bx < 32) _Pragma("unroll 1") for (int r2 = 0, n2 = opq(REP_CH); r2 < n2; ++r2) gdn_chain(gdn0, gdnx, P, bx, lds + 12288, WIDL, lane);
#endif
            if (bx >= 32 && bx < 38) rg_carry(SUMA, SUMH, HIN, (bx - 32) * 512 + (WIDL * 64 + lane_now()));
            __syncthreads();
            const int n_items = NAW_LAT + (l < DEPTH - 1 ? NAW_CTX : 0);
            _Pragma("unroll 1") for (int r3 = 0, n3 = opq(REP_NA); r3 < n3; ++r3) {
            unsigned* cnt = ctl + 64 * (l + 1) + 16 * rp + 8 * r3;
            for (;;) {
                if ((WIDL * 64 + lane_now()) == 0) *(LAS int*)(lds + NAW_ITEMW) = (int)__hip_atomic_fetch_add(cnt, 1u, __ATOMIC_RELAXED, __HIP_MEMORY_SCOPE_AGENT);
                __syncthreads();
                const int it = __builtin_amdgcn_readfirstlane(*(const LAS int*)(lds + NAW_ITEMW));
                if (it >= n_items) break;
                na_wg_item(P, VT, lds, UF, it, WIDL, lane_now());
            } }
            __syncthreads();
        }
        GSYNC(); PH_MARK(4);
        _Pragma("unroll 1") for (int rp = 0, nrp = opq(REP_P3); rp < nrp; ++rp) {
        _Pragma("unroll 1") for (int r2 = 0, n2 = opq(REP_RG3); r2 < n2; ++r2)
        rg_pass<3>(P, IN(I_CONVW) + (size_t)l * 4 * CONV_CH, RGWT, rgtab, nullptr, nullptr, HIN, UF, lds, WIDL, BIDL, opq(256));
        { const int lane = fresh_v(lane0); const int gw = (BIDL * 8 + WIDL); _Pragma("unroll 1") for (int r2 = 0, n2 = opq(REP_COMB); r2 < n2; ++r2) combine_rows(P, IN(I_NW) + l * 64, UF, gw, NGW, lane); } }
        GSYNC(); PH_MARK(5);
        { pg8::Gemm g{UF, WTOUT, T, D, D};
          pg8::EpiZ E{IN(I_X), IN(I_CTX), X, X, modl, l == 0 ? 1 : 0};
          if (l < DEPTH - 1) { pg8::StaticOrder S; S.init(T, D, 256, BIDL); pg8::gemm_phase<pg8::EpiZ, pg8::StaticOrder, true, true>(lds, g, S, E, WIDL * 64 + lane_now()); }
          else { pg8::LatOrder S{BIDL}; pg8::gemm_phase<pg8::EpiZ, pg8::LatOrder, false, true>(lds, g, S, E, WIDL * 64 + lane_now()); }
        }
        GSYNC(); PH_MARK(6);
        if (l < DEPTH - 1) { const int lane = fresh_v(lane0); const int gw = (BIDL * 8 + WIDL);
            if (opq(REP_P5) > 1) { ln_rows(X, (float*)P, IN(I_LNG) + l * D, IN(I_LNB) + l * D, nullptr, mod + (size_t)(l + 1) * 5 * 3072, (bf16_t*)((unsigned char*)P + 72 * MiB), gw, NGW, lane);
                convert_weights(IN(I_WIN) + (size_t)(l + 1) * D * DIN, IN(I_WOUT) + (size_t)(l + 1) * D * D, WTIN, WTOUT, (LAS float*)(lds + WIDL * 16384), gw, NGW, lane); }
            ln_rows(X, X, IN(I_LNG) + l * D, IN(I_LNB) + l * D, nullptr, mod + (size_t)(l + 1) * 5 * 3072, UF, gw, NGW, lane);
            convert_weights(IN(I_WIN) + (size_t)(l + 1) * D * DIN, IN(I_WOUT) + (size_t)(l + 1) * D * D, WTIN, WTOUT, (LAS float*)(lds + WIDL * 16384), gw, NGW, lane);
            convert_rg(IN(I_RGWA) + (size_t)(l + 1) * 49152, IN(I_RGBA) + (l + 1) * 768, IN(I_RGWX) + (size_t)(l + 1) * 49152, IN(I_RGBX) + (l + 1) * 768, IN(I_RGLAM) + (l + 1) * 768, RGWT, rgtab, BIDL * 512 + (WIDL * 64 + lane_now()), opq(256) * 512);
            GSYNC(); PH_MARK(7);
        } else { const int lane = fresh_v(lane0); const int gw = (BIDL * 8 + WIDL); ln_rows(X, X, IN(I_LNG) + l * D, IN(I_LNB) + l * D, OUTP, nullptr, nullptr, gw, NGW, lane); }
    }
#ifdef PHPROBE
    GSYNC(); PH_MARK(7);
    if (bid == 0 && threadIdx.x == 0) { const LAS unsigned long long* ph = (const LAS unsigned long long*)(lds + LDS_BAR_OFF + 64); OUTP[0] = 0.01f * (float)ph[16 + PHPROBE]; }
#endif
#ifdef TPROBE
#ifndef TPBASE
#define TPBASE 0
#endif
    GSYNC();
    if (bid == 0 && threadIdx.x == 0) { const LAS unsigned long long* tp = (const LAS unsigned long long*)(lds + LDS_BAR_OFF + 64);
        OUTP[0] = 1000.0f * (float)tp[TPROBE] / (float)tp[TPBASE]; }
#endif
}
#undef ctl
#undef mod
#undef WTIN
#undef WTOUT
#undef X
#undef UF
#undef P
#undef gdn0
#undef gdnx
#undef VT
#undef rcos
#undef rsin
#undef RGWT
#undef rgtab
#undef SUMA
#undef SUMH
#undef HIN
#undef lane0
#undef BIDL
#undef WIDL
#undef tid
}

extern "C" void kernel_launch(void* const* d_in, const int* in_sizes, int n_in, void* d_out, int out_size, void* d_ws, size_t ws_size, hipStream_t stream) {
    static int grid = 0;
    if (grid == 0) {
        if (n_in != 20 || ws_size < WS_END) { fprintf(stderr, "kernel_launch: unexpected n_in %d / ws_size %zu\n", n_in, ws_size); grid = -1; return; }
        int dev = 0, cus = 0, per_cu = 0;
        hipGetDevice(&dev);
        hipDeviceGetAttribute(&cus, hipDeviceAttributeMultiprocessorCount, dev);
        if (hipFuncSetAttribute((const void*)mega_fwd, hipFuncAttributeMaxDynamicSharedMemorySize, LDS_BYTES) != hipSuccess) { fprintf(stderr, "kernel_launch: hipFuncSetAttribute failed\n"); grid = -1; return; }
        if (hipOccupancyMaxActiveBlocksPerMultiprocessor(&per_cu, (const void*)mega_fwd, 512, LDS_BYTES) != hipSuccess || per_cu < 1) { fprintf(stderr, "kernel_launch: occupancy query gave %d\n", per_cu); per_cu = 1; }
        (void)hipGetLastError();
        grid = 256;
        if (cus < 256) { fprintf(stderr, "kernel_launch: needs 256 CUs, device has %d\n", cus); grid = -1; return; }
        fprintf(stderr, "kernel_launch: cus %d per_cu %d grid %d\n", cus, per_cu, grid);
    }
    if (grid < 0) return;
    hipMemsetAsync((char*)d_ws + WS_CTL, 0, CTL_ZERO_BYTES, stream);
    Params prm{};
    for (int i = 0; i < 20; ++i) prm.ptr[i] = d_in[i];
    prm.ptr[20] = d_out; prm.ptr[21] = d_ws;
    void* args[] = {&prm};
    hipError_t e = hipLaunchCooperativeKernel((const void*)mega_fwd, dim3(grid), dim3(512), args, LDS_BYTES, stream);
    if (e != hipSuccess) fprintf(stderr, "cooperative launch failed: %s (grid %d)\n", hipGetErrorString(e), grid);
}
```
